# Optimizing an MI355X kernel written in HIP

```python
import jax, jax.numpy as jnp
from jax import lax
import numpy as np

D_MODEL = 2048
BATCH = 1
SEQ = 16384
DEPTH = 2

SB_HEAD_DIM = 128
SB_HEADS = D_MODEL // (2 * SB_HEAD_DIM)
SB_WIDTH = SB_HEADS * SB_HEAD_DIM
Q_BLOCK = 128
K_CHUNK = 128
SSM_WIDTH = D_MODEL // 2
SSM_GROUP = 16
SSM_GROUPS = SSM_WIDTH // SSM_GROUP
SSM_STATE = 64
DT_MIN = 0.001
DT_MAX = 0.1
IN_COLS = 3 * SB_WIDTH + SSM_WIDTH + 2 * D_MODEL
D_FF_DENSE = 2 * D_MODEL
N_EXPERTS = 8
TOP_K = 2
D_FF_EXPERT = D_MODEL // 2
N_DENSE = (DEPTH + 1) // 2
N_MOE = DEPTH // 2
RMS_EPS = 1e-6

kernel_name = 'hybrid_stickbreak_s5_moe_trunk'


def rms_norm(x, g):
    x32 = x.astype(jnp.float32)
    y = x32 * lax.rsqrt(jnp.mean(x32 * x32, axis=-1, keepdims=True) + RMS_EPS)
    return (y * g.astype(jnp.float32)).astype(x.dtype)


def suffix_sum(m, n_chunks):
    mc = m.reshape(m.shape[:-1] + (n_chunks, K_CHUNK))
    ci = jnp.arange(K_CHUNK)
    tri = (ci[:, None] >= ci[None, :]).astype(m.dtype)
    ni = jnp.arange(n_chunks)
    strict = (ni[:, None] > ni[None, :]).astype(m.dtype)
    within = jnp.einsum('bhqnc,cd->bhqnd', mc, tri)
    after = jnp.einsum('bhqn,np->bhqp', jnp.sum(mc, axis=-1), strict)
    return (within + after[..., None]).reshape(m.shape)


def stick_breaking_attention(q, k, v):
    b, s, h, dh = q.shape
    nb = s // Q_BLOCK
    scale = dh ** -0.5
    qh = q.transpose(0, 2, 1, 3)
    kh = k.transpose(0, 2, 1, 3)
    vh = v.transpose(0, 2, 1, 3)
    outs = []
    for blk in range(nb):
        lk = (blk + 1) * Q_BLOCK
        q_blk = qh[:, :, blk * Q_BLOCK:lk]
        z = jnp.einsum('bhqd,bhkd->bhqk', q_blk, kh[:, :, :lk],
                       preferred_element_type=jnp.float32) * scale
        q_pos = blk * Q_BLOCK + jnp.arange(Q_BLOCK)
        causal = jnp.arange(lk)[None, :] < q_pos[:, None]
        sp = jnp.where(causal, jax.nn.softplus(z), 0.0)
        r = suffix_sum(sp, lk // K_CHUNK)
        w = jnp.exp(jnp.where(causal, z - r, -jnp.inf))
        outs.append(jnp.einsum('bhqk,bhkd->bhqd', w.astype(vh.dtype), vh[:, :, :lk]))
    out = jnp.concatenate(outs, axis=2)
    return out.transpose(0, 2, 1, 3).reshape(b, s, h * dh)


def s5_ssm(u, a_re, a_im, log_dt, b_re, b_im, c_re, c_im, d_skip):
    bsz, s, _ = u.shape
    f32 = jnp.float32
    u32 = u.astype(f32).reshape(bsz, s, SSM_GROUPS, SSM_GROUP)
    dt = jnp.exp(log_dt.astype(f32))[:, None]
    ar = a_re.astype(f32)
    ai = a_im.astype(f32)
    mag = jnp.exp(dt * ar)
    abar_re = mag * jnp.cos(dt * ai)
    abar_im = mag * jnp.sin(dt * ai)
    den = ar * ar + ai * ai
    num_re = abar_re - 1.0
    zoh_re = (num_re * ar + abar_im * ai) / den
    zoh_im = (abar_im * ar - num_re * ai) / den
    br = b_re.astype(f32)
    bi = b_im.astype(f32)
    bbar_re = zoh_re[..., None] * br - zoh_im[..., None] * bi
    bbar_im = zoh_re[..., None] * bi + zoh_im[..., None] * br
    bu_re = jnp.einsum('bsgp,gnp->bsgn', u32, bbar_re)
    bu_im = jnp.einsum('bsgp,gnp->bsgn', u32, bbar_im)
    a_re_t = jnp.broadcast_to(abar_re, bu_re.shape)
    a_im_t = jnp.broadcast_to(abar_im, bu_im.shape)

    def combine(left, right):
        l_ar, l_ai, l_br, l_bi = left
        r_ar, r_ai, r_br, r_bi = right
        return (r_ar * l_ar - r_ai * l_ai,
                r_ar * l_ai + r_ai * l_ar,
                r_ar * l_br - r_ai * l_bi + r_br,
                r_ar * l_bi + r_ai * l_br + r_bi)

    _, _, x_re, x_im = lax.associative_scan(combine, (a_re_t, a_im_t, bu_re, bu_im), axis=1)
    y = (jnp.einsum('bsgn,gpn->bsgp', x_re, c_re.astype(f32))
         - jnp.einsum('bsgn,gpn->bsgp', x_im, c_im.astype(f32))
         + d_skip.astype(f32) * u32)
    return y.reshape(bsz, s, SSM_WIDTH).astype(u.dtype)


def hybrid_mixer(h, w_in, a_re, a_im, log_dt, b_re, b_im, c_re, c_im, d_skip,
                 w_glu, p_attn, p_ssm, w_out):
    b, s, _ = h.shape
    proj = h @ w_in
    cuts = [SB_WIDTH, 2 * SB_WIDTH, 3 * SB_WIDTH, 3 * SB_WIDTH + SSM_WIDTH,
            3 * SB_WIDTH + SSM_WIDTH + D_MODEL]
    q, k, v, u, gate_a, gate_b = jnp.split(proj, cuts, axis=-1)
    heads = lambda t: t.reshape(b, s, SB_HEADS, SB_HEAD_DIM)
    o_attn = stick_breaking_attention(heads(q), heads(k), heads(v))
    y = jax.nn.gelu(s5_ssm(u, a_re, a_im, log_dt, b_re, b_im, c_re, c_im, d_skip))
    o_ssm = y * jax.nn.sigmoid(y @ w_glu)
    merged = (jax.nn.sigmoid(gate_a) * (o_attn @ p_attn)
              + jax.nn.sigmoid(gate_b) * (o_ssm @ p_ssm))
    return merged @ w_out


def swiglu(h, w_gate, w_up, w_down):
    return (jax.nn.silu(h @ w_gate) * (h @ w_up)) @ w_down


def moe_swiglu(h, w_router, w_gate, w_up, w_down):
    logits = jnp.einsum('bsd,de->bse', h, w_router, preferred_element_type=jnp.float32)
    top_val, top_idx = lax.top_k(logits, TOP_K)
    gates = jax.nn.softmax(top_val, axis=-1)
    weights = jnp.sum(jax.nn.one_hot(top_idx, N_EXPERTS, dtype=jnp.float32)
                      * gates[..., None], axis=-2)
    out = jnp.zeros_like(h)
    for e in range(N_EXPERTS):
        out = out + weights[..., e:e + 1].astype(h.dtype) * swiglu(h, w_gate[e], w_up[e], w_down[e])
    return out


def setup_inputs(seed: int = 0) -> dict:
    key = jax.random.key(seed)
    ks = jax.random.split(key, 26)
    f32 = jnp.float32
    nrm = lambda k, shape, scale: jax.random.normal(k, shape, f32) * scale
    n_idx = jnp.arange(SSM_STATE, dtype=f32)
    a_re = -0.5 + nrm(ks[5], (DEPTH, SSM_GROUPS, SSM_STATE), 0.01)
    a_im = jnp.pi * n_idx + nrm(ks[6], (DEPTH, SSM_GROUPS, SSM_STATE), 0.01)
    log_dt = jax.random.uniform(ks[7], (DEPTH, SSM_GROUPS), f32,
                                float(np.log(DT_MIN)), float(np.log(DT_MAX)))
    b_scale = (2.0 * SSM_GROUP) ** -0.5
    c_scale = (2.0 * SSM_STATE) ** -0.5
    return {
        'x': nrm(ks[0], (BATCH, SEQ, D_MODEL), 1.0),
        'mix_norm': 1.0 + nrm(ks[1], (DEPTH, D_MODEL), 0.02),
        'ffn_norm': 1.0 + nrm(ks[2], (DEPTH, D_MODEL), 0.02),
        'final_norm': 1.0 + nrm(ks[3], (D_MODEL,), 0.02),
        'w_in': nrm(ks[4], (DEPTH, D_MODEL, IN_COLS), D_MODEL ** -0.5),
        'ssm_a_re': a_re,
        'ssm_a_im': a_im,
        'ssm_log_dt': log_dt,
        'ssm_b_re': nrm(ks[8], (DEPTH, SSM_GROUPS, SSM_STATE, SSM_GROUP), b_scale),
        'ssm_b_im': nrm(ks[9], (DEPTH, SSM_GROUPS, SSM_STATE, SSM_GROUP), b_scale),
        'ssm_c_re': nrm(ks[10], (DEPTH, SSM_GROUPS, SSM_GROUP, SSM_STATE), c_scale),
        'ssm_c_im': nrm(ks[11], (DEPTH, SSM_GROUPS, SSM_GROUP, SSM_STATE), c_scale),
        'ssm_d': nrm(ks[12], (DEPTH, SSM_GROUPS, SSM_GROUP), 1.0),
        'w_glu': nrm(ks[13], (DEPTH, SSM_WIDTH, SSM_WIDTH), SSM_WIDTH ** -0.5),
        'p_attn': nrm(ks[14], (DEPTH, SB_WIDTH, D_MODEL), SB_WIDTH ** -0.5),
        'p_ssm': nrm(ks[15], (DEPTH, SSM_WIDTH, D_MODEL), SSM_WIDTH ** -0.5),
        'w_out': nrm(ks[16], (DEPTH, D_MODEL, D_MODEL), D_MODEL ** -0.5),
        'ffn_w_gate': nrm(ks[17], (N_DENSE, D_MODEL, D_FF_DENSE), D_MODEL ** -0.5),
        'ffn_w_up': nrm(ks[18], (N_DENSE, D_MODEL, D_FF_DENSE), D_MODEL ** -0.5),
        'ffn_w_down': nrm(ks[19], (N_DENSE, D_FF_DENSE, D_MODEL), D_FF_DENSE ** -0.5),
        'w_router': nrm(ks[20], (N_MOE, D_MODEL, N_EXPERTS), D_MODEL ** -0.5),
        'moe_w_gate': nrm(ks[21], (N_MOE, N_EXPERTS, D_MODEL, D_FF_EXPERT), D_MODEL ** -0.5),
        'moe_w_up': nrm(ks[22], (N_MOE, N_EXPERTS, D_MODEL, D_FF_EXPERT), D_MODEL ** -0.5),
        'moe_w_down': nrm(ks[23], (N_MOE, N_EXPERTS, D_FF_EXPERT, D_MODEL), D_FF_EXPERT ** -0.5),
    }


def reference(x, mix_norm, ffn_norm, final_norm, w_in, ssm_a_re, ssm_a_im, ssm_log_dt,
              ssm_b_re, ssm_b_im, ssm_c_re, ssm_c_im, ssm_d, w_glu, p_attn, p_ssm, w_out,
              ffn_w_gate, ffn_w_up, ffn_w_down, w_router, moe_w_gate, moe_w_up, moe_w_down):
    for layer in range(DEPTH):
        h = rms_norm(x, mix_norm[layer])
        x = x + hybrid_mixer(h, w_in[layer], ssm_a_re[layer], ssm_a_im[layer], ssm_log_dt[layer],
                             ssm_b_re[layer], ssm_b_im[layer], ssm_c_re[layer], ssm_c_im[layer],
                             ssm_d[layer], w_glu[layer], p_attn[layer], p_ssm[layer], w_out[layer])
        h = rms_norm(x, ffn_norm[layer])
        i = layer // 2
        if layer % 2 == 0:
            x = x + swiglu(h, ffn_w_gate[i], ffn_w_up[i], ffn_w_down[i])
        else:
            x = x + moe_swiglu(h, w_router[i], moe_w_gate[i], moe_w_up[i], moe_w_down[i])
    return rms_norm(x, final_norm)
```

```cpp
#include <hip/hip_runtime.h>
#include <cstdio>
#include <cstdint>

#ifndef MK_ONE_LAUNCH
#define MK_ONE_LAUNCH 0
#endif

#define GAS __attribute__((address_space(1)))
#define LAS __attribute__((address_space(3)))
typedef unsigned short bf16;
typedef short bf16x8 __attribute__((ext_vector_type(8)));
typedef float f32x4 __attribute__((ext_vector_type(4)));
typedef float f32x16 __attribute__((ext_vector_type(16)));
typedef unsigned u32x4 __attribute__((ext_vector_type(4)));
typedef unsigned u32x2 __attribute__((ext_vector_type(2)));
typedef GAS unsigned gu32;

constexpr int S = 16384, D = 2048, INC = 8192, SBW = 1024, SSMW = 1024, NH = 8, HD = 128;
constexpr int SG = 64, SN = 64, SP = 16;
constexpr int FFD = 4096, NE = 8, FFE = 1024;
constexpr int CH = 64, NCH = S / CH;
constexpr float RMS_EPS = 1e-6f;
constexpr float SB_THRESH = 30.0f;

constexpr size_t MiB = 1u << 20;
constexpr size_t WS_CTL = 0, CTL_ZERO_BYTES = 1 * MiB;
constexpr size_t WS_SSMT = 1 * MiB;
constexpr size_t WS_MOE = 2 * MiB;
constexpr size_t WS_XE = 4 * MiB;
constexpr size_t WS_W = 12 * MiB;
constexpr size_t W_IN = 0, W_GLU = 32 * MiB, W_PA = 34 * MiB, W_PS = 38 * MiB, W_OUT = 42 * MiB, W_FFN = 50 * MiB;
constexpr size_t W_GU = W_FFN, W_DN_DENSE = W_FFN + 32 * MiB, W_DN_MOE = W_FFN + 64 * MiB;
constexpr size_t WS_XN = 158 * MiB;
constexpr size_t WS_Y = 158 * MiB, WS_OSSM = 190 * MiB;
constexpr size_t WS_Q = 222 * MiB;
constexpr size_t WS_GA = 350 * MiB, WS_GB = 414 * MiB;
constexpr size_t WS_ACT = 222 * MiB;
constexpr size_t WS_MOEY = 350 * MiB;
constexpr size_t WS_OATT = 478 * MiB;
constexpr size_t WS_END = 510 * MiB;

constexpr int CW_BAR = 4096;
constexpr int CW_MOECNT = 16384;

constexpr size_t ST_ABAR = 0;
constexpr size_t ST_ABARL = 32768;
constexpr size_t ST_BBF = 65536;
constexpr size_t ST_CTF = 65536 + 262144;

constexpr int NWAVES = 8, NTHR = 512;
constexpr int RING_BYTES = 131072, LDSCTL_OFF = RING_BYTES, MISC_OFF = LDSCTL_OFF + 320, LDS_BYTES = 147456;

#define RLX_AGENT __ATOMIC_RELAXED, __HIP_MEMORY_SCOPE_AGENT
#define LDS_WAIT() asm volatile("s_waitcnt lgkmcnt(0)" ::: "memory")
#define VM_WAIT() asm volatile("s_waitcnt vmcnt(0)" ::: "memory")

__device__ __forceinline__ unsigned f2bf(float f) { unsigned u = __builtin_bit_cast(unsigned, f); return (u + 0x7fffu + ((u >> 16) & 1u)) >> 16; }
__device__ __forceinline__ unsigned pk2(float lo, float hi) { return f2bf(lo) | (f2bf(hi) << 16); }
typedef float f32x2_t __attribute__((ext_vector_type(2)));
typedef __bf16 bf16x2_t __attribute__((ext_vector_type(2)));
__device__ __forceinline__ unsigned cvt_pk_bf16(float lo, float hi) { const f32x2_t v = {lo, hi}; const bf16x2_t b = __builtin_convertvector(v, bf16x2_t); return __builtin_bit_cast(unsigned, b); }
__device__ __forceinline__ float bflo(unsigned w) { return __builtin_bit_cast(float, w << 16); }
__device__ __forceinline__ float bfhi(unsigned w) { return __builtin_bit_cast(float, w & 0xffff0000u); }
__device__ __forceinline__ float bf2f(bf16 b) { return __builtin_bit_cast(float, ((unsigned)b) << 16); }
__device__ __forceinline__ float sigmoidf_(float x) { return __builtin_amdgcn_rcpf(1.0f + __expf(-x)); }
__device__ __forceinline__ float wave_sum(float v) {
#pragma unroll
    for (int o = 1; o < 64; o <<= 1) v += __shfl_xor(v, o);
    return v;
}

#define XB_TMO      128
#define XB_XCNT(j)  (256  + 64 * (j))
#define XB_XSUB(j)  (1280 + 64 * (j))
#define XB_XGEN(j)  (2304 + 64 * (j))
#define XB_TOP      3328
#define XB_TOPGEN   3392
#define XCD_BAR_WORDS 3456
#define XB_SPIN_CAP (1u << 18)
__device__ __forceinline__ unsigned xb_ld(unsigned* p)              { return __hip_atomic_load(p, __ATOMIC_RELAXED, __HIP_MEMORY_SCOPE_AGENT); }
__device__ __forceinline__ unsigned xb_add(unsigned* p, unsigned v) { return __hip_atomic_fetch_add(p, v, __ATOMIC_RELAXED, __HIP_MEMORY_SCOPE_AGENT); }
__device__ __forceinline__ unsigned xb_xcc_id() { return (unsigned)__builtin_amdgcn_s_getreg((3 << 11) | 20) & 0xFu; }
#define XB_SPIN(cond, bar) do { unsigned _sp = 0; while (cond) { __builtin_amdgcn_s_sleep(1); \
    if ((++_sp & 255u) == 0u) { if (xb_ld(&(bar)[XB_TMO])) break; if (_sp > XB_SPIN_CAP) { atomicAdd(&(bar)[XB_TMO], 1u); break; } } } } while (0)
struct XcdBarrier { unsigned* bar; unsigned x; volatile LAS unsigned* st; };
__device__ __forceinline__ XcdBarrier xcd_barrier_post(unsigned* bar, volatile LAS unsigned* st) {
    XcdBarrier b; b.bar = bar; b.x = xb_xcc_id(); b.st = st;
    if (threadIdx.x == 0) (void)xb_add(&bar[XB_XCNT(b.x)], 1u);
    return b;
}
__device__ __forceinline__ void xcd_barrier_complete(unsigned* bar, unsigned x, unsigned& nloc, unsigned& nx) {
    const unsigned G = gridDim.x * gridDim.y * gridDim.z;
    unsigned sum, cnt, mine, sp = 0u;
    for (;;) {
        sum = 0u; cnt = 0u; mine = 0u;
#pragma unroll
        for (unsigned j = 0; j < 16; ++j) { const unsigned c = xb_ld(&bar[XB_XCNT(j)]); sum += c; cnt += (c > 0u) ? 1u : 0u; mine = (j == x) ? c : mine; }
        if (sum == G) break;
        __builtin_amdgcn_s_sleep(1);
        if ((++sp & 255u) == 0u) { if (xb_ld(&bar[XB_TMO])) break; if (sp > XB_SPIN_CAP) { atomicAdd(&bar[XB_TMO], 1u); break; } }
    }
    nloc = mine > 0u ? mine : 1u; nx = cnt > 0u ? cnt : 1u;
}
__device__ __forceinline__ void xcd_barrier(const XcdBarrier& b) {
    asm volatile("s_waitcnt vmcnt(0)" ::: "memory");
    __syncthreads();
    if (threadIdx.x == 0) {
        unsigned* bar = b.bar;
        __builtin_amdgcn_s_waitcnt(0);
        unsigned nloc = b.st[0], nx = b.st[1];
        if (nloc == 0u) { xcd_barrier_complete(bar, b.x, nloc, nx); b.st[0] = nloc; b.st[1] = nx; }
        const unsigned old = xb_add(&bar[XB_XSUB(b.x)], 1u);
        const unsigned gen = old / nloc;
        if (old + 1u == (gen + 1u) * nloc) {
            __builtin_amdgcn_fence(__ATOMIC_RELEASE, "agent");
            asm volatile("s_waitcnt vmcnt(0)" ::: "memory");
            const unsigned og = xb_add(&bar[XB_TOP], 1u);
            const unsigned tg = og / nx;
            if (og + 1u == (tg + 1u) * nx) xb_add(&bar[XB_TOPGEN], 1u);
            else XB_SPIN(xb_ld(&bar[XB_TOPGEN]) == tg, bar);
            __builtin_amdgcn_fence(__ATOMIC_ACQUIRE, "agent");
            xb_add(&bar[XB_XGEN(b.x)], 1u);
            asm volatile("s_waitcnt vmcnt(0)" ::: "memory");
        } else {
            XB_SPIN(xb_ld(&bar[XB_XGEN(b.x)]) == gen, bar);
            __builtin_amdgcn_fence(__ATOMIC_ACQUIRE, "agent");
            asm volatile("s_waitcnt vmcnt(0)" ::: "memory");
        }
    }
    __syncthreads();
}

namespace pg8 {
constexpr int BM = 256, BK = 64, HALF = 128, HTB = HALF * BK * 2, STAGE_BYTES = 8 * HTB, NXCD = 8, WGM = 8;
__host__ __device__ __forceinline__ int lds_byte(int r, int c) { const int st = (r >> 4) * 2 + (c >> 5), rr = r & 15, cc = c & 31, ob = rr * 64 + cc * 2; return st * 1024 + (ob ^ (((ob >> 9) & 1) << 5)); }
__host__ __device__ __forceinline__ void stage_rc(int b, int& R, int& C) { const int st = b / 1024, sb = b % 1024, swz = sb ^ (((sb >> 9) & 1) << 5); R = (st >> 1) * 16 + swz / 64; C = (st & 1) * 32 + (swz % 64) / 2; }
__host__ __device__ __forceinline__ int perm32(int rho) { const int n = rho >> 4, i = rho & 15; return 8 * (i >> 2) + 4 * n + (i & 3); }

struct Unit { int pm, pn, e, nv; };

struct StaticOrder {
    int nM, nN, nwg, G, c;
    __device__ void init(int M, int N, int G_, int c_) { nM = M / BM; nN = N / BM; nwg = nM * nN; G = G_; c = c_; }
    __device__ bool next(int i, Unit& u) const {
        const long L = (long)i * G + c; if (L >= nwg) return false;
        int wgid = (int)L; { const int q = nwg / NXCD, r = nwg % NXCD, xcd = wgid % NXCD, off = wgid / NXCD; wgid = (xcd < r ? xcd * (q + 1) : r * (q + 1) + (xcd - r) * q) + off; }
        const int nig = WGM * nN, gid = wgid / nig, fm = gid * WGM, gsz = (nM - fm) < WGM ? (nM - fm) : WGM;
        u.pm = fm + ((wgid % nig) % gsz); u.pn = (wgid % nig) / gsz; u.e = 0; u.nv = 256; return true;
    }
};
struct DenseSched {
    StaticOrder so; const bf16* A; const bf16* Bt; int K;
    __device__ __forceinline__ bool next(int i, Unit& u) const { return so.next(i, u); }
    __device__ __forceinline__ const char* abase(const Unit& u) const { return (const char*)A + (size_t)u.pm * 256 * K * 2; }
    __device__ __forceinline__ const char* bbase(const Unit& u) const { return (const char*)Bt + (size_t)u.pn * 256 * K * 2; }
    __device__ __forceinline__ void aoff(const Unit&, const int (&R)[2], const int (&C)[2], unsigned (&v)[2][2]) const {
#pragma unroll
        for (int h = 0; h < 2; ++h)
#pragma unroll
            for (int i = 0; i < 2; ++i) v[h][i] = (unsigned)((h * HALF + R[i]) * K + C[i]) * 2u;
    }
};
struct MoeSched {
    const bf16* A; const bf16* Bt; int K; int G, c; bool gather;
    const int* lists; int cnt[NE]; int cum[NE + 1];
    __device__ void init(const unsigned* cntw, int G_, int c_) {
        G = G_; c = c_; int a = 0;
#pragma unroll
        for (int e = 0; e < NE; ++e) { cnt[e] = __builtin_amdgcn_readfirstlane((int)__hip_atomic_load(cntw + 64 * e, RLX_AGENT)); cum[e] = a; a += (cnt[e] + 255) >> 8; }
        cum[NE] = a;
    }
    __device__ __forceinline__ bool next(int i, Unit& u) const {
        const int L = i * G + c; if (L >= cum[NE] * 8) return false;
        const int gp = L >> 3; u.pn = L & 7; u.pm = gp; int e = 0;
#pragma unroll
        for (int k = 1; k < NE; ++k) e += (gp >= cum[k]) ? 1 : 0;
        u.e = e; int c_e = 0, b_e = 0;
#pragma unroll
        for (int k = 0; k < NE; ++k) { c_e = (k == e) ? cnt[k] : c_e; b_e = (k == e) ? cum[k] : b_e; }
        const int p = gp - b_e; int nv = c_e - 256 * p; u.nv = nv > 256 ? 256 : nv; return true;
    }
    __device__ __forceinline__ const char* abase(const Unit& u) const { return gather ? (const char*)A : (const char*)A + (size_t)u.pm * 256 * K * 2; }
    __device__ __forceinline__ const char* bbase(const Unit& u) const { return (const char*)Bt + ((size_t)u.e * 2048 + (size_t)u.pn * 256) * K * 2; }
    __device__ __forceinline__ void aoff(const Unit& u, const int (&R)[2], const int (&C)[2], unsigned (&v)[2][2]) const {
        int b_e = 0;
#pragma unroll
        for (int k = 0; k < NE; ++k) b_e = (k == u.e) ? cum[k] : b_e;
        const int p = u.pm - b_e;
#pragma unroll
        for (int h = 0; h < 2; ++h)
#pragma unroll
            for (int i = 0; i < 2; ++i) {
                const int r = h * HALF + R[i];
                if (gather) { int tok = 0; if (r < u.nv) tok = lists[u.e * S + 256 * p + r] >> 1; v[h][i] = (unsigned)(tok * K + C[i]) * 2u; }
                else v[h][i] = (unsigned)(r * K + C[i]) * 2u;
            }
    }
};

template <class Epi, class Sched, bool ALIGN_EPI>
__device__ __forceinline__ void gemm_phase(LAS unsigned char* lds, const int K, const Sched& S_, const Epi& E) {
    int tid_ = threadIdx.x; asm volatile("" : "+v"(tid_));
    const int tid = tid_, wid = __builtin_amdgcn_readfirstlane(tid >> 6), lane = tid & 63, wr = wid >> 2, wc = wid & 3, fr = lane & 15, fq = lane >> 4;
    const int nt = K / BK;
    int Rr[2], Cc[2]; unsigned voffB[2];
#pragma unroll
    for (int i = 0; i < 2; ++i) { int R, C; stage_rc(tid * 16 + i * 8192, R, C); Rr[i] = R; Cc[i] = C; const int Rb = Epi::PERM ? ((R & ~31) + perm32(R & 31)) : R; voffB[i] = (unsigned)(Rb * K + C) * 2u; }
    const size_t kstep = (size_t)(BK * 2);
    const size_t hstep = (size_t)HALF * K * 2;
    const unsigned ldsw = (unsigned)wid * 1024u;
    const int aoff = lds_byte(wr * 64 + fr, fq * 8), boff = lds_byte(wc * 32 + fr, fq * 8);
#define PG8_SA(b, h) (((b) * 2 + (h)) * HTB)
#define PG8_SB(b, h) ((4 + (b) * 2 + (h)) * HTB)
#define PG8_STAGE(bufoff, gbase, voff) do { _Pragma("unroll") for (int _i = 0; _i < 2; ++_i) \
        __builtin_amdgcn_global_load_lds((const unsigned*)((const char*)(gbase) + (voff)[_i]), (LAS unsigned*)(lds + (bufoff) + ldsw + _i * 8192), 16, 0, 0); } while (0)
#define PG8_LDA(dst, b, h) do { _Pragma("unroll") for (int m = 0; m < 4; ++m) _Pragma("unroll") for (int k = 0; k < 2; ++k) dst[m][k] = *(const LAS bf16x8*)(lds + PG8_SA(b, h) + aoff + m * 2048 + k * 1024); } while (0)
#define PG8_LDB(dst, b, h) do { _Pragma("unroll") for (int n = 0; n < 2; ++n) _Pragma("unroll") for (int k = 0; k < 2; ++k) dst[n][k] = *(const LAS bf16x8*)(lds + PG8_SB(b, h) + boff + n * 2048 + k * 1024); } while (0)
#define PG8_MMA(ai, bj, At, Bt) do { __builtin_amdgcn_s_setprio(1); _Pragma("unroll") for (int m = 0; m < 4; ++m) _Pragma("unroll") for (int n = 0; n < 2; ++n) _Pragma("unroll") for (int k = 0; k < 2; ++k) \
        acc[ai][bj][m][n] = __builtin_amdgcn_mfma_f32_16x16x32_bf16(Bt[n][k], At[m][k], acc[ai][bj][m][n], 0, 0, 0); __builtin_amdgcn_s_setprio(0); } while (0)
#define PG8_WAIT_V(n) asm volatile("s_waitcnt vmcnt(" #n ")" ::: "memory")
#define PG8_WAIT_L(n) asm volatile("s_waitcnt lgkmcnt(" #n ")" ::: "memory")
#define PG8_BAR __builtin_amdgcn_s_barrier()
#define PG8_SCHED __builtin_amdgcn_sched_barrier(0)
    Unit cur, nxt; int ui = 0;
    if (!S_.next(0, cur)) return;
    f32x4 acc[2][2][4][2];
#pragma unroll
    for (int a = 0; a < 2; ++a)
#pragma unroll
        for (int b = 0; b < 2; ++b)
#pragma unroll
            for (int m = 0; m < 4; ++m)
#pragma unroll
                for (int n = 0; n < 2; ++n) acc[a][b][m][n] = (f32x4){0.f, 0.f, 0.f, 0.f};
    bf16x8 At[4][2], B0[2][2], B1[2][2];
    const char* cA = S_.abase(cur); const char* cB = S_.bbase(cur);
    unsigned vA[2][2], nvA[2][2]; S_.aoff(cur, Rr, Cc, vA);
    PG8_STAGE(PG8_SB(0, 0), cB, voffB); PG8_STAGE(PG8_SB(0, 1), cB + hstep, voffB); PG8_STAGE(PG8_SA(0, 0), cA, vA[0]); PG8_STAGE(PG8_SA(0, 1), cA, vA[1]);
    if (wr == 1) PG8_BAR;
    PG8_WAIT_V(2); PG8_BAR;
    PG8_STAGE(PG8_SB(1, 0), cB + kstep, voffB); PG8_STAGE(PG8_SA(1, 0), cA + kstep, vA[0]); PG8_STAGE(PG8_SB(1, 1), cB + hstep + kstep, voffB);
    PG8_WAIT_V(6); PG8_BAR;
    for (;;) {
        const bool has_next = S_.next(ui + 1, nxt);
        const char* nA = has_next ? S_.abase(nxt) : cA; const char* nB = has_next ? S_.bbase(nxt) : cB;
        if (has_next) S_.aoff(nxt, Rr, Cc, nvA); else {
#pragma unroll
            for (int h = 0; h < 2; ++h)
#pragma unroll
                for (int i = 0; i < 2; ++i) nvA[h][i] = vA[h][i]; }
        for (int t = 0; t < nt; t += 2) {
            const bool last = (t == nt - 2);
            const char* a1 = cA + (size_t)(t + 1) * kstep;
            const char* a2 = last ? nA : cA + (size_t)(t + 2) * kstep; const char* b2 = last ? nB : cB + (size_t)(t + 2) * kstep;
            const char* a3 = a2 + kstep; const char* b3 = b2 + kstep;
            unsigned wA[2][2];
#pragma unroll
            for (int h = 0; h < 2; ++h)
#pragma unroll
                for (int i = 0; i < 2; ++i) wA[h][i] = last ? nvA[h][i] : vA[h][i];
            PG8_LDB(B0, 0, 0); PG8_LDB(B1, 0, 1); PG8_SCHED; PG8_LDA(At, 0, 0); PG8_STAGE(PG8_SA(1, 1), a1, vA[1]);
            PG8_WAIT_V(8); PG8_WAIT_L(0); PG8_BAR; PG8_MMA(0, 0, At, B0); PG8_MMA(0, 1, At, B1); PG8_BAR; PG8_SCHED;
            PG8_LDA(At, 0, 1); PG8_STAGE(PG8_SB(0, 0), b2, voffB); PG8_STAGE(PG8_SB(0, 1), b2 + hstep, voffB); PG8_STAGE(PG8_SA(0, 0), a2, wA[0]);
            PG8_WAIT_V(8); PG8_WAIT_L(0); PG8_BAR; PG8_MMA(1, 0, At, B0); PG8_MMA(1, 1, At, B1); PG8_BAR; PG8_SCHED;
            PG8_LDB(B0, 1, 0); PG8_LDB(B1, 1, 1); PG8_SCHED; PG8_LDA(At, 1, 0); PG8_STAGE(PG8_SA(0, 1), a2, wA[1]);
            PG8_WAIT_V(8); PG8_WAIT_L(0); PG8_BAR; PG8_MMA(0, 0, At, B0); PG8_MMA(0, 1, At, B1); PG8_BAR; PG8_SCHED;
            PG8_LDA(At, 1, 1); PG8_STAGE(PG8_SB(1, 0), b3, voffB); PG8_STAGE(PG8_SB(1, 1), b3 + hstep, voffB); PG8_STAGE(PG8_SA(1, 0), a3, wA[0]);
            PG8_WAIT_V(8); PG8_WAIT_L(0); PG8_BAR; PG8_MMA(1, 0, At, B0); PG8_MMA(1, 1, At, B1); PG8_BAR; PG8_SCHED;
        }
        if constexpr (ALIGN_EPI) { if (wr == 0) PG8_BAR; }
        E(acc, cur, wr, wc, fr, fq);
        if (!has_next) break;
#pragma unroll
        for (int a = 0; a < 2; ++a)
#pragma unroll
            for (int b = 0; b < 2; ++b)
#pragma unroll
                for (int m = 0; m < 4; ++m)
#pragma unroll
                    for (int n = 0; n < 2; ++n) acc[a][b][m][n] = (f32x4){0.f, 0.f, 0.f, 0.f};
        cur = nxt; cA = nA; cB = nB; ++ui;
#pragma unroll
        for (int h = 0; h < 2; ++h)
#pragma unroll
            for (int i = 0; i < 2; ++i) vA[h][i] = nvA[h][i];
        if constexpr (ALIGN_EPI) { if (wr == 1) PG8_BAR; }
    }
    PG8_WAIT_V(0);
    if constexpr (!ALIGN_EPI) { if (wr == 0) PG8_BAR; }
    PG8_BAR;
#undef PG8_SA
#undef PG8_SB
#undef PG8_STAGE
#undef PG8_LDA
#undef PG8_LDB
#undef PG8_MMA
#undef PG8_WAIT_V
#undef PG8_WAIT_L
#undef PG8_BAR
#undef PG8_SCHED
}

typedef const f32x4 (&AccRef)[2][2][4][2];

struct EpiProj {
    static constexpr bool PERM = true;
    bf16* Q; bf16* GA;
    __device__ __forceinline__ void operator()(AccRef acc, const Unit& u, int wr, int wc, int fr, int fq) const {
        const int row0 = u.pm * BM + wr * 64 + fr;
        if (u.pn < 16) {
            bf16* base = Q + (size_t)(u.pn >> 2) * ((size_t)S * 1024) + (u.pn & 3) * 256 + wc * 32 + 8 * fq;
#pragma unroll
            for (int ai = 0; ai < 2; ++ai)
#pragma unroll
                for (int m = 0; m < 4; ++m) { bf16* rowp = base + (size_t)(row0 + ai * HALF + m * 16) * 1024;
#pragma unroll
                    for (int bj = 0; bj < 2; ++bj) { const f32x4 v0 = acc[ai][bj][m][0], v1 = acc[ai][bj][m][1];
                        u32x4 w; w.x = cvt_pk_bf16(v0[0], v0[1]); w.y = cvt_pk_bf16(v0[2], v0[3]); w.z = cvt_pk_bf16(v1[0], v1[1]); w.w = cvt_pk_bf16(v1[2], v1[3]);
                        *(u32x4*)(rowp + bj * HALF) = w; } }
        } else {
            const int pg = u.pn - 16;
            bf16* base = GA + (size_t)(pg >> 3) * ((size_t)S * 2048) + (pg & 7) * 256 + wc * 32 + 8 * fq;
#pragma unroll
            for (int ai = 0; ai < 2; ++ai)
#pragma unroll
                for (int m = 0; m < 4; ++m) { bf16* rowp = base + (size_t)(row0 + ai * HALF + m * 16) * 2048;
#pragma unroll
                    for (int bj = 0; bj < 2; ++bj) { f32x4 v0 = acc[ai][bj][m][0], v1 = acc[ai][bj][m][1];
#pragma unroll
                        for (int j = 0; j < 4; ++j) { v0[j] = sigmoidf_(v0[j]); v1[j] = sigmoidf_(v1[j]); }
                        u32x4 w; w.x = cvt_pk_bf16(v0[0], v0[1]); w.y = cvt_pk_bf16(v0[2], v0[3]); w.z = cvt_pk_bf16(v1[0], v1[1]); w.w = cvt_pk_bf16(v1[2], v1[3]);
                        *(u32x4*)(rowp + bj * HALF) = w; } }
        }
    }
};
template <int MODE> struct EpiGate {
    static constexpr bool PERM = true;
    const bf16* G; bf16* O; int ld;
    __device__ __forceinline__ void operator()(AccRef acc, const Unit& u, int wr, int wc, int fr, int fq) const {
        const int row0 = u.pm * BM + wr * 64 + fr, col0 = u.pn * BM + wc * 32 + 8 * fq;
#pragma unroll
        for (int ai = 0; ai < 2; ++ai)
#pragma unroll
            for (int m = 0; m < 4; ++m) { const size_t off = (size_t)(row0 + ai * HALF + m * 16) * ld + col0;
#pragma unroll
                for (int bj = 0; bj < 2; ++bj) { const f32x4 v0 = acc[ai][bj][m][0], v1 = acc[ai][bj][m][1];
                    const u32x4 g = *(const u32x4*)(G + off + bj * HALF);
                    float a[8] = {v0[0], v0[1], v0[2], v0[3], v1[0], v1[1], v1[2], v1[3]};
                    const float gg[8] = {bflo(g.x), bfhi(g.x), bflo(g.y), bfhi(g.y), bflo(g.z), bfhi(g.z), bflo(g.w), bfhi(g.w)};
                    if (MODE == 1) {
#pragma unroll
                        for (int j = 0; j < 8; ++j) a[j] = gg[j] * sigmoidf_(a[j]);
                    } else if (MODE == 0) {
#pragma unroll
                        for (int j = 0; j < 8; ++j) a[j] = gg[j] * a[j];
                    } else {
                        const u32x4 o = *(const u32x4*)(O + off + bj * HALF);
                        const float oo[8] = {bflo(o.x), bfhi(o.x), bflo(o.y), bfhi(o.y), bflo(o.z), bfhi(o.z), bflo(o.w), bfhi(o.w)};
#pragma unroll
                        for (int j = 0; j < 8; ++j) a[j] = oo[j] + gg[j] * a[j];
                    }
                    u32x4 w; w.x = cvt_pk_bf16(a[0], a[1]); w.y = cvt_pk_bf16(a[2], a[3]); w.z = cvt_pk_bf16(a[4], a[5]); w.w = cvt_pk_bf16(a[6], a[7]);
                    *(u32x4*)(O + off + bj * HALF) = w; }
                asm volatile("" ::: "memory"); }
    }
};
struct EpiResid {
    static constexpr bool PERM = false;
    const float* xin; float* xout;
    __device__ __forceinline__ void operator()(AccRef acc, const Unit& u, int wr, int wc, int fr, int fq) const {
        const int row0 = u.pm * BM + wr * 64 + fr, col0 = u.pn * BM + wc * 32 + 4 * fq;
#pragma unroll
        for (int ai = 0; ai < 2; ++ai)
#pragma unroll
            for (int m = 0; m < 4; ++m) { const size_t off = (size_t)(row0 + ai * HALF + m * 16) * D + col0;
#pragma unroll
                for (int bj = 0; bj < 2; ++bj)
#pragma unroll
                    for (int n = 0; n < 2; ++n) { const f32x4 xv = *(const f32x4*)(xin + off + bj * HALF + n * 16); *(f32x4*)(xout + off + bj * HALF + n * 16) = xv + acc[ai][bj][m][n]; }
                asm volatile("" ::: "memory"); }
    }
};
struct EpiSwiglu {
    static constexpr bool PERM = true;
    bf16* O; int ld;
    __device__ __forceinline__ void operator()(AccRef acc, const Unit& u, int wr, int wc, int fr, int fq) const {
        const int row0 = u.pm * BM + wr * 64 + fr, col0 = u.pn * HALF + wc * 32 + 8 * fq;
#pragma unroll
        for (int ai = 0; ai < 2; ++ai)
#pragma unroll
            for (int m = 0; m < 4; ++m) { bf16* rowp = O + (size_t)(row0 + ai * HALF + m * 16) * ld + col0;
                float a[8];
#pragma unroll
                for (int n = 0; n < 2; ++n)
#pragma unroll
                    for (int j = 0; j < 4; ++j) { const float g = acc[ai][0][m][n][j], up = acc[ai][1][m][n][j]; a[n * 4 + j] = g * sigmoidf_(g) * up; }
                u32x4 w; w.x = cvt_pk_bf16(a[0], a[1]); w.y = cvt_pk_bf16(a[2], a[3]); w.z = cvt_pk_bf16(a[4], a[5]); w.w = cvt_pk_bf16(a[6], a[7]);
                *(u32x4*)rowp = w; }
    }
};
struct EpiMoeDown {
    static constexpr bool PERM = true;
    bf16* O; const int* lists; const float* gw; int cumv[NE];
    __device__ __forceinline__ void operator()(AccRef acc, const Unit& u, int wr, int wc, int fr, int fq) const {
        int b_e = 0;
#pragma unroll
        for (int k = 0; k < NE; ++k) b_e = (k == u.e) ? cumv[k] : b_e;
        const int p = u.pm - b_e; const int col0 = u.pn * BM + wc * 32 + 8 * fq;
#pragma unroll
        for (int ai = 0; ai < 2; ++ai)
#pragma unroll
            for (int m = 0; m < 4; ++m) { const int r = ai * HALF + wr * 64 + m * 16 + fr;
                if (r < u.nv) { const int slot = lists[u.e * S + 256 * p + r]; const float g = gw[slot]; bf16* rowp = O + (size_t)slot * D + col0;
#pragma unroll
                    for (int bj = 0; bj < 2; ++bj) { const f32x4 v0 = acc[ai][bj][m][0] * g, v1 = acc[ai][bj][m][1] * g;
                        u32x4 w; w.x = cvt_pk_bf16(v0[0], v0[1]); w.y = cvt_pk_bf16(v0[2], v0[3]); w.z = cvt_pk_bf16(v1[0], v1[1]); w.w = cvt_pk_bf16(v1[2], v1[3]);
                        *(u32x4*)(rowp + bj * HALF) = w; } } }
    }
};
}

struct Args { const float* in[24]; float* out; unsigned char* ws; int ph_lo, ph_hi; };
struct Frame {
    LAS unsigned char* lds;
    gu32* ctl;
    unsigned char* ws;
    int tid, lane, wave, vcu, G, bid;
    const struct Args __attribute__((address_space(4)))* ka;
};

__device__ __forceinline__ void transpose_item(const float* W, int K, int N, bf16* WT, int k0, int n0, int drow0, LAS float* scr, int lane) {
#pragma unroll 8
    for (int i = 0; i < 32; ++i) { const int kk = 2 * i + (lane >> 5); scr[kk * 33 + (lane & 31)] = W[(size_t)(k0 + kk) * N + n0 + (lane & 31)]; }
    LDS_WAIT(); asm volatile("" ::: "memory");
    const int c = lane & 7;
#pragma unroll
    for (int j = 0; j < 4; ++j) { const int n = (lane >> 3) + 8 * j; const LAS float* s = scr + (8 * c) * 33 + n;
        u32x4 o; o.x = pk2(s[0 * 33], s[1 * 33]); o.y = pk2(s[2 * 33], s[3 * 33]); o.z = pk2(s[4 * 33], s[5 * 33]); o.w = pk2(s[6 * 33], s[7 * 33]);
        *(GAS u32x4*)(WT + (size_t)(drow0 + n) * K + k0 + 8 * c) = o; }
    LDS_WAIT(); asm volatile("" ::: "memory");
}
__device__ __forceinline__ void transpose_mat(Frame& F, const float* W, int K, int N, bf16* WT, int il  , int item, LAS float* scr) {
    const int nblk = N / 32, kb = item / nblk, nb = item % nblk, k0 = 64 * kb, n0 = 32 * nb;
    const int drow0 = il ? ((n0 >> 7) * 256 + (n0 & 127) + (il == 2 ? 128 : 0)) : n0;
    transpose_item(W, K, N, WT, k0, n0, drow0, scr, F.lane);
}
__device__ __forceinline__ void rms_row_to_bf16(Frame& F, const float* xrow, const float* g, bf16* orow) {
    const GAS f32x4* xr = (const GAS f32x4*)xrow + F.lane; const GAS f32x4* gr = (const GAS f32x4*)g + F.lane;
    f32x4 v[8]; float s = 0.f;
#pragma unroll
    for (int j = 0; j < 8; ++j) { v[j] = xr[64 * j]; s += (v[j].x * v[j].x + v[j].y * v[j].y) + (v[j].z * v[j].z + v[j].w * v[j].w); }
    const float rstd = 1.0f / sqrtf(wave_sum(s) * (1.f / D) + RMS_EPS);
    GAS unsigned long long* o8 = (GAS unsigned long long*)orow + F.lane;
#pragma unroll
    for (int j = 0; j < 8; ++j) { const f32x4 gg = gr[64 * j]; o8[64 * j] = (unsigned long long)pk2(v[j].x * rstd * gg.x, v[j].y * rstd * gg.y) | ((unsigned long long)pk2(v[j].z * rstd * gg.z, v[j].w * rstd * gg.w) << 32); }
}

__device__ __forceinline__ void cis_d(double th, float& c, float& s) {
    const double TWO_PI = 6.283185307179586476925286766559;
    const double k = rint(th / TWO_PI); const float r = (float)(th - k * TWO_PI);
    c = cosf(r); s = sinf(r);
}
__device__ __forceinline__ void ssm_tables_group(Frame& F, int g, const float* a_re, const float* a_im, const float* log_dt, const float* b_re, const float* b_im,
                                                 const float* c_re, const float* c_im) {
    const int n = F.lane;
    const double dt = exp((double)log_dt[g]); const double ar = (double)a_re[g * SN + n], ai = (double)a_im[g * SN + n];
    float cr, sr; cis_d(dt * ai, cr, sr); const float mag = (float)exp(dt * ar);
    const float abr = mag * cr, abi = mag * sr;
    float cl, sl; cis_d(dt * ai * (double)CH, cl, sl); const float magl = (float)exp(dt * ar * (double)CH);
    float* abar = (float*)(F.ws + WS_SSMT + ST_ABAR); float* abarl = (float*)(F.ws + WS_SSMT + ST_ABARL);
    abar[(g * SN + n) * 2] = abr; abar[(g * SN + n) * 2 + 1] = abi; abarl[(g * SN + n) * 2] = magl * cl; abarl[(g * SN + n) * 2 + 1] = magl * sl;
    const float arf = (float)ar, aif = (float)ai; const float den = arf * arf + aif * aif; const float nre = abr - 1.0f;
    const float zre = (nre * arf + abi * aif) / den, zim = (abi * arf - nre * aif) / den;
    bf16* bbf = (bf16*)(F.ws + WS_SSMT + ST_BBF);
#pragma unroll
    for (int q = 0; q < SP; ++q) {
        const float br = b_re[(g * SN + n) * SP + q], bi = b_im[(g * SN + n) * SP + q];
        const float re = zre * br - zim * bi, im = zre * bi + zim * br;
        const int l = (n & 31) + 32 * (q >> 3), j = q & 7;
        bbf[((size_t)(g * 4 + (n >> 5)) * 64 + l) * 8 + j] = (bf16)f2bf(re);
        bbf[((size_t)(g * 4 + 2 + (n >> 5)) * 64 + l) * 8 + j] = (bf16)f2bf(im);
    }
    bf16* ctf = (bf16*)(F.ws + WS_SSMT + ST_CTF);
    for (int kk = 0; kk < 4; ++kk)
#pragma unroll
        for (int j = 0; j < 8; ++j) { const int l = F.lane, kp = 32 * kk + 8 * (l >> 4) + j, st = kp >> 1, p = l & 15;
            const float v = (kp & 1) ? -c_im[(g * SP + p) * SN + st] : c_re[(g * SP + p) * SN + st];
            ctf[((size_t)(g * 4 + kk) * 64 + l) * 8 + j] = (bf16)f2bf(v); }
}

constexpr int XROWB = 272;
template <bool READOUT>
__device__ __forceinline__ void ssm_run(Frame& F, int g, int c0, const bf16* U, bf16* Y, const float* dskip, LAS unsigned char* xl) {
    const int lane = F.lane, ci = lane & 31, hh = lane >> 5;
    const float* abar = (const float*)(F.ws + WS_SSMT + ST_ABAR); const float* abarl = (const float*)(F.ws + WS_SSMT + ST_ABARL);
    float* XE = (float*)(F.ws + WS_XE) + (size_t)g * NCH * 128;
    float ar[2], ai[2], lr[2], li[2];
#pragma unroll
    for (int s = 0; s < 2; ++s) { const int n = ci + 32 * s; ar[s] = abar[(g * SN + n) * 2]; ai[s] = abar[(g * SN + n) * 2 + 1]; lr[s] = abarl[(g * SN + n) * 2]; li[s] = abarl[(g * SN + n) * 2 + 1]; }
    bf16x8 bfr[4], ctf[4];
#pragma unroll
    for (int nt = 0; nt < 4; ++nt) bfr[nt] = *(const bf16x8*)((const bf16*)(F.ws + WS_SSMT + ST_BBF) + ((size_t)(g * 4 + nt) * 64 + lane) * 8);
    float dsk = 0.f;
    if (READOUT) {
#pragma unroll
        for (int kk = 0; kk < 4; ++kk) ctf[kk] = *(const bf16x8*)((const bf16*)(F.ws + WS_SSMT + ST_CTF) + ((size_t)(g * 4 + kk) * 64 + lane) * 8);
        dsk = dskip[g * SP + (lane & 15)];
    }
    float xr[2] = {0.f, 0.f}, xi[2] = {0.f, 0.f};
    if (READOUT) {
        const int cm = c0 + hh;
        for (int cc = 0; cc < cm; ++cc) {
#pragma unroll
            for (int s = 0; s < 2; ++s) { const float er = XE[cc * 128 + ci + 32 * s], ei = XE[cc * 128 + 64 + ci + 32 * s];
                const float nr = lr[s] * xr[s] - li[s] * xi[s] + er, ni = lr[s] * xi[s] + li[s] * xr[s] + ei; xr[s] = nr; xi[s] = ni; }
        }
    }
    for (int u = 0; u < 4; ++u) {
        const int cA = c0 + 2 * u, cm = cA + hh;
        if (!READOUT) { xr[0] = xr[1] = xi[0] = xi[1] = 0.f; }
        else if (u > 0) {
#pragma unroll
            for (int s = 0; s < 2; ++s) { const float er = XE[(cm - 1) * 128 + ci + 32 * s], ei = XE[(cm - 1) * 128 + 64 + ci + 32 * s];
                const float nr = lr[s] * xr[s] - li[s] * xi[s] + er, ni = lr[s] * xi[s] + li[s] * xr[s] + ei; xr[s] = nr; xi[s] = ni; }
        }
        for (int k = 0; k < 4; ++k) {
            const int seg = (ci >> 2) & 1, tok = 16 * k + 4 * (ci >> 3) + (ci & 3);
            const bf16x8 af = *(const bf16x8*)(U + (size_t)((cA + seg) * CH + tok) * SSMW + g * SP + 8 * hh);
            f32x16 bu[4];
#pragma unroll
            for (int nt = 0; nt < 4; ++nt) { f32x16 z;
#pragma unroll
                for (int r = 0; r < 16; ++r) z[r] = 0.f;
                bu[nt] = __builtin_amdgcn_mfma_f32_32x32x16_bf16(af, bfr[nt], z, 0, 0, 0); }
#pragma unroll
            for (int r = 0; r < 16; ++r) {
#pragma unroll
                for (int s = 0; s < 2; ++s) {
                    const float nr = ar[s] * xr[s] - ai[s] * xi[s] + bu[s][r], ni = ar[s] * xi[s] + ai[s] * xr[s] + bu[2 + s][r]; xr[s] = nr; xi[s] = ni;
                    if (READOUT) *(LAS unsigned*)(xl + (hh * 16 + r) * XROWB + (ci + 32 * s) * 4) = cvt_pk_bf16(nr, ni);
                }
            }
            if (READOUT) {
                LDS_WAIT();
#pragma unroll
                for (int sg = 0; sg < 2; ++sg) {
                    f32x4 y = (f32x4){0.f, 0.f, 0.f, 0.f};
#pragma unroll
                    for (int kk = 0; kk < 4; ++kk) { const bf16x8 xa = *(const LAS bf16x8*)(xl + (sg * 16 + (lane & 15)) * XROWB + (32 * kk + 8 * (lane >> 4)) * 2);
                        y = __builtin_amdgcn_mfma_f32_16x16x32_bf16(xa, ctf[kk], y, 0, 0, 0); }
#pragma unroll
                    for (int r = 0; r < 4; ++r) { const size_t idx = (size_t)((cA + sg) * CH + 16 * k + 4 * (lane >> 4) + r) * SSMW + g * SP + (lane & 15);
                        const float v = y[r] + dsk * bf2f(U[idx]);
                        const float t = tanhf(0.7978845608028654f * (v + 0.044715f * v * v * v));
                        Y[idx] = (bf16)f2bf(0.5f * v * (1.0f + t)); }
                }
                LDS_WAIT();
            }
        }
        if (!READOUT) {
#pragma unroll
            for (int s = 0; s < 2; ++s) { XE[cm * 128 + ci + 32 * s] = xr[s]; XE[cm * 128 + 64 + ci + 32 * s] = xi[s]; }
        }
    }
}

__device__ __forceinline__ void attn_item(Frame& F, int h, int t, const bf16* Q, const bf16* K, const bf16* V, bf16* O, LAS float* qs) {
    const int lane = F.lane;
    { const unsigned qw = *(const unsigned*)(Q + (size_t)t * SBW + h * HD + 2 * lane); const float sc = 0.08838834764831845f;
      qs[2 * lane] = bflo(qw) * sc; qs[2 * lane + 1] = bfhi(qw) * sc; }
    LDS_WAIT();
    float o0 = 0.f, o1 = 0.f, carry = 0.f;
    for (int kb = t - 1; kb >= 0; kb -= 64) {
        const int s = kb - lane; const bool valid = s >= 0; const int sc = valid ? s : 0;
        const bf16* krow = K + (size_t)sc * SBW + h * HD;
        float dot = 0.f;
#pragma unroll
        for (int c = 0; c < 16; ++c) { const u32x4 kv = *(const u32x4*)(krow + 8 * c); const f32x4 qa = *(const LAS f32x4*)(qs + 8 * c), qb = *(const LAS f32x4*)(qs + 8 * c + 4);
            dot += bflo(kv.x) * qa.x + bfhi(kv.x) * qa.y + bflo(kv.y) * qa.z + bfhi(kv.y) * qa.w + bflo(kv.z) * qb.x + bfhi(kv.z) * qb.y + bflo(kv.w) * qb.z + bfhi(kv.w) * qb.w; }
        const float z = dot;
        float sp = valid ? (fmaxf(z, 0.f) + __logf(1.0f + __expf(-fabsf(z)))) : 0.f;
        float incl = sp;
#pragma unroll
        for (int o = 1; o < 64; o <<= 1) { const float v = __shfl_up(incl, o); if (lane >= o) incl += v; }
        const float w = valid ? __expf(z - (carry + incl)) : 0.f;
        const float total = __shfl(incl, 63);
        const int nk = (kb + 1) < 64 ? (kb + 1) : 64;
        const bf16* vbase = V + (size_t)kb * SBW + h * HD + 2 * lane;
        for (int kk = 0; kk < nk; ++kk) { const float wk = __builtin_bit_cast(float, __builtin_amdgcn_readlane(__builtin_bit_cast(int, w), kk));
            const unsigned vw = *(const unsigned*)(vbase - (size_t)kk * SBW); o0 += wk * bflo(vw); o1 += wk * bfhi(vw); }
        carry += total;
        if (carry > SB_THRESH) break;
    }
    *(unsigned*)(O + (size_t)t * SBW + h * HD + 2 * lane) = cvt_pk_bf16(o0, o1);
    LDS_WAIT();
}

constexpr int NPHASE = 21;

__device__ __forceinline__ Frame mk_frame() {
    Frame F; int t_ = threadIdx.x; asm volatile("" : "+v"(t_)); int b_ = blockIdx.x; asm volatile("" : "+s"(b_));
    const Args __attribute__((address_space(4)))* ka = (const Args __attribute__((address_space(4)))*)__builtin_amdgcn_kernarg_segment_ptr(); asm volatile("" : "+s"(ka));
    extern __shared__ __attribute__((aligned(16))) unsigned char lds[];
    F.ka = ka; unsigned char* w_ = ka->ws;
    F.lds = (LAS unsigned char*)lds; F.ws = w_; F.ctl = (gu32*)(w_ + WS_CTL);
    F.tid = t_; F.lane = t_ & 63; F.wave = __builtin_amdgcn_readfirstlane(t_ >> 6);
    F.G = gridDim.x; F.vcu = (F.G % 8 == 0) ? (b_ % 8) * (F.G / 8) + b_ / 8 : b_; F.bid = b_;
    return F;
}
#define WSP(off) ((bf16*)(F.ws + (off)))

#if MK_ONE_LAUNCH
#define GRID_BAR() xcd_barrier(bar)
#else
#define GRID_BAR() do { } while (0)
#endif
#ifndef PHMASK
#define PHMASK 0x7FF
#endif
#define IN(k) (lo <= (k) && (k) < hi)
#define SEAM(k) do { if (IN(k) && IN((k) + 1)) GRID_BAR(); } while (0)
template <int l> __device__ __forceinline__ void layer_phases(const int lo, const int hi, const XcdBarrier& bar) {
    constexpr int pb = l * 10;
        if (((PHMASK >> 0) & 1) && IN(pb + 0)) {
            Frame F = mk_frame(); const int gw = F.vcu * NWAVES + F.wave, NGW = F.G * NWAVES; LAS float* scr = (LAS float*)(F.lds + F.wave * 16384);
            float* xres = F.ka->out; const float* xin = (l == 0) ? F.ka->in[0] : xres;
            bf16* Win_t = WSP(WS_W + W_IN); bf16* Wglu_t = WSP(WS_W + W_GLU); bf16* Pa_t = WSP(WS_W + W_PA); bf16* Ps_t = WSP(WS_W + W_PS);
            bf16* Wout_t = WSP(WS_W + W_OUT); bf16* Wgu_t = WSP(WS_W + W_GU); bf16* Wdn_t = WSP(WS_W + W_DN_DENSE); bf16* Wdnm_t = WSP(WS_W + W_DN_MOE);
            const float* w_in = F.ka->in[4] + (size_t)l * D * INC; const float* w_glu = F.ka->in[13] + (size_t)l * SSMW * SSMW;
            const float* p_attn = F.ka->in[14] + (size_t)l * SBW * D; const float* p_ssm = F.ka->in[15] + (size_t)l * SSMW * D; const float* w_out = F.ka->in[16] + (size_t)l * D * D;
            constexpr int I_IN = (D / 64) * (INC / 32), I_GLU = (SSMW / 64) * (SSMW / 32), I_PA = (SBW / 64) * (D / 32), I_OUT = (D / 64) * (D / 32);
            constexpr int I_FG = (D / 64) * (FFD / 32), I_FD = (FFD / 64) * (D / 32);
            constexpr int I_MG = (D / 64) * (FFE / 32), I_MD = (FFE / 64) * (D / 32);
            const int n_ffn = (l == 0) ? (2 * I_FG + I_FD) : NE * (2 * I_MG + I_MD);
            const int NITEMS = I_IN + I_GLU + 2 * I_PA + I_OUT + n_ffn;
            for (int it = gw; it < NITEMS; it += NGW) {
                int r = it;
                if (r < I_IN) { transpose_mat(F, w_in, D, INC, Win_t, 0, r, scr); continue; } r -= I_IN;
                if (r < I_GLU) { transpose_mat(F, w_glu, SSMW, SSMW, Wglu_t, 0, r, scr); continue; } r -= I_GLU;
                if (r < I_PA) { transpose_mat(F, p_attn, SBW, D, Pa_t, 0, r, scr); continue; } r -= I_PA;
                if (r < I_PA) { transpose_mat(F, p_ssm, SSMW, D, Ps_t, 0, r, scr); continue; } r -= I_PA;
                if (r < I_OUT) { transpose_mat(F, w_out, D, D, Wout_t, 0, r, scr); continue; } r -= I_OUT;
                if (l == 0) {
                    if (r < I_FG) { transpose_mat(F, F.ka->in[17], D, FFD, Wgu_t, 1, r, scr); continue; } r -= I_FG;
                    if (r < I_FG) { transpose_mat(F, F.ka->in[18], D, FFD, Wgu_t, 2, r, scr); continue; } r -= I_FG;
                    transpose_mat(F, F.ka->in[19], FFD, D, Wdn_t, 0, r, scr);
                } else {
                    const int per = 2 * I_MG + I_MD, e = r / per; r -= e * per;
                    if (r < I_MG) { transpose_mat(F, F.ka->in[21] + (size_t)e * D * FFE, D, FFE, Wgu_t + (size_t)e * 2048 * D, 1, r, scr); continue; } r -= I_MG;
                    if (r < I_MG) { transpose_mat(F, F.ka->in[22] + (size_t)e * D * FFE, D, FFE, Wgu_t + (size_t)e * 2048 * D, 2, r, scr); continue; } r -= I_MG;
                    transpose_mat(F, F.ka->in[23] + (size_t)e * FFE * D, FFE, D, Wdnm_t + (size_t)e * 2048 * FFE, 0, r, scr);
                }
            }
            if (gw < SG) ssm_tables_group(F, gw, F.ka->in[5] + l * SG * SN, F.ka->in[6] + l * SG * SN, F.ka->in[7] + l * SG, F.ka->in[8] + (size_t)l * SG * SN * SP, F.ka->in[9] + (size_t)l * SG * SN * SP,
                                          F.ka->in[10] + (size_t)l * SG * SP * SN, F.ka->in[11] + (size_t)l * SG * SP * SN);
            const float* gnorm = F.ka->in[1] + l * D; bf16* XN = WSP(WS_XN);
            for (int m = gw; m < S; m += NGW) rms_row_to_bf16(F, xin + (size_t)m * D, gnorm, XN + (size_t)m * D);
        }
        SEAM(pb + 0);
        if (((PHMASK >> 1) & 1) && IN(pb + 1)) {
            Frame F = mk_frame();
            pg8::DenseSched Sd; Sd.so.init(S, INC, F.G, F.bid); Sd.A = WSP(WS_XN); Sd.Bt = WSP(WS_W + W_IN); Sd.K = D;
            pg8::EpiProj E{WSP(WS_Q), WSP(WS_GA)};
            pg8::gemm_phase<pg8::EpiProj, pg8::DenseSched, true>(F.lds, D, Sd, E);
        }
        SEAM(pb + 1);
        if (((PHMASK >> 2) & 1) && IN(pb + 2)) {
            Frame F = mk_frame(); const int gw = F.vcu * NWAVES + F.wave, NGW = F.G * NWAVES;
            bf16* Qb = WSP(WS_Q); bf16* Kb = Qb + (size_t)S * 1024; bf16* Vb = Kb + (size_t)S * 1024; bf16* Ub = Vb + (size_t)S * 1024;
            { const int g = gw >> 5, c0 = (gw & 31) * 8; if (gw < SG * 32) ssm_run<false>(F, g, c0, Ub, WSP(WS_Y), nullptr, F.lds + F.wave * 16384); }
            LAS float* qs = (LAS float*)(F.lds + F.wave * 16384); bf16* OATT = WSP(WS_OATT);
            for (int it = gw; it < NH * S; it += NGW) { const int h = it & 7, t = it >> 3; attn_item(F, h, t, Qb, Kb, Vb, OATT, qs); }
        }
        SEAM(pb + 2);
        if (((PHMASK >> 3) & 1) && IN(pb + 3)) {
            Frame F = mk_frame(); const int gw = F.vcu * NWAVES + F.wave;
            const int g = gw >> 5, c0 = (gw & 31) * 8; if (gw < SG * 32) ssm_run<true>(F, g, c0, WSP(WS_Q) + (size_t)3 * S * 1024, WSP(WS_Y), F.ka->in[12] + l * SG * SP, F.lds + F.wave * 16384);
        }
        SEAM(pb + 3);
        if (((PHMASK >> 4) & 1) && IN(pb + 4)) {
#ifndef DBG_P4
#define DBG_P4 3
#endif
            if (DBG_P4 & 1) { Frame F = mk_frame();
              pg8::DenseSched Sd; Sd.so.init(S, D, F.G, F.bid); Sd.A = WSP(WS_OATT); Sd.Bt = WSP(WS_W + W_PA); Sd.K = SBW;
              pg8::EpiGate<0> E{WSP(WS_GA), WSP(WS_GA), D};
              pg8::gemm_phase<pg8::EpiGate<0>, pg8::DenseSched, true>(F.lds, SBW, Sd, E); }
            if (DBG_P4 & 2) { Frame F = mk_frame();
              pg8::DenseSched Sd; Sd.so.init(S, SSMW, F.G, F.bid); Sd.A = WSP(WS_Y); Sd.Bt = WSP(WS_W + W_GLU); Sd.K = SSMW;
              pg8::EpiGate<1> E{WSP(WS_Y), WSP(WS_OSSM), SSMW};
              pg8::gemm_phase<pg8::EpiGate<1>, pg8::DenseSched, true>(F.lds, SSMW, Sd, E); }
        }
        SEAM(pb + 4);
        if (((PHMASK >> 5) & 1) && IN(pb + 5)) {
            Frame F = mk_frame();
            pg8::DenseSched Sd; Sd.so.init(S, D, F.G, F.bid); Sd.A = WSP(WS_OSSM); Sd.Bt = WSP(WS_W + W_PS); Sd.K = SSMW;
            pg8::EpiGate<2> E{WSP(WS_GB), WSP(WS_GA), D};
            pg8::gemm_phase<pg8::EpiGate<2>, pg8::DenseSched, true>(F.lds, SSMW, Sd, E);
        }
        SEAM(pb + 5);
        if (((PHMASK >> 6) & 1) && IN(pb + 6)) {
            Frame F = mk_frame();
            pg8::DenseSched Sd; Sd.so.init(S, D, F.G, F.bid); Sd.A = WSP(WS_GA); Sd.Bt = WSP(WS_W + W_OUT); Sd.K = D;
            float* xres = F.ka->out; const float* xin = (l == 0) ? F.ka->in[0] : xres;
            pg8::EpiResid E{xin, xres};
            pg8::gemm_phase<pg8::EpiResid, pg8::DenseSched, true>(F.lds, D, Sd, E);
        }
        SEAM(pb + 6);
        if (((PHMASK >> 7) & 1) && IN(pb + 7)) {
            Frame F = mk_frame(); const int gw = F.vcu * NWAVES + F.wave, NGW = F.G * NWAVES;
            const float* gnorm = F.ka->in[2] + l * D; bf16* XN = WSP(WS_XN); float* xres = F.ka->out;
            if (l == 0) { for (int m = gw; m < S; m += NGW) rms_row_to_bf16(F, xres + (size_t)m * D, gnorm, XN + (size_t)m * D); }
            else {
                const float* wrt = F.ka->in[20]; int* lists = (int*)(F.ws + WS_MOE); float* gatew = (float*)(F.ws + WS_MOE + (size_t)NE * S * 4);
                for (int m = gw; m < S; m += NGW) {
                    const GAS f32x4* xr = (const GAS f32x4*)(xres + (size_t)m * D) + F.lane; const GAS f32x4* gr = (const GAS f32x4*)gnorm + F.lane;
                    f32x4 v[8]; float s = 0.f; float lg[NE];
#pragma unroll
                    for (int e = 0; e < NE; ++e) lg[e] = 0.f;
                    const char* wbase = (const char*)wrt + (size_t)F.lane * (4 * NE * 4);
#pragma unroll
                    for (int j = 0; j < 8; ++j) { v[j] = xr[64 * j]; s += (v[j].x * v[j].x + v[j].y * v[j].y) + (v[j].z * v[j].z + v[j].w * v[j].w);
                        const f32x4 xg = v[j] * gr[64 * j];
                        const char* wb = wbase + (size_t)j * (256 * NE * 4); asm volatile("" : "+v"(wb) :: "memory");
                        const GAS f32x4* wp = (const GAS f32x4*)wb;
#pragma unroll
                        for (int q = 0; q < 4; ++q) { const f32x4 w0 = wp[2 * q], w1 = wp[2 * q + 1]; const float hq = xg[q];
                            lg[0] += hq * w0.x; lg[1] += hq * w0.y; lg[2] += hq * w0.z; lg[3] += hq * w0.w; lg[4] += hq * w1.x; lg[5] += hq * w1.y; lg[6] += hq * w1.z; lg[7] += hq * w1.w; } }
                    const float rstd = 1.0f / sqrtf(wave_sum(s) * (1.f / D) + RMS_EPS);
                    GAS unsigned long long* o8 = (GAS unsigned long long*)(XN + (size_t)m * D) + F.lane;
#pragma unroll
                    for (int j = 0; j < 8; ++j) { const f32x4 gg = gr[64 * j]; const f32x4 hv = v[j] * rstd * gg;
                        o8[64 * j] = (unsigned long long)pk2(hv.x, hv.y) | ((unsigned long long)pk2(hv.z, hv.w) << 32); }
#pragma unroll
                    for (int e = 0; e < NE; ++e) lg[e] = wave_sum(lg[e]) * rstd;
                    int i1 = 0; float v1 = lg[0];
#pragma unroll
                    for (int e = 1; e < NE; ++e) if (lg[e] > v1) { v1 = lg[e]; i1 = e; }
                    int i2 = (i1 == 0) ? 1 : 0; float v2 = -3.0e38f;
#pragma unroll
                    for (int e = 0; e < NE; ++e) if (e != i1 && lg[e] > v2) { v2 = lg[e]; i2 = e; }
                    if (F.lane == 0) {
                        const float e2 = __expf(v2 - v1); const float g1 = 1.0f / (1.0f + e2), g2 = e2 / (1.0f + e2);
                        const unsigned p1 = __hip_atomic_fetch_add((unsigned*)(F.ctl + CW_MOECNT + 64 * i1), 1u, RLX_AGENT);
                        const unsigned p2 = __hip_atomic_fetch_add((unsigned*)(F.ctl + CW_MOECNT + 64 * i2), 1u, RLX_AGENT);
                        lists[i1 * S + (int)p1] = 2 * m; lists[i2 * S + (int)p2] = 2 * m + 1; gatew[2 * m] = g1; gatew[2 * m + 1] = g2;
                    }
                }
            }
        }
        SEAM(pb + 7);
        if (l == 0) {
            if (((PHMASK >> 8) & 1) && IN(pb + 8)) {
                Frame F = mk_frame();
                pg8::DenseSched Sd; Sd.so.init(S, 2 * FFD, F.G, F.bid); Sd.A = WSP(WS_XN); Sd.Bt = WSP(WS_W + W_GU); Sd.K = D;
                pg8::EpiSwiglu E{WSP(WS_ACT), FFD};
                pg8::gemm_phase<pg8::EpiSwiglu, pg8::DenseSched, true>(F.lds, D, Sd, E);
            }
            SEAM(pb + 8);
            if (((PHMASK >> 9) & 1) && IN(pb + 9)) {
                Frame F = mk_frame();
                pg8::DenseSched Sd; Sd.so.init(S, D, F.G, F.bid); Sd.A = WSP(WS_ACT); Sd.Bt = WSP(WS_W + W_DN_DENSE); Sd.K = FFD;
                float* xres = F.ka->out;
                pg8::EpiResid E{xres, xres};
                pg8::gemm_phase<pg8::EpiResid, pg8::DenseSched, true>(F.lds, FFD, Sd, E);
            }
            SEAM(pb + 9);
        } else {
            if (((PHMASK >> 8) & 1) && IN(pb + 8)) {
                Frame F = mk_frame(); const int* lists = (const int*)(F.ws + WS_MOE);
                pg8::MoeSched Sm; Sm.A = WSP(WS_XN); Sm.Bt = WSP(WS_W + W_GU); Sm.K = D; Sm.gather = true; Sm.lists = lists; Sm.init((const unsigned*)(F.ctl + CW_MOECNT), F.G, F.bid);
                pg8::EpiSwiglu E{WSP(WS_ACT), FFE};
                pg8::gemm_phase<pg8::EpiSwiglu, pg8::MoeSched, true>(F.lds, D, Sm, E);
            }
            SEAM(pb + 8);
            if (((PHMASK >> 9) & 1) && IN(pb + 9)) {
                Frame F = mk_frame(); const int* lists = (const int*)(F.ws + WS_MOE); const float* gatew = (const float*)(F.ws + WS_MOE + (size_t)NE * S * 4);
                pg8::MoeSched Sm; Sm.A = WSP(WS_ACT); Sm.Bt = WSP(WS_W + W_DN_MOE); Sm.K = FFE; Sm.gather = false; Sm.lists = lists; Sm.init((const unsigned*)(F.ctl + CW_MOECNT), F.G, F.bid);
                pg8::EpiMoeDown E; E.O = WSP(WS_MOEY); E.lists = lists; E.gw = gatew;
#pragma unroll
                for (int e = 0; e < NE; ++e) E.cumv[e] = Sm.cum[e];
                pg8::gemm_phase<pg8::EpiMoeDown, pg8::MoeSched, true>(F.lds, FFE, Sm, E);
            }
            SEAM(pb + 9);
        }
}

__global__ void __launch_bounds__(NTHR, 2) trunk_fwd(Args args) {
    extern __shared__ __attribute__((aligned(16))) unsigned char lds[];
    {
        LAS unsigned char* l0 = (LAS unsigned char*)lds;
        for (int u = threadIdx.x; u < (LDS_BYTES - LDSCTL_OFF) / 4; u += NTHR) ((LAS unsigned*)(l0 + LDSCTL_OFF))[u] = 0u;
        __syncthreads();
    }
#if MK_ONE_LAUNCH
    XcdBarrier bar = xcd_barrier_post((unsigned*)(args.ws + WS_CTL) + CW_BAR, (volatile LAS unsigned*)((LAS unsigned char*)lds + MISC_OFF) + 8);
#else
    XcdBarrier bar; bar.bar = nullptr; bar.x = 0; bar.st = nullptr;
#endif
    const int lo = args.ph_lo, hi = args.ph_hi;
    layer_phases<0>(lo, hi, bar);
    layer_phases<1>(lo, hi, bar);

    if (((PHMASK >> 10) & 1) && IN(20)) {
        Frame F = mk_frame(); const int gw = F.vcu * NWAVES + F.wave, NGW = F.G * NWAVES;
        const float* gnorm = F.ka->in[3]; const bf16* MOEY = WSP(WS_MOEY); float* xres = F.ka->out;
        for (int m = gw; m < S; m += NGW) {
            GAS f32x4* xr = (GAS f32x4*)(xres + (size_t)m * D) + F.lane; const GAS f32x4* gr = (const GAS f32x4*)gnorm + F.lane;
            const GAS u32x2* y0 = (const GAS u32x2*)(MOEY + (size_t)(2 * m) * D) + F.lane; const GAS u32x2* y1 = (const GAS u32x2*)(MOEY + (size_t)(2 * m + 1) * D) + F.lane;
            f32x4 v[8]; float s = 0.f;
#pragma unroll
            for (int j = 0; j < 8; ++j) { v[j] = xr[64 * j]; const u32x2 a = y0[64 * j], b = y1[64 * j];
                v[j].x += bflo(a.x) + bflo(b.x); v[j].y += bfhi(a.x) + bfhi(b.x); v[j].z += bflo(a.y) + bflo(b.y); v[j].w += bfhi(a.y) + bfhi(b.y);
                s += (v[j].x * v[j].x + v[j].y * v[j].y) + (v[j].z * v[j].z + v[j].w * v[j].w); }
            const float rstd = 1.0f / sqrtf(wave_sum(s) * (1.f / D) + RMS_EPS);
#pragma unroll
            for (int j = 0; j < 8; ++j) { const f32x4 gg = gr[64 * j]; xr[64 * j] = v[j] * rstd * gg; }
        }
    }
#undef IN
#undef SEAM
}


#ifdef DBG_LAST
__global__ void dbg_dump(const unsigned short* buf, float* out, int ld, int f32src) {
    for (size_t i = (size_t)blockIdx.x * blockDim.x + threadIdx.x; i < (size_t)S * D; i += (size_t)gridDim.x * blockDim.x) {
        const size_t r = i / D, c = i % D;
        if (f32src) out[i] = ((const float*)buf)[r * ld + (c % ld)];
        else out[i] = __builtin_bit_cast(float, ((unsigned)buf[r * ld + (c % ld)]) << 16);
    }
}
#endif
extern "C" void kernel_launch(void* const* d_in, const int* in_sizes, int n_in, void* d_out, int out_size, void* d_ws, size_t ws_size, hipStream_t stream) {
    static int grid = 0;
    if (grid == 0) {
        if (n_in != 24 || out_size != S * D || ws_size < WS_END) { fprintf(stderr, "kernel_launch: unexpected problem (n_in %d, out %d, ws %zu); nothing launched\n", n_in, out_size, ws_size); grid = -1; return; }
        int dev = 0, cus = 0, per_cu = 0;
        if (hipGetDevice(&dev) != hipSuccess || hipDeviceGetAttribute(&cus, hipDeviceAttributeMultiprocessorCount, dev) != hipSuccess) { grid = -1; return; }
        if (hipFuncSetAttribute((const void*)trunk_fwd, hipFuncAttributeMaxDynamicSharedMemorySize, LDS_BYTES) != hipSuccess) { fprintf(stderr, "kernel_launch: hipFuncSetAttribute failed\n"); grid = -1; return; }
        if (hipOccupancyMaxActiveBlocksPerMultiprocessor(&per_cu, (const void*)trunk_fwd, NTHR, LDS_BYTES) != hipSuccess || per_cu < 1)
            fprintf(stderr, "kernel_launch: note: occupancy query reports %d workgroups per CU\n", per_cu);
        (void)hipGetLastError();
        grid = cus;
    }
    if (grid < 0) return;
    if (hipMemsetAsync((char*)d_ws + WS_CTL, 0, CTL_ZERO_BYTES, stream) != hipSuccess) return;
    Args a{};
    for (int i = 0; i < 24; ++i) a.in[i] = (const float*)d_in[i];
    a.out = (float*)d_out; a.ws = (unsigned char*)d_ws;
#if MK_ONE_LAUNCH
    a.ph_lo = 0; a.ph_hi = NPHASE;
    hipLaunchKernelGGL(trunk_fwd, dim3(grid), dim3(NTHR), LDS_BYTES, stream, a);
#else
#ifdef DBG_LAST
    for (int p = 0; p <= DBG_LAST; ++p) { a.ph_lo = p; a.ph_hi = p + 1; hipLaunchKernelGGL(trunk_fwd, dim3(grid), dim3(NTHR), LDS_BYTES, stream, a); }
    hipLaunchKernelGGL(dbg_dump, dim3(2048), dim3(256), 0, stream, (const unsigned short*)((const char*)d_ws + DBG_OFF), (float*)d_out, DBG_LD, DBG_F32);
#else
    for (int p = 0; p < NPHASE; ++p) { a.ph_lo = p; a.ph_hi = p + 1; hipLaunchKernelGGL(trunk_fwd, dim3(grid), dim3(NTHR), LDS_BYTES, stream, a); }
#endif
#endif
}
```

```cpp
#include <hip/hip_runtime.h>
#include <cstdio>
#include <cstdint>

#ifndef MK_ONE_LAUNCH
#define MK_ONE_LAUNCH 1
#endif

#define GAS __attribute__((address_space(1)))
#define LAS __attribute__((address_space(3)))
typedef unsigned short bf16;
typedef short bf16x8 __attribute__((ext_vector_type(8)));
typedef float f32x4 __attribute__((ext_vector_type(4)));
typedef float f32x16 __attribute__((ext_vector_type(16)));
typedef unsigned u32x4 __attribute__((ext_vector_type(4)));
typedef unsigned u32x2 __attribute__((ext_vector_type(2)));
typedef GAS unsigned gu32;

constexpr int S = 16384, D = 2048, INC = 8192, SBW = 1024, SSMW = 1024, NH = 8, HD = 128;
constexpr int SG = 64, SN = 64, SP = 16;
constexpr int FFD = 4096, NE = 8, FFE = 1024;
constexpr int CH = 64, NCH = S / CH;
constexpr float RMS_EPS = 1e-6f;
constexpr float SB_THRESH = 30.0f;

constexpr size_t MiB = 1u << 20;
constexpr size_t WS_CTL = 0, CTL_ZERO_BYTES = 1 * MiB;
constexpr size_t WS_SSMT = 1 * MiB;
constexpr size_t WS_MOE = 2 * MiB;
constexpr size_t WS_XE = 4 * MiB;
constexpr size_t WS_W = 12 * MiB;
constexpr size_t W_IN = 0, W_GLU = 32 * MiB, W_PA = 34 * MiB, W_PS = 38 * MiB, W_OUT = 42 * MiB, W_FFN = 50 * MiB;
constexpr size_t W_GU = W_FFN, W_DN_DENSE = W_FFN + 32 * MiB, W_DN_MOE = W_FFN + 64 * MiB;
constexpr size_t WS_XN = 158 * MiB;
constexpr size_t WS_Y = 158 * MiB, WS_OSSM = 190 * MiB;
constexpr size_t WS_Q = 222 * MiB;
constexpr size_t WS_GA = 350 * MiB, WS_GB = 414 * MiB;
constexpr size_t WS_ACT = 222 * MiB;
constexpr size_t WS_MOEY = 350 * MiB;
constexpr size_t WS_OATT = 478 * MiB;
constexpr size_t WS_END = 510 * MiB;

constexpr int CW_BAR = 4096;
constexpr int CW_MOECNT = 16384;

constexpr size_t ST_ABAR = 0;
constexpr size_t ST_ABARL = 32768;
constexpr size_t ST_BBF = 65536;
constexpr size_t ST_CTF = 65536 + 262144;

constexpr int NWAVES = 8, NTHR = 512;
constexpr int RING_BYTES = 131072, LDSCTL_OFF = RING_BYTES, MISC_OFF = LDSCTL_OFF + 320, LDS_BYTES = 147456;

#define RLX_AGENT __ATOMIC_RELAXED, __HIP_MEMORY_SCOPE_AGENT
#define LDS_WAIT() asm volatile("s_waitcnt lgkmcnt(0)" ::: "memory")
#define VM_WAIT() asm volatile("s_waitcnt vmcnt(0)" ::: "memory")

__device__ __forceinline__ unsigned f2bf(float f) { unsigned u = __builtin_bit_cast(unsigned, f); return (u + 0x7fffu + ((u >> 16) & 1u)) >> 16; }
__device__ __forceinline__ unsigned pk2(float lo, float hi) { return f2bf(lo) | (f2bf(hi) << 16); }
typedef float f32x2_t __attribute__((ext_vector_type(2)));
typedef __bf16 bf16x2_t __attribute__((ext_vector_type(2)));
__device__ __forceinline__ unsigned cvt_pk_bf16(float lo, float hi) { const f32x2_t v = {lo, hi}; const bf16x2_t b = __builtin_convertvector(v, bf16x2_t); return __builtin_bit_cast(unsigned, b); }
__device__ __forceinline__ float bflo(unsigned w) { return __builtin_bit_cast(float, w << 16); }
__device__ __forceinline__ float bfhi(unsigned w) { return __builtin_bit_cast(float, w & 0xffff0000u); }
__device__ __forceinline__ float bf2f(bf16 b) { return __builtin_bit_cast(float, ((unsigned)b) << 16); }
__device__ __forceinline__ float sigmoidf_(float x) { return __builtin_amdgcn_rcpf(1.0f + __expf(-x)); }
__device__ __forceinline__ float wave_sum(float v) {
#pragma unroll
    for (int o = 1; o < 64; o <<= 1) v += __shfl_xor(v, o);
    return v;
}

#define XB_TMO      128
#define XB_XCNT(j)  (256  + 64 * (j))
#define XB_XSUB(j)  (1280 + 64 * (j))
#define XB_XGEN(j)  (2304 + 64 * (j))
#define XB_TOP      3328
#define XB_TOPGEN   3392
#define XCD_BAR_WORDS 3456
#define XB_SPIN_CAP (1u << 18)
__device__ __forceinline__ unsigned xb_ld(unsigned* p)              { return __hip_atomic_load(p, __ATOMIC_RELAXED, __HIP_MEMORY_SCOPE_AGENT); }
__device__ __forceinline__ unsigned xb_add(unsigned* p, unsigned v) { return __hip_atomic_fetch_add(p, v, __ATOMIC_RELAXED, __HIP_MEMORY_SCOPE_AGENT); }
__device__ __forceinline__ unsigned xb_xcc_id() { return (unsigned)__builtin_amdgcn_s_getreg((3 << 11) | 20) & 0xFu; }
#define XB_SPIN(cond, bar) do { unsigned _sp = 0; while (cond) { __builtin_amdgcn_s_sleep(1); \
    if ((++_sp & 255u) == 0u) { if (xb_ld(&(bar)[XB_TMO])) break; if (_sp > XB_SPIN_CAP) { atomicAdd(&(bar)[XB_TMO], 1u); break; } } } } while (0)
struct XcdBarrier { unsigned* bar; unsigned x; volatile LAS unsigned* st; };
__device__ __forceinline__ XcdBarrier xcd_barrier_post(unsigned* bar, volatile LAS unsigned* st) {
    XcdBarrier b; b.bar = bar; b.x = xb_xcc_id(); b.st = st;
    if (threadIdx.x == 0) (void)xb_add(&bar[XB_XCNT(b.x)], 1u);
    return b;
}
__device__ __forceinline__ void xcd_barrier_complete(unsigned* bar, unsigned x, unsigned& nloc, unsigned& nx) {
    const unsigned G = gridDim.x * gridDim.y * gridDim.z;
    unsigned sum, cnt, mine, sp = 0u;
    for (;;) {
        sum = 0u; cnt = 0u; mine = 0u;
#pragma unroll
        for (unsigned j = 0; j < 16; ++j) { const unsigned c = xb_ld(&bar[XB_XCNT(j)]); sum += c; cnt += (c > 0u) ? 1u : 0u; mine = (j == x) ? c : mine; }
        if (sum == G) break;
        __builtin_amdgcn_s_sleep(1);
        if ((++sp & 255u) == 0u) { if (xb_ld(&bar[XB_TMO])) break; if (sp > XB_SPIN_CAP) { atomicAdd(&bar[XB_TMO], 1u); break; } }
    }
    nloc = mine > 0u ? mine : 1u; nx = cnt > 0u ? cnt : 1u;
}
__device__ __forceinline__ void xcd_barrier(const XcdBarrier& b) {
    asm volatile("s_waitcnt vmcnt(0)" ::: "memory");
    __syncthreads();
    if (threadIdx.x == 0) {
        unsigned* bar = b.bar;
        __builtin_amdgcn_s_waitcnt(0);
        unsigned nloc = b.st[0], nx = b.st[1];
        if (nloc == 0u) { xcd_barrier_complete(bar, b.x, nloc, nx); b.st[0] = nloc; b.st[1] = nx; }
        const unsigned old = xb_add(&bar[XB_XSUB(b.x)], 1u);
        const unsigned gen = old / nloc;
        if (old + 1u == (gen + 1u) * nloc) {
            __builtin_amdgcn_fence(__ATOMIC_RELEASE, "agent");
            asm volatile("s_waitcnt vmcnt(0)" ::: "memory");
            const unsigned og = xb_add(&bar[XB_TOP], 1u);
            const unsigned tg = og / nx;
            if (og + 1u == (tg + 1u) * nx) xb_add(&bar[XB_TOPGEN], 1u);
            else XB_SPIN(xb_ld(&bar[XB_TOPGEN]) == tg, bar);
            __builtin_amdgcn_fence(__ATOMIC_ACQUIRE, "agent");
            xb_add(&bar[XB_XGEN(b.x)], 1u);
            asm volatile("s_waitcnt vmcnt(0)" ::: "memory");
        } else {
            XB_SPIN(xb_ld(&bar[XB_XGEN(b.x)]) == gen, bar);
            __builtin_amdgcn_fence(__ATOMIC_ACQUIRE, "agent");
            asm volatile("s_waitcnt vmcnt(0)" ::: "memory");
        }
    }
    __syncthreads();
}

namespace pg8 {
constexpr int BM = 256, BK = 64, HALF = 128, HTB = HALF * BK * 2, STAGE_BYTES = 8 * HTB, NXCD = 8, WGM = 8;
__host__ __device__ __forceinline__ int lds_byte(int r, int c) { const int st = (r >> 4) * 2 + (c >> 5), rr = r & 15, cc = c & 31, ob = rr * 64 + cc * 2; return st * 1024 + (ob ^ (((ob >> 9) & 1) << 5)); }
__host__ __device__ __forceinline__ void stage_rc(int b, int& R, int& C) { const int st = b / 1024, sb = b % 1024, swz = sb ^ (((sb >> 9) & 1) << 5); R = (st >> 1) * 16 + swz / 64; C = (st & 1) * 32 + (swz % 64) / 2; }
__host__ __device__ __forceinline__ int perm32(int rho) { const int n = rho >> 4, i = rho & 15; return 8 * (i >> 2) + 4 * n + (i & 3); }

struct Unit { int pm, pn, e, nv; };

struct StaticOrder {
    int nM, nN, nwg, G, c;
    __device__ void init(int M, int N, int G_, int c_) { nM = M / BM; nN = N / BM; nwg = nM * nN; G = G_; c = c_; }
    __device__ bool next(int i, Unit& u) const {
        const long L = (long)i * G + c; if (L >= nwg) return false;
        int wgid = (int)L; { const int q = nwg / NXCD, r = nwg % NXCD, xcd = wgid % NXCD, off = wgid / NXCD; wgid = (xcd < r ? xcd * (q + 1) : r * (q + 1) + (xcd - r) * q) + off; }
        const int nig = WGM * nN, gid = wgid / nig, fm = gid * WGM, gsz = (nM - fm) < WGM ? (nM - fm) : WGM;
        u.pm = fm + ((wgid % nig) % gsz); u.pn = (wgid % nig) / gsz; u.e = 0; u.nv = 256; return true;
    }
};
struct DenseSched {
    StaticOrder so; const bf16* A; const bf16* Bt; int K;
    __device__ __forceinline__ bool next(int i, Unit& u) const { return so.next(i, u); }
    __device__ __forceinline__ const char* abase(const Unit& u) const { return (const char*)A + (size_t)u.pm * 256 * K * 2; }
    __device__ __forceinline__ const char* bbase(const Unit& u) const { return (const char*)Bt + (size_t)u.pn * 256 * K * 2; }
    __device__ __forceinline__ void aoff(const Unit&, const int (&R)[2], const int (&C)[2], unsigned (&v)[2][2]) const {
#pragma unroll
        for (int h = 0; h < 2; ++h)
#pragma unroll
            for (int i = 0; i < 2; ++i) v[h][i] = (unsigned)((h * HALF + R[i]) * K + C[i]) * 2u;
    }
};
struct MoeSched {
    const bf16* A; const bf16* Bt; int K; int G, c; bool gather;
    const int* lists; int cnt[NE]; int cum[NE + 1];
    __device__ void init(const unsigned* cntw, int G_, int c_) {
        G = G_; c = c_; int a = 0;
#pragma unroll
        for (int e = 0; e < NE; ++e) { cnt[e] = __builtin_amdgcn_readfirstlane((int)__hip_atomic_load(cntw + 64 * e, RLX_AGENT)); cum[e] = a; a += (cnt[e] + 255) >> 8; }
        cum[NE] = a;
    }
    __device__ __forceinline__ bool next(int i, Unit& u) const {
        const int L = i * G + c; if (L >= cum[NE] * 8) return false;
        const int gp = L >> 3; u.pn = L & 7; u.pm = gp; int e = 0;
#pragma unroll
        for (int k = 1; k < NE; ++k) e += (gp >= cum[k]) ? 1 : 0;
        u.e = e; int c_e = 0, b_e = 0;
#pragma unroll
        for (int k = 0; k < NE; ++k) { c_e = (k == e) ? cnt[k] : c_e; b_e = (k == e) ? cum[k] : b_e; }
        const int p = gp - b_e; int nv = c_e - 256 * p; u.nv = nv > 256 ? 256 : nv; return true;
    }
    __device__ __forceinline__ const char* abase(const Unit& u) const { return gather ? (const char*)A : (const char*)A + (size_t)u.pm * 256 * K * 2; }
    __device__ __forceinline__ const char* bbase(const Unit& u) const { return (const char*)Bt + ((size_t)u.e * 2048 + (size_t)u.pn * 256) * K * 2; }
    __device__ __forceinline__ void aoff(const Unit& u, const int (&R)[2], const int (&C)[2], unsigned (&v)[2][2]) const {
        int b_e = 0;
#pragma unroll
        for (int k = 0; k < NE; ++k) b_e = (k == u.e) ? cum[k] : b_e;
        const int p = u.pm - b_e;
#pragma unroll
        for (int h = 0; h < 2; ++h)
#pragma unroll
            for (int i = 0; i < 2; ++i) {
                const int r = h * HALF + R[i];
                if (gather) { int tok = 0; if (r < u.nv) tok = lists[u.e * S + 256 * p + r] >> 1; v[h][i] = (unsigned)(tok * K + C[i]) * 2u; }
                else v[h][i] = (unsigned)(r * K + C[i]) * 2u;
            }
    }
};

template <class Epi, class Sched, bool ALIGN_EPI>
__device__ __forceinline__ void gemm_phase(LAS unsigned char* lds, const int K, const Sched& S_, const Epi& E) {
    int tid_ = threadIdx.x; asm volatile("" : "+v"(tid_));
    const int tid = tid_, wid = __builtin_amdgcn_readfirstlane(tid >> 6), lane = tid & 63, wr = wid >> 2, wc = wid & 3, fr = lane & 15, fq = lane >> 4;
    const int nt = K / BK;
    int Rr[2], Cc[2]; unsigned voffB[2];
#pragma unroll
    for (int i = 0; i < 2; ++i) { int R, C; stage_rc(tid * 16 + i * 8192, R, C); Rr[i] = R; Cc[i] = C; const int Rb = Epi::PERM ? ((R & ~31) + perm32(R & 31)) : R; voffB[i] = (unsigned)(Rb * K + C) * 2u; }
    const size_t kstep = (size_t)(BK * 2);
    const size_t hstep = (size_t)HALF * K * 2;
    const unsigned ldsw = (unsigned)wid * 1024u;
    const int aoff = lds_byte(wr * 64 + fr, fq * 8), boff = lds_byte(wc * 32 + fr, fq * 8);
#define PG8_SA(b, h) (((b) * 2 + (h)) * HTB)
#define PG8_SB(b, h) ((4 + (b) * 2 + (h)) * HTB)
#define PG8_STAGE(bufoff, gbase, voff) do { _Pragma("unroll") for (int _i = 0; _i < 2; ++_i) \
        __builtin_amdgcn_global_load_lds((const unsigned*)((const char*)(gbase) + (voff)[_i]), (LAS unsigned*)(lds + (bufoff) + ldsw + _i * 8192), 16, 0, 0); } while (0)
#define PG8_LDA(dst, b, h) do { _Pragma("unroll") for (int m = 0; m < 4; ++m) _Pragma("unroll") for (int k = 0; k < 2; ++k) dst[m][k] = *(const LAS bf16x8*)(lds + PG8_SA(b, h) + aoff + m * 2048 + k * 1024); } while (0)
#define PG8_LDB(dst, b, h) do { _Pragma("unroll") for (int n = 0; n < 2; ++n) _Pragma("unroll") for (int k = 0; k < 2; ++k) dst[n][k] = *(const LAS bf16x8*)(lds + PG8_SB(b, h) + boff + n * 2048 + k * 1024); } while (0)
#define PG8_MMA(ai, bj, At, Bt) do { __builtin_amdgcn_s_setprio(1); _Pragma("unroll") for (int m = 0; m < 4; ++m) _Pragma("unroll") for (int n = 0; n < 2; ++n) _Pragma("unroll") for (int k = 0; k < 2; ++k) \
        acc[ai][bj][m][n] = __builtin_amdgcn_mfma_f32_16x16x32_bf16(Bt[n][k], At[m][k], acc[ai][bj][m][n], 0, 0, 0); __builtin_amdgcn_s_setprio(0); } while (0)
#define PG8_WAIT_V(n) asm volatile("s_waitcnt vmcnt(" #n ")" ::: "memory")
#define PG8_WAIT_L(n) asm volatile("s_waitcnt lgkmcnt(" #n ")" ::: "memory")
#define PG8_BAR __builtin_amdgcn_s_barrier()
#define PG8_SCHED __builtin_amdgcn_sched_barrier(0)
    Unit cur, nxt; int ui = 0;
    if (!S_.next(0, cur)) return;
    f32x4 acc[2][2][4][2];
#pragma unroll
    for (int a = 0; a < 2; ++a)
#pragma unroll
        for (int b = 0; b < 2; ++b)
#pragma unroll
            for (int m = 0; m < 4; ++m)
#pragma unroll
                for (int n = 0; n < 2; ++n) acc[a][b][m][n] = (f32x4){0.f, 0.f, 0.f, 0.f};
    bf16x8 At[4][2], B0[2][2], B1[2][2];
    const char* cA = S_.abase(cur); const char* cB = S_.bbase(cur);
    unsigned vA[2][2], nvA[2][2]; S_.aoff(cur, Rr, Cc, vA);
    PG8_STAGE(PG8_SB(0, 0), cB, voffB); PG8_STAGE(PG8_SB(0, 1), cB + hstep, voffB); PG8_STAGE(PG8_SA(0, 0), cA, vA[0]); PG8_STAGE(PG8_SA(0, 1), cA, vA[1]);
    if (wr == 1) PG8_BAR;
    PG8_WAIT_V(2); PG8_BAR;
    PG8_STAGE(PG8_SB(1, 0), cB + kstep, voffB); PG8_STAGE(PG8_SA(1, 0), cA + kstep, vA[0]); PG8_STAGE(PG8_SB(1, 1), cB + hstep + kstep, voffB);
    PG8_WAIT_V(6); PG8_BAR;
    for (;;) {
        const bool has_next = S_.next(ui + 1, nxt);
        const char* nA = has_next ? S_.abase(nxt) : cA; const char* nB = has_next ? S_.bbase(nxt) : cB;
        if (has_next) S_.aoff(nxt, Rr, Cc, nvA); else {
#pragma unroll
            for (int h = 0; h < 2; ++h)
#pragma unroll
                for (int i = 0; i < 2; ++i) nvA[h][i] = vA[h][i]; }
        for (int t = 0; t < nt; t += 2) {
            const bool last = (t == nt - 2);
            const char* a1 = cA + (size_t)(t + 1) * kstep;
            const char* a2 = last ? nA : cA + (size_t)(t + 2) * kstep; const char* b2 = last ? nB : cB + (size_t)(t + 2) * kstep;
            const char* a3 = a2 + kstep; const char* b3 = b2 + kstep;
            unsigned wA[2][2];
#pragma unroll
            for (int h = 0; h < 2; ++h)
#pragma unroll
                for (int i = 0; i < 2; ++i) wA[h][i] = last ? nvA[h][i] : vA[h][i];
            PG8_LDB(B0, 0, 0); PG8_LDB(B1, 0, 1); PG8_SCHED; PG8_LDA(At, 0, 0); PG8_STAGE(PG8_SA(1, 1), a1, vA[1]);
            PG8_WAIT_V(8); PG8_WAIT_L(0); PG8_BAR; PG8_MMA(0, 0, At, B0); PG8_MMA(0, 1, At, B1); PG8_BAR; PG8_SCHED;
            PG8_LDA(At, 0, 1); PG8_STAGE(PG8_SB(0, 0), b2, voffB); PG8_STAGE(PG8_SB(0, 1), b2 + hstep, voffB); PG8_STAGE(PG8_SA(0, 0), a2, wA[0]);
            PG8_WAIT_V(8); PG8_WAIT_L(0); PG8_BAR; PG8_MMA(1, 0, At, B0); PG8_MMA(1, 1, At, B1); PG8_BAR; PG8_SCHED;
            PG8_LDB(B0, 1, 0); PG8_LDB(B1, 1, 1); PG8_SCHED; PG8_LDA(At, 1, 0); PG8_STAGE(PG8_SA(0, 1), a2, wA[1]);
            PG8_WAIT_V(8); PG8_WAIT_L(0); PG8_BAR; PG8_MMA(0, 0, At, B0); PG8_MMA(0, 1, At, B1); PG8_BAR; PG8_SCHED;
            PG8_LDA(At, 1, 1); PG8_STAGE(PG8_SB(1, 0), b3, voffB); PG8_STAGE(PG8_SB(1, 1), b3 + hstep, voffB); PG8_STAGE(PG8_SA(1, 0), a3, wA[0]);
            PG8_WAIT_V(8); PG8_WAIT_L(0); PG8_BAR; PG8_MMA(1, 0, At, B0); PG8_MMA(1, 1, At, B1); PG8_BAR; PG8_SCHED;
        }
        if constexpr (ALIGN_EPI) { if (wr == 0) PG8_BAR; }
        E(acc, cur, wr, wc, fr, fq);
        if (!has_next) break;
#pragma unroll
        for (int a = 0; a < 2; ++a)
#pragma unroll
            for (int b = 0; b < 2; ++b)
#pragma unroll
                for (int m = 0; m < 4; ++m)
#pragma unroll
                    for (int n = 0; n < 2; ++n) acc[a][b][m][n] = (f32x4){0.f, 0.f, 0.f, 0.f};
        cur = nxt; cA = nA; cB = nB; ++ui;
#pragma unroll
        for (int h = 0; h < 2; ++h)
#pragma unroll
            for (int i = 0; i < 2; ++i) vA[h][i] = nvA[h][i];
        if constexpr (ALIGN_EPI) { if (wr == 1) PG8_BAR; }
    }
    PG8_WAIT_V(0);
    if constexpr (!ALIGN_EPI) { if (wr == 0) PG8_BAR; }
    PG8_BAR;
#undef PG8_SA
#undef PG8_SB
#undef PG8_STAGE
#undef PG8_LDA
#undef PG8_LDB
#undef PG8_MMA
#undef PG8_WAIT_V
#undef PG8_WAIT_L
#undef PG8_BAR
#undef PG8_SCHED
}

typedef const f32x4 (&AccRef)[2][2][4][2];

struct EpiProj {
    static constexpr bool PERM = true;
    bf16* Q; bf16* GA;
    __device__ __forceinline__ void operator()(AccRef acc, const Unit& u, int wr, int wc, int fr, int fq) const {
        const int row0 = u.pm * BM + wr * 64 + fr;
        if (u.pn < 16) {
            bf16* base = Q + (size_t)(u.pn >> 2) * ((size_t)S * 1024) + (u.pn & 3) * 256 + wc * 32 + 8 * fq;
#pragma unroll
            for (int ai = 0; ai < 2; ++ai)
#pragma unroll
                for (int m = 0; m < 4; ++m) { bf16* rowp = base + (size_t)(row0 + ai * HALF + m * 16) * 1024;
#pragma unroll
                    for (int bj = 0; bj < 2; ++bj) { const f32x4 v0 = acc[ai][bj][m][0], v1 = acc[ai][bj][m][1];
                        u32x4 w; w.x = cvt_pk_bf16(v0[0], v0[1]); w.y = cvt_pk_bf16(v0[2], v0[3]); w.z = cvt_pk_bf16(v1[0], v1[1]); w.w = cvt_pk_bf16(v1[2], v1[3]);
                        *(u32x4*)(rowp + bj * HALF) = w; } }
        } else {
            const int pg = u.pn - 16;
            bf16* base = GA + (size_t)(pg >> 3) * ((size_t)S * 2048) + (pg & 7) * 256 + wc * 32 + 8 * fq;
#pragma unroll
            for (int ai = 0; ai < 2; ++ai)
#pragma unroll
                for (int m = 0; m < 4; ++m) { bf16* rowp = base + (size_t)(row0 + ai * HALF + m * 16) * 2048;
#pragma unroll
                    for (int bj = 0; bj < 2; ++bj) { f32x4 v0 = acc[ai][bj][m][0], v1 = acc[ai][bj][m][1];
#pragma unroll
                        for (int j = 0; j < 4; ++j) { v0[j] = sigmoidf_(v0[j]); v1[j] = sigmoidf_(v1[j]); }
                        u32x4 w; w.x = cvt_pk_bf16(v0[0], v0[1]); w.y = cvt_pk_bf16(v0[2], v0[3]); w.z = cvt_pk_bf16(v1[0], v1[1]); w.w = cvt_pk_bf16(v1[2], v1[3]);
                        *(u32x4*)(rowp + bj * HALF) = w; } }
        }
    }
};
template <int MODE> struct EpiGate {
    static constexpr bool PERM = true;
    const bf16* G; bf16* O; int ld;
    __device__ __forceinline__ void operator()(AccRef acc, const Unit& u, int wr, int wc, int fr, int fq) const {
        const int row0 = u.pm * BM + wr * 64 + fr, col0 = u.pn * BM + wc * 32 + 8 * fq;
#pragma unroll
        for (int ai = 0; ai < 2; ++ai)
#pragma unroll
            for (int m = 0; m < 4; ++m) { const size_t off = (size_t)(row0 + ai * HALF + m * 16) * ld + col0;
#pragma unroll
                for (int bj = 0; bj < 2; ++bj) { const f32x4 v0 = acc[ai][bj][m][0], v1 = acc[ai][bj][m][1];
                    const u32x4 g = *(const u32x4*)(G + off + bj * HALF);
                    float a[8] = {v0[0], v0[1], v0[2], v0[3], v1[0], v1[1], v1[2], v1[3]};
                    const float gg[8] = {bflo(g.x), bfhi(g.x), bflo(g.y), bfhi(g.y), bflo(g.z), bfhi(g.z), bflo(g.w), bfhi(g.w)};
                    if (MODE == 1) {
#pragma unroll
                        for (int j = 0; j < 8; ++j) a[j] = gg[j] * sigmoidf_(a[j]);
                    } else if (MODE == 0) {
#pragma unroll
                        for (int j = 0; j < 8; ++j) a[j] = gg[j] * a[j];
                    } else {
                        const u32x4 o = *(const u32x4*)(O + off + bj * HALF);
                        const float oo[8] = {bflo(o.x), bfhi(o.x), bflo(o.y), bfhi(o.y), bflo(o.z), bfhi(o.z), bflo(o.w), bfhi(o.w)};
#pragma unroll
                        for (int j = 0; j < 8; ++j) a[j] = oo[j] + gg[j] * a[j];
                    }
                    u32x4 w; w.x = cvt_pk_bf16(a[0], a[1]); w.y = cvt_pk_bf16(a[2], a[3]); w.z = cvt_pk_bf16(a[4], a[5]); w.w = cvt_pk_bf16(a[6], a[7]);
                    *(u32x4*)(O + off + bj * HALF) = w; }
                asm volatile("" ::: "memory"); }
    }
};
struct EpiResid {
    static constexpr bool PERM = false;
    const float* xin; float* xout;
    __device__ __forceinline__ void operator()(AccRef acc, const Unit& u, int wr, int wc, int fr, int fq) const {
        const int row0 = u.pm * BM + wr * 64 + fr, col0 = u.pn * BM + wc * 32 + 4 * fq;
#pragma unroll
        for (int ai = 0; ai < 2; ++ai)
#pragma unroll
            for (int m = 0; m < 4; ++m) { const size_t off = (size_t)(row0 + ai * HALF + m * 16) * D + col0;
#pragma unroll
                for (int bj = 0; bj < 2; ++bj)
#pragma unroll
                    for (int n = 0; n < 2; ++n) { const f32x4 xv = *(const f32x4*)(xin + off + bj * HALF + n * 16); *(f32x4*)(xout + off + bj * HALF + n * 16) = xv + acc[ai][bj][m][n]; }
                asm volatile("" ::: "memory"); }
    }
};
struct EpiSwiglu {
    static constexpr bool PERM = true;
    bf16* O; int ld;
    __device__ __forceinline__ void operator()(AccRef acc, const Unit& u, int wr, int wc, int fr, int fq) const {
        const int row0 = u.pm * BM + wr * 64 + fr, col0 = u.pn * HALF + wc * 32 + 8 * fq;
#pragma unroll
        for (int ai = 0; ai < 2; ++ai)
#pragma unroll
            for (int m = 0; m < 4; ++m) { bf16* rowp = O + (size_t)(row0 + ai * HALF + m * 16) * ld + col0;
                float a[8];
#pragma unroll
                for (int n = 0; n < 2; ++n)
#pragma unroll
                    for (int j = 0; j < 4; ++j) { const float g = acc[ai][0][m][n][j], up = acc[ai][1][m][n][j]; a[n * 4 + j] = g * sigmoidf_(g) * up; }
                u32x4 w; w.x = cvt_pk_bf16(a[0], a[1]); w.y = cvt_pk_bf16(a[2], a[3]); w.z = cvt_pk_bf16(a[4], a[5]); w.w = cvt_pk_bf16(a[6], a[7]);
                *(u32x4*)rowp = w; }
    }
};
struct EpiMoeDown {
    static constexpr bool PERM = true;
    bf16* O; const int* lists; const float* gw; int cumv[NE];
    __device__ __forceinline__ void operator()(AccRef acc, const Unit& u, int wr, int wc, int fr, int fq) const {
        int b_e = 0;
#pragma unroll
        for (int k = 0; k < NE; ++k) b_e = (k == u.e) ? cumv[k] : b_e;
        const int p = u.pm - b_e; const int col0 = u.pn * BM + wc * 32 + 8 * fq;
#pragma unroll
        for (int ai = 0; ai < 2; ++ai)
#pragma unroll
            for (int m = 0; m < 4; ++m) { const int r = ai * HALF + wr * 64 + m * 16 + fr;
                if (r < u.nv) { const int slot = lists[u.e * S + 256 * p + r]; const float g = gw[slot]; bf16* rowp = O + (size_t)slot * D + col0;
#pragma unroll
                    for (int bj = 0; bj < 2; ++bj) { const f32x4 v0 = acc[ai][bj][m][0] * g, v1 = acc[ai][bj][m][1] * g;
                        u32x4 w; w.x = cvt_pk_bf16(v0[0], v0[1]); w.y = cvt_pk_bf16(v0[2], v0[3]); w.z = cvt_pk_bf16(v1[0], v1[1]); w.w = cvt_pk_bf16(v1[2], v1[3]);
                        *(u32x4*)(rowp + bj * HALF) = w; } } }
    }
};
}

struct Args { const float* in[24]; float* out; unsigned char* ws; int ph_lo, ph_hi; };
struct Frame {
    LAS unsigned char* lds;
    gu32* ctl;
    unsigned char* ws;
    int tid, lane, wave, vcu, G, bid;
    const struct Args __attribute__((address_space(4)))* ka;
};

__device__ __forceinline__ void transpose_item(const float* W, int K, int N, bf16* WT, int k0, int n0, int drow0, LAS float* scr, int lane) {
#pragma unroll 8
    for (int i = 0; i < 32; ++i) { const int kk = 2 * i + (lane >> 5); scr[kk * 33 + (lane & 31)] = W[(size_t)(k0 + kk) * N + n0 + (lane & 31)]; }
    LDS_WAIT(); asm volatile("" ::: "memory");
    const int c = lane & 7;
#pragma unroll
    for (int j = 0; j < 4; ++j) { const int n = (lane >> 3) + 8 * j; const LAS float* s = scr + (8 * c) * 33 + n;
        u32x4 o; o.x = pk2(s[0 * 33], s[1 * 33]); o.y = pk2(s[2 * 33], s[3 * 33]); o.z = pk2(s[4 * 33], s[5 * 33]); o.w = pk2(s[6 * 33], s[7 * 33]);
        *(GAS u32x4*)(WT + (size_t)(drow0 + n) * K + k0 + 8 * c) = o; }
    LDS_WAIT(); asm volatile("" ::: "memory");
}
__device__ __forceinline__ void transpose_mat(Frame& F, const float* W, int K, int N, bf16* WT, int il  , int item, LAS float* scr) {
    const int nblk = N / 32, kb = item / nblk, nb = item % nblk, k0 = 64 * kb, n0 = 32 * nb;
    const int drow0 = il ? ((n0 >> 7) * 256 + (n0 & 127) + (il == 2 ? 128 : 0)) : n0;
    transpose_item(W, K, N, WT, k0, n0, drow0, scr, F.lane);
}
__device__ __forceinline__ void rms_row_to_bf16(Frame& F, const float* xrow, const float* g, bf16* orow) {
    const GAS f32x4* xr = (const GAS f32x4*)xrow + F.lane; const GAS f32x4* gr = (const GAS f32x4*)g + F.lane;
    f32x4 v[8]; float s = 0.f;
#pragma unroll
    for (int j = 0; j < 8; ++j) { v[j] = xr[64 * j]; s += (v[j].x * v[j].x + v[j].y * v[j].y) + (v[j].z * v[j].z + v[j].w * v[j].w); }
    const float rstd = 1.0f / sqrtf(wave_sum(s) * (1.f / D) + RMS_EPS);
    GAS unsigned long long* o8 = (GAS unsigned long long*)orow + F.lane;
#pragma unroll
    for (int j = 0; j < 8; ++j) { const f32x4 gg = gr[64 * j]; o8[64 * j] = (unsigned long long)pk2(v[j].x * rstd * gg.x, v[j].y * rstd * gg.y) | ((unsigned long long)pk2(v[j].z * rstd * gg.z, v[j].w * rstd * gg.w) << 32); }
}

__device__ __forceinline__ void cis_d(double th, float& c, float& s) {
    const double TWO_PI = 6.283185307179586476925286766559;
    const double k = rint(th / TWO_PI); const float r = (float)(th - k * TWO_PI);
    c = cosf(r); s = sinf(r);
}
__device__ __forceinline__ void ssm_tables_group(Frame& F, int g, const float* a_re, const float* a_im, const float* log_dt, const float* b_re, const float* b_im,
                                                 const float* c_re, const float* c_im) {
    const int n = F.lane;
    const double dt = exp((double)log_dt[g]); const double ar = (double)a_re[g * SN + n], ai = (double)a_im[g * SN + n];
    float cr, sr; cis_d(dt * ai, cr, sr); const float mag = (float)exp(dt * ar);
    const float abr = mag * cr, abi = mag * sr;
    float cl, sl; cis_d(dt * ai * (double)CH, cl, sl); const float magl = (float)exp(dt * ar * (double)CH);
    float* abar = (float*)(F.ws + WS_SSMT + ST_ABAR); float* abarl = (float*)(F.ws + WS_SSMT + ST_ABARL);
    abar[(g * SN + n) * 2] = abr; abar[(g * SN + n) * 2 + 1] = abi; abarl[(g * SN + n) * 2] = magl * cl; abarl[(g * SN + n) * 2 + 1] = magl * sl;
    const float arf = (float)ar, aif = (float)ai; const float den = arf * arf + aif * aif; const float nre = abr - 1.0f;
    const float zre = (nre * arf + abi * aif) / den, zim = (abi * arf - nre * aif) / den;
    bf16* bbf = (bf16*)(F.ws + WS_SSMT + ST_BBF);
#pragma unroll
    for (int q = 0; q < SP; ++q) {
        const float br = b_re[(g * SN + n) * SP + q], bi = b_im[(g * SN + n) * SP + q];
        const float re = zre * br - zim * bi, im = zre * bi + zim * br;
        const int l = (n & 31) + 32 * (q >> 3), j = q & 7;
        bbf[((size_t)(g * 4 + (n >> 5)) * 64 + l) * 8 + j] = (bf16)f2bf(re);
        bbf[((size_t)(g * 4 + 2 + (n >> 5)) * 64 + l) * 8 + j] = (bf16)f2bf(im);
    }
    bf16* ctf = (bf16*)(F.ws + WS_SSMT + ST_CTF);
    for (int kk = 0; kk < 4; ++kk)
#pragma unroll
        for (int j = 0; j < 8; ++j) { const int l = F.lane, kp = 32 * kk + 8 * (l >> 4) + j, st = kp >> 1, p = l & 15;
            const float v = (kp & 1) ? -c_im[(g * SP + p) * SN + st] : c_re[(g * SP + p) * SN + st];
            ctf[((size_t)(g * 4 + kk) * 64 + l) * 8 + j] = (bf16)f2bf(v); }
}

constexpr int XROWB = 272;
template <bool READOUT>
__device__ __forceinline__ void ssm_run(Frame& F, int g, int c0, const bf16* U, bf16* Y, const float* dskip, LAS unsigned char* xl) {
    const int lane = F.lane, ci = lane & 31, hh = lane >> 5;
    const float* abar = (const float*)(F.ws + WS_SSMT + ST_ABAR); const float* abarl = (const float*)(F.ws + WS_SSMT + ST_ABARL);
    float* XE = (float*)(F.ws + WS_XE) + (size_t)g * NCH * 128;
    float ar[2], ai[2], lr[2], li[2];
#pragma unroll
    for (int s = 0; s < 2; ++s) { const int n = ci + 32 * s; ar[s] = abar[(g * SN + n) * 2]; ai[s] = abar[(g * SN + n) * 2 + 1]; lr[s] = abarl[(g * SN + n) * 2]; li[s] = abarl[(g * SN + n) * 2 + 1]; }
    bf16x8 bfr[4], ctf[4];
#pragma unroll
    for (int nt = 0; nt < 4; ++nt) bfr[nt] = *(const bf16x8*)((const bf16*)(F.ws + WS_SSMT + ST_BBF) + ((size_t)(g * 4 + nt) * 64 + lane) * 8);
    float dsk = 0.f;
    if (READOUT) {
#pragma unroll
        for (int kk = 0; kk < 4; ++kk) ctf[kk] = *(const bf16x8*)((const bf16*)(F.ws + WS_SSMT + ST_CTF) + ((size_t)(g * 4 + kk) * 64 + lane) * 8);
        dsk = dskip[g * SP + (lane & 15)];
    }
    float xr[2] = {0.f, 0.f}, xi[2] = {0.f, 0.f};
    if (READOUT) {
        const int cm = c0 + hh;
        for (int cc = 0; cc < cm; ++cc) {
#pragma unroll
            for (int s = 0; s < 2; ++s) { const float er = XE[cc * 128 + ci + 32 * s], ei = XE[cc * 128 + 64 + ci + 32 * s];
                const float nr = lr[s] * xr[s] - li[s] * xi[s] + er, ni = lr[s] * xi[s] + li[s] * xr[s] + ei; xr[s] = nr; xi[s] = ni; }
        }
    }
    for (int u = 0; u < 4; ++u) {
        const int cA = c0 + 2 * u, cm = cA + hh;
        if (!READOUT) { xr[0] = xr[1] = xi[0] = xi[1] = 0.f; }
        else if (u > 0) {
#pragma unroll
            for (int s = 0; s < 2; ++s) { const float er = XE[(cm - 1) * 128 + ci + 32 * s], ei = XE[(cm - 1) * 128 + 64 + ci + 32 * s];
                const float nr = lr[s] * xr[s] - li[s] * xi[s] + er, ni = lr[s] * xi[s] + li[s] * xr[s] + ei; xr[s] = nr; xi[s] = ni; }
        }
        for (int k = 0; k < 4; ++k) {
            const int seg = (ci >> 2) & 1, tok = 16 * k + 4 * (ci >> 3) + (ci & 3);
            const bf16x8 af = *(const bf16x8*)(U + (size_t)((cA + seg) * CH + tok) * SSMW + g * SP + 8 * hh);
            f32x16 bu[4];
#pragma unroll
            for (int nt = 0; nt < 4; ++nt) { f32x16 z;
#pragma unroll
                for (int r = 0; r < 16; ++r) z[r] = 0.f;
                bu[nt] = __builtin_amdgcn_mfma_f32_32x32x16_bf16(af, bfr[nt], z, 0, 0, 0); }
#pragma unroll
            for (int r = 0; r < 16; ++r) {
#pragma unroll
                for (int s = 0; s < 2; ++s) {
                    const float nr = ar[s] * xr[s] - ai[s] * xi[s] + bu[s][r], ni = ar[s] * xi[s] + ai[s] * xr[s] + bu[2 + s][r]; xr[s] = nr; xi[s] = ni;
                    if (READOUT) *(LAS unsigned*)(xl + (hh * 16 + r) * XROWB + (ci + 32 * s) * 4) = cvt_pk_bf16(nr, ni);
                }
            }
            if (READOUT) {
                LDS_WAIT();
#pragma unroll
                for (int sg = 0; sg < 2; ++sg) {
                    f32x4 y = (f32x4){0.f, 0.f, 0.f, 0.f};
#pragma unroll
                    for (int kk = 0; kk < 4; ++kk) { const bf16x8 xa = *(const LAS bf16x8*)(xl + (sg * 16 + (lane & 15)) * XROWB + (32 * kk + 8 * (lane >> 4)) * 2);
                        y = __builtin_amdgcn_mfma_f32_16x16x32_bf16(xa, ctf[kk], y, 0, 0, 0); }
#pragma unroll
                    for (int r = 0; r < 4; ++r) { const size_t idx = (size_t)((cA + sg) * CH + 16 * k + 4 * (lane >> 4) + r) * SSMW + g * SP + (lane & 15);
                        const float v = y[r] + dsk * bf2f(U[idx]);
                        const float t = tanhf(0.7978845608028654f * (v + 0.044715f * v * v * v));
                        Y[idx] = (bf16)f2bf(0.5f * v * (1.0f + t)); }
                }
                LDS_WAIT();
            }
        }
        if (!READOUT) {
#pragma unroll
            for (int s = 0; s < 2; ++s) { XE[cm * 128 + ci + 32 * s] = xr[s]; XE[cm * 128 + 64 + ci + 32 * s] = xi[s]; }
        }
    }
}

__device__ __forceinline__ void attn_item(Frame& F, int h, int t, const bf16* Q, const bf16* K, const bf16* V, bf16* O, LAS float* qs) {
    const int lane = F.lane;
    { const unsigned qw = *(const unsigned*)(Q + (size_t)t * SBW + h * HD + 2 * lane); const float sc = 0.08838834764831845f;
      qs[2 * lane] = bflo(qw) * sc; qs[2 * lane + 1] = bfhi(qw) * sc; }
    LDS_WAIT();
    float o0 = 0.f, o1 = 0.f, carry = 0.f;
    for (int kb = t - 1; kb >= 0; kb -= 64) {
        const int s = kb - lane; const bool valid = s >= 0; const int sc = valid ? s : 0;
        const bf16* krow = K + (size_t)sc * SBW + h * HD;
        float dot = 0.f;
#pragma unroll
        for (int c = 0; c < 16; ++c) { const u32x4 kv = *(const u32x4*)(krow + 8 * c); const f32x4 qa = *(const LAS f32x4*)(qs + 8 * c), qb = *(const LAS f32x4*)(qs + 8 * c + 4);
            dot += bflo(kv.x) * qa.x + bfhi(kv.x) * qa.y + bflo(kv.y) * qa.z + bfhi(kv.y) * qa.w + bflo(kv.z) * qb.x + bfhi(kv.z) * qb.y + bflo(kv.w) * qb.z + bfhi(kv.w) * qb.w; }
        const float z = dot;
        float sp = valid ? (fmaxf(z, 0.f) + __logf(1.0f + __expf(-fabsf(z)))) : 0.f;
        float incl = sp;
#pragma unroll
        for (int o = 1; o < 64; o <<= 1) { const float v = __shfl_up(incl, o); if (lane >= o) incl += v; }
        const float w = valid ? __expf(z - (carry + incl)) : 0.f;
        const float total = __shfl(incl, 63);
        const int nk = (kb + 1) < 64 ? (kb + 1) : 64;
        const bf16* vbase = V + (size_t)kb * SBW + h * HD + 2 * lane;
        for (int kk = 0; kk < nk; ++kk) { const float wk = __builtin_bit_cast(float, __builtin_amdgcn_readlane(__builtin_bit_cast(int, w), kk));
            const unsigned vw = *(const unsigned*)(vbase - (size_t)kk * SBW); o0 += wk * bflo(vw); o1 += wk * bfhi(vw); }
        carry += total;
        if (carry > SB_THRESH) break;
    }
    *(unsigned*)(O + (size_t)t * SBW + h * HD + 2 * lane) = cvt_pk_bf16(o0, o1);
    LDS_WAIT();
}

constexpr int NPHASE = 21;

__device__ __forceinline__ Frame mk_frame() {
    Frame F; int t_ = threadIdx.x; asm volatile("" : "+v"(t_)); int b_ = blockIdx.x; asm volatile("" : "+s"(b_));
    const Args __attribute__((address_space(4)))* ka = (const Args __attribute__((address_space(4)))*)__builtin_amdgcn_kernarg_segment_ptr(); asm volatile("" : "+s"(ka));
    extern __shared__ __attribute__((aligned(16))) unsigned char lds[];
    F.ka = ka; unsigned char* w_ = ka->ws;
    F.lds = (LAS unsigned char*)lds; F.ws = w_; F.ctl = (gu32*)(w_ + WS_CTL);
    F.tid = t_; F.lane = t_ & 63; F.wave = __builtin_amdgcn_readfirstlane(t_ >> 6);
    F.G = gridDim.x; F.vcu = (F.G % 8 == 0) ? (b_ % 8) * (F.G / 8) + b_ / 8 : b_; F.bid = b_;
    return F;
}
#define WSP(off) ((bf16*)(F.ws + (off)))

#if MK_ONE_LAUNCH
#define GRID_BAR() xcd_barrier(bar)
#else
#define GRID_BAR() do { } while (0)
#endif
#ifndef PHMASK
#define PHMASK 0x7FF
#endif
#define IN(k) (lo <= (k) && (k) < hi)
#define SEAM(k) do { if (IN(k) && IN((k) + 1)) GRID_BAR(); } while (0)
template <int l> __device__ __forceinline__ void layer_phases(const int lo, const int hi, const XcdBarrier& bar) {
    constexpr int pb = l * 10;
        if (((PHMASK >> 0) & 1) && IN(pb + 0)) {
            Frame F = mk_frame(); const int gw = F.vcu * NWAVES + F.wave, NGW = F.G * NWAVES; LAS float* scr = (LAS float*)(F.lds + F.wave * 16384);
            float* xres = F.ka->out; const float* xin = (l == 0) ? F.ka->in[0] : xres;
            bf16* Win_t = WSP(WS_W + W_IN); bf16* Wglu_t = WSP(WS_W + W_GLU); bf16* Pa_t = WSP(WS_W + W_PA); bf16* Ps_t = WSP(WS_W + W_PS);
            bf16* Wout_t = WSP(WS_W + W_OUT); bf16* Wgu_t = WSP(WS_W + W_GU); bf16* Wdn_t = WSP(WS_W + W_DN_DENSE); bf16* Wdnm_t = WSP(WS_W + W_DN_MOE);
            const float* w_in = F.ka->in[4] + (size_t)l * D * INC; const float* w_glu = F.ka->in[13] + (size_t)l * SSMW * SSMW;
            const float* p_attn = F.ka->in[14] + (size_t)l * SBW * D; const float* p_ssm = F.ka->in[15] + (size_t)l * SSMW * D; const float* w_out = F.ka->in[16] + (size_t)l * D * D;
            constexpr int I_IN = (D / 64) * (INC / 32), I_GLU = (SSMW / 64) * (SSMW / 32), I_PA = (SBW / 64) * (D / 32), I_OUT = (D / 64) * (D / 32);
            constexpr int I_FG = (D / 64) * (FFD / 32), I_FD = (FFD / 64) * (D / 32);
            constexpr int I_MG = (D / 64) * (FFE / 32), I_MD = (FFE / 64) * (D / 32);
            const int n_ffn = (l == 0) ? (2 * I_FG + I_FD) : NE * (2 * I_MG + I_MD);
            const int NITEMS = I_IN + I_GLU + 2 * I_PA + I_OUT + n_ffn;
            for (int it = gw; it < NITEMS; it += NGW) {
                int r = it;
                if (r < I_IN) { transpose_mat(F, w_in, D, INC, Win_t, 0, r, scr); continue; } r -= I_IN;
                if (r < I_GLU) { transpose_mat(F, w_glu, SSMW, SSMW, Wglu_t, 0, r, scr); continue; } r -= I_GLU;
                if (r < I_PA) { transpose_mat(F, p_attn, SBW, D, Pa_t, 0, r, scr); continue; } r -= I_PA;
                if (r < I_PA) { transpose_mat(F, p_ssm, SSMW, D, Ps_t, 0, r, scr); continue; } r -= I_PA;
                if (r < I_OUT) { transpose_mat(F, w_out, D, D, Wout_t, 0, r, scr); continue; } r -= I_OUT;
                if (l == 0) {
                    if (r < I_FG) { transpose_mat(F, F.ka->in[17], D, FFD, Wgu_t, 1, r, scr); continue; } r -= I_FG;
                    if (r < I_FG) { transpose_mat(F, F.ka->in[18], D, FFD, Wgu_t, 2, r, scr); continue; } r -= I_FG;
                    transpose_mat(F, F.ka->in[19], FFD, D, Wdn_t, 0, r, scr);
                } else {
                    const int per = 2 * I_MG + I_MD, e = r / per; r -= e * per;
                    if (r < I_MG) { transpose_mat(F, F.ka->in[21] + (size_t)e * D * FFE, D, FFE, Wgu_t + (size_t)e * 2048 * D, 1, r, scr); continue; } r -= I_MG;
                    if (r < I_MG) { transpose_mat(F, F.ka->in[22] + (size_t)e * D * FFE, D, FFE, Wgu_t + (size_t)e * 2048 * D, 2, r, scr); continue; } r -= I_MG;
                    transpose_mat(F, F.ka->in[23] + (size_t)e * FFE * D, FFE, D, Wdnm_t + (size_t)e * 2048 * FFE, 0, r, scr);
                }
            }
            if (gw < SG) ssm_tables_group(F, gw, F.ka->in[5] + l * SG * SN, F.ka->in[6] + l * SG * SN, F.ka->in[7] + l * SG, F.ka->in[8] + (size_t)l * SG * SN * SP, F.ka->in[9] + (size_t)l * SG * SN * SP,
                                          F.ka->in[10] + (size_t)l * SG * SP * SN, F.ka->in[11] + (size_t)l * SG * SP * SN);
            const float* gnorm = F.ka->in[1] + l * D; bf16* XN = WSP(WS_XN);
            for (int m = gw; m < S; m += NGW) rms_row_to_bf16(F, xin + (size_t)m * D, gnorm, XN + (size_t)m * D);
        }
        SEAM(pb + 0);
        if (((PHMASK >> 1) & 1) && IN(pb + 1)) {
            Frame F = mk_frame();
            pg8::DenseSched Sd; Sd.so.init(S, INC, F.G, F.bid); Sd.A = WSP(WS_XN); Sd.Bt = WSP(WS_W + W_IN); Sd.K = D;
            pg8::EpiProj E{WSP(WS_Q), WSP(WS_GA)};
            pg8::gemm_phase<pg8::EpiProj, pg8::DenseSched, true>(F.lds, D, Sd, E);
        }
        SEAM(pb + 1);
        if (((PHMASK >> 2) & 1) && IN(pb + 2)) {
            Frame F = mk_frame(); const int gw = F.vcu * NWAVES + F.wave, NGW = F.G * NWAVES;
            bf16* Qb = WSP(WS_Q); bf16* Kb = Qb + (size_t)S * 1024; bf16* Vb = Kb + (size_t)S * 1024; bf16* Ub = Vb + (size_t)S * 1024;
            { const int g = gw >> 5, c0 = (gw & 31) * 8; if (gw < SG * 32) ssm_run<false>(F, g, c0, Ub, WSP(WS_Y), nullptr, F.lds + F.wave * 16384); }
            LAS float* qs = (LAS float*)(F.lds + F.wave * 16384); bf16* OATT = WSP(WS_OATT);
            for (int it = gw; it < NH * S; it += NGW) { const int h = it & 7, t = it >> 3; attn_item(F, h, t, Qb, Kb, Vb, OATT, qs); }
        }
        SEAM(pb + 2);
        if (((PHMASK >> 3) & 1) && IN(pb + 3)) {
            Frame F = mk_frame(); const int gw = F.vcu * NWAVES + F.wave;
            const int g = gw >> 5, c0 = (gw & 31) * 8; if (gw < SG * 32) ssm_run<true>(F, g, c0, WSP(WS_Q) + (size_t)3 * S * 1024, WSP(WS_Y), F.ka->in[12] + l * SG * SP, F.lds + F.wave * 16384);
        }
        SEAM(pb + 3);
        if (((PHMASK >> 4) & 1) && IN(pb + 4)) {
#ifndef DBG_P4
#define DBG_P4 3
#endif
            if (DBG_P4 & 1) { Frame F = mk_frame();
              pg8::DenseSched Sd; Sd.so.init(S, D, F.G, F.bid); Sd.A = WSP(WS_OATT); Sd.Bt = WSP(WS_W + W_PA); Sd.K = SBW;
              pg8::EpiGate<0> E{WSP(WS_GA), WSP(WS_GA), D};
              pg8::gemm_phase<pg8::EpiGate<0>, pg8::DenseSched, true>(F.lds, SBW, Sd, E); }
            if (DBG_P4 & 2) { Frame F = mk_frame();
              pg8::DenseSched Sd; Sd.so.init(S, SSMW, F.G, F.bid); Sd.A = WSP(WS_Y); Sd.Bt = WSP(WS_W + W_GLU); Sd.K = SSMW;
              pg8::EpiGate<1> E{WSP(WS_Y), WSP(WS_OSSM), SSMW};
              pg8::gemm_phase<pg8::EpiGate<1>, pg8::DenseSched, true>(F.lds, SSMW, Sd, E); }
        }
        SEAM(pb + 4);
        if (((PHMASK >> 5) & 1) && IN(pb + 5)) {
            Frame F = mk_frame();
            pg8::DenseSched Sd; Sd.so.init(S, D, F.G, F.bid); Sd.A = WSP(WS_OSSM); Sd.Bt = WSP(WS_W + W_PS); Sd.K = SSMW;
            pg8::EpiGate<2> E{WSP(WS_GB), WSP(WS_GA), D};
            pg8::gemm_phase<pg8::EpiGate<2>, pg8::DenseSched, true>(F.lds, SSMW, Sd, E);
        }
        SEAM(pb + 5);
        if (((PHMASK >> 6) & 1) && IN(pb + 6)) {
            Frame F = mk_frame();
            pg8::DenseSched Sd; Sd.so.init(S, D, F.G, F.bid); Sd.A = WSP(WS_GA); Sd.Bt = WSP(WS_W + W_OUT); Sd.K = D;
            float* xres = F.ka->out; const float* xin = (l == 0) ? F.ka->in[0] : xres;
            pg8::EpiResid E{xin, xres};
            pg8::gemm_phase<pg8::EpiResid, pg8::DenseSched, true>(F.lds, D, Sd, E);
        }
        SEAM(pb + 6);
        if (((PHMASK >> 7) & 1) && IN(pb + 7)) {
            Frame F = mk_frame(); const int gw = F.vcu * NWAVES + F.wave, NGW = F.G * NWAVES;
            const float* gnorm = F.ka->in[2] + l * D; bf16* XN = WSP(WS_XN); float* xres = F.ka->out;
            if (l == 0) { for (int m = gw; m < S; m += NGW) rms_row_to_bf16(F, xres + (size_t)m * D, gnorm, XN + (size_t)m * D); }
            else {
                const float* wrt = F.ka->in[20]; int* lists = (int*)(F.ws + WS_MOE); float* gatew = (float*)(F.ws + WS_MOE + (size_t)NE * S * 4);
                for (int m = gw; m < S; m += NGW) {
                    const GAS f32x4* xr = (const GAS f32x4*)(xres + (size_t)m * D) + F.lane; const GAS f32x4* gr = (const GAS f32x4*)gnorm + F.lane;
                    f32x4 v[8]; float s = 0.f; float lg[NE];
#pragma unroll
                    for (int e = 0; e < NE; ++e) lg[e] = 0.f;
                    const char* wbase = (const char*)wrt + (size_t)F.lane * (4 * NE * 4);
#pragma unroll
                    for (int j = 0; j < 8; ++j) { v[j] = xr[64 * j]; s += (v[j].x * v[j].x + v[j].y * v[j].y) + (v[j].z * v[j].z + v[j].w * v[j].w);
                        const f32x4 xg = v[j] * gr[64 * j];
                        const char* wb = wbase + (size_t)j * (256 * NE * 4); asm volatile("" : "+v"(wb) :: "memory");
                        const GAS f32x4* wp = (const GAS f32x4*)wb;
#pragma unroll
                        for (int q = 0; q < 4; ++q) { const f32x4 w0 = wp[2 * q], w1 = wp[2 * q + 1]; const float hq = xg[q];
                            lg[0] += hq * w0.x; lg[1] += hq * w0.y; lg[2] += hq * w0.z; lg[3] += hq * w0.w; lg[4] += hq * w1.x; lg[5] += hq * w1.y; lg[6] += hq * w1.z; lg[7] += hq * w1.w; } }
                    const float rstd = 1.0f / sqrtf(wave_sum(s) * (1.f / D) + RMS_EPS);
                    GAS unsigned long long* o8 = (GAS unsigned long long*)(XN + (size_t)m * D) + F.lane;
#pragma unroll
                    for (int j = 0; j < 8; ++j) { const f32x4 gg = gr[64 * j]; const f32x4 hv = v[j] * rstd * gg;
                        o8[64 * j] = (unsigned long long)pk2(hv.x, hv.y) | ((unsigned long long)pk2(hv.z, hv.w) << 32); }
#pragma unroll
                    for (int e = 0; e < NE; ++e) lg[e] = wave_sum(lg[e]) * rstd;
                    int i1 = 0; float v1 = lg[0];
#pragma unroll
                    for (int e = 1; e < NE; ++e) if (lg[e] > v1) { v1 = lg[e]; i1 = e; }
                    int i2 = (i1 == 0) ? 1 : 0; float v2 = -3.0e38f;
#pragma unroll
                    for (int e = 0; e < NE; ++e) if (e != i1 && lg[e] > v2) { v2 = lg[e]; i2 = e; }
                    if (F.lane == 0) {
                        const float e2 = __expf(v2 - v1); const float g1 = 1.0f / (1.0f + e2), g2 = e2 / (1.0f + e2);
                        const unsigned p1 = __hip_atomic_fetch_add((unsigned*)(F.ctl + CW_MOECNT + 64 * i1), 1u, RLX_AGENT);
                        const unsigned p2 = __hip_atomic_fetch_add((unsigned*)(F.ctl + CW_MOECNT + 64 * i2), 1u, RLX_AGENT);
                        lists[i1 * S + (int)p1] = 2 * m; lists[i2 * S + (int)p2] = 2 * m + 1; gatew[2 * m] = g1; gatew[2 * m + 1] = g2;
                    }
                }
            }
        }
        SEAM(pb + 7);
        if (l == 0) {
            if (((PHMASK >> 8) & 1) && IN(pb + 8)) {
                Frame F = mk_frame();
                pg8::DenseSched Sd; Sd.so.init(S, 2 * FFD, F.G, F.bid); Sd.A = WSP(WS_XN); Sd.Bt = WSP(WS_W + W_GU); Sd.K = D;
                pg8::EpiSwiglu E{WSP(WS_ACT), FFD};
                pg8::gemm_phase<pg8::EpiSwiglu, pg8::DenseSched, true>(F.lds, D, Sd, E);
            }
            SEAM(pb + 8);
            if (((PHMASK >> 9) & 1) && IN(pb + 9)) {
                Frame F = mk_frame();
                pg8::DenseSched Sd; Sd.so.init(S, D, F.G, F.bid); Sd.A = WSP(WS_ACT); Sd.Bt = WSP(WS_W + W_DN_DENSE); Sd.K = FFD;
                float* xres = F.ka->out;
                pg8::EpiResid E{xres, xres};
                pg8::gemm_phase<pg8::EpiResid, pg8::DenseSched, true>(F.lds, FFD, Sd, E);
            }
            SEAM(pb + 9);
        } else {
            if (((PHMASK >> 8) & 1) && IN(pb + 8)) {
                Frame F = mk_frame(); const int* lists = (const int*)(F.ws + WS_MOE);
                pg8::MoeSched Sm; Sm.A = WSP(WS_XN); Sm.Bt = WSP(WS_W + W_GU); Sm.K = D; Sm.gather = true; Sm.lists = lists; Sm.init((const unsigned*)(F.ctl + CW_MOECNT), F.G, F.bid);
                pg8::EpiSwiglu E{WSP(WS_ACT), FFE};
                pg8::gemm_phase<pg8::EpiSwiglu, pg8::MoeSched, true>(F.lds, D, Sm, E);
            }
            SEAM(pb + 8);
            if (((PHMASK >> 9) & 1) && IN(pb + 9)) {
                Frame F = mk_frame(); const int* lists = (const int*)(F.ws + WS_MOE); const float* gatew = (const float*)(F.ws + WS_MOE + (size_t)NE * S * 4);
                pg8::MoeSched Sm; Sm.A = WSP(WS_ACT); Sm.Bt = WSP(WS_W + W_DN_MOE); Sm.K = FFE; Sm.gather = false; Sm.lists = lists; Sm.init((const unsigned*)(F.ctl + CW_MOECNT), F.G, F.bid);
                pg8::EpiMoeDown E; E.O = WSP(WS_MOEY); E.lists = lists; E.gw = gatew;
#pragma unroll
                for (int e = 0; e < NE; ++e) E.cumv[e] = Sm.cum[e];
                pg8::gemm_phase<pg8::EpiMoeDown, pg8::MoeSched, true>(F.lds, FFE, Sm, E);
            }
            SEAM(pb + 9);
        }
}

__global__ void __launch_bounds__(NTHR, 2) trunk_fwd(Args args) {
    extern __shared__ __attribute__((aligned(16))) unsigned char lds[];
    {
        LAS unsigned char* l0 = (LAS unsigned char*)lds;
        for (int u = threadIdx.x; u < (LDS_BYTES - LDSCTL_OFF) / 4; u += NTHR) ((LAS unsigned*)(l0 + LDSCTL_OFF))[u] = 0u;
        __syncthreads();
    }
#if MK_ONE_LAUNCH
    XcdBarrier bar = xcd_barrier_post((unsigned*)(args.ws + WS_CTL) + CW_BAR, (volatile LAS unsigned*)((LAS unsigned char*)lds + MISC_OFF) + 8);
#else
    XcdBarrier bar; bar.bar = nullptr; bar.x = 0; bar.st = nullptr;
#endif
    const int lo = args.ph_lo, hi = args.ph_hi;
    layer_phases<0>(lo, hi, bar);
    layer_phases<1>(lo, hi, bar);

    if (((PHMASK >> 10) & 1) && IN(20)) {
        Frame F = mk_frame(); const int gw = F.vcu * NWAVES + F.wave, NGW = F.G * NWAVES;
        const float* gnorm = F.ka->in[3]; const bf16* MOEY = WSP(WS_MOEY); float* xres = F.ka->out;
        for (int m = gw; m < S; m += NGW) {
            GAS f32x4* xr = (GAS f32x4*)(xres + (size_t)m * D) + F.lane; const GAS f32x4* gr = (const GAS f32x4*)gnorm + F.lane;
            const GAS u32x2* y0 = (const GAS u32x2*)(MOEY + (size_t)(2 * m) * D) + F.lane; const GAS u32x2* y1 = (const GAS u32x2*)(MOEY + (size_t)(2 * m + 1) * D) + F.lane;
            f32x4 v[8]; float s = 0.f;
#pragma unroll
            for (int j = 0; j < 8; ++j) { v[j] = xr[64 * j]; const u32x2 a = y0[64 * j], b = y1[64 * j];
                v[j].x += bflo(a.x) + bflo(b.x); v[j].y += bfhi(a.x) + bfhi(b.x); v[j].z += bflo(a.y) + bflo(b.y); v[j].w += bfhi(a.y) + bfhi(b.y);
                s += (v[j].x * v[j].x + v[j].y * v[j].y) + (v[j].z * v[j].z + v[j].w * v[j].w); }
            const float rstd = 1.0f / sqrtf(wave_sum(s) * (1.f / D) + RMS_EPS);
#pragma unroll
            for (int j = 0; j < 8; ++j) { const f32x4 gg = gr[64 * j]; xr[64 * j] = v[j] * rstd * gg; }
        }
    }
#undef IN
#undef SEAM
}


#ifdef DBG_LAST
__global__ void dbg_dump(const unsigned short* buf, float* out, int ld, int f32src) {
    for (size_t i = (size_t)blockIdx.x * blockDim.x + threadIdx.x; i < (size_t)S * D; i += (size_t)gridDim.x * blockDim.x) {
        const size_t r = i / D, c = i % D;
        if (f32src) out[i] = ((const float*)buf)[r * ld + (c % ld)];
        else out[i] = __builtin_bit_cast(float, ((unsigned)buf[r * ld + (c % ld)]) << 16);
    }
}
#endif
extern "C" void kernel_launch(void* const* d_in, const int* in_sizes, int n_in, void* d_out, int out_size, void* d_ws, size_t ws_size, hipStream_t stream) {
    static int grid = 0;
    if (grid == 0) {
        if (n_in != 24 || out_size != S * D || ws_size < WS_END) { fprintf(stderr, "kernel_launch: unexpected problem (n_in %d, out %d, ws %zu); nothing launched\n", n_in, out_size, ws_size); grid = -1; return; }
        int dev = 0, cus = 0, per_cu = 0;
        if (hipGetDevice(&dev) != hipSuccess || hipDeviceGetAttribute(&cus, hipDeviceAttributeMultiprocessorCount, dev) != hipSuccess) { grid = -1; return; }
        if (hipFuncSetAttribute((const void*)trunk_fwd, hipFuncAttributeMaxDynamicSharedMemorySize, LDS_BYTES) != hipSuccess) { fprintf(stderr, "kernel_launch: hipFuncSetAttribute failed\n"); grid = -1; return; }
        if (hipOccupancyMaxActiveBlocksPerMultiprocessor(&per_cu, (const void*)trunk_fwd, NTHR, LDS_BYTES) != hipSuccess || per_cu < 1)
            fprintf(stderr, "kernel_launch: note: occupancy query reports %d workgroups per CU\n", per_cu);
        (void)hipGetLastError();
        grid = cus;
    }
    if (grid < 0) return;
    if (hipMemsetAsync((char*)d_ws + WS_CTL, 0, CTL_ZERO_BYTES, stream) != hipSuccess) return;
    Args a{};
    for (int i = 0; i < 24; ++i) a.in[i] = (const float*)d_in[i];
    a.out = (float*)d_out; a.ws = (unsigned char*)d_ws;
#if MK_ONE_LAUNCH
    a.ph_lo = 0; a.ph_hi = NPHASE;
    hipLaunchKernelGGL(trunk_fwd, dim3(grid), dim3(NTHR), LDS_BYTES, stream, a);
#else
#ifdef DBG_LAST
    for (int p = 0; p <= DBG_LAST; ++p) { a.ph_lo = p; a.ph_hi = p + 1; hipLaunchKernelGGL(trunk_fwd, dim3(grid), dim3(NTHR), LDS_BYTES, stream, a); }
    hipLaunchKernelGGL(dbg_dump, dim3(2048), dim3(256), 0, stream, (const unsigned short*)((const char*)d_ws + DBG_OFF), (float*)d_out, DBG_LD, DBG_F32);
#else
    for (int p = 0; p < NPHASE; ++p) { a.ph_lo = p; a.ph_hi = p + 1; hipLaunchKernelGGL(trunk_fwd, dim3(grid), dim3(NTHR), LDS_BYTES, stream, a); }
#endif
#endif
}
```

```cpp
#include <hip/hip_runtime.h>
#include <cstdio>
#include <cstdint>

#ifndef MK_ONE_LAUNCH
#define MK_ONE_LAUNCH 1
#endif

#define GAS __attribute__((address_space(1)))
#define LAS __attribute__((address_space(3)))
typedef unsigned short bf16;
typedef short bf16x8 __attribute__((ext_vector_type(8)));
typedef float f32x4 __attribute__((ext_vector_type(4)));
typedef float f32x16 __attribute__((ext_vector_type(16)));
typedef unsigned u32x4 __attribute__((ext_vector_type(4)));
typedef unsigned u32x2 __attribute__((ext_vector_type(2)));
typedef GAS unsigned gu32;

constexpr int S = 16384, D = 2048, INC = 8192, SBW = 1024, SSMW = 1024, NH = 8, HD = 128;
constexpr int SG = 64, SN = 64, SP = 16;
constexpr int FFD = 4096, NE = 8, FFE = 1024;
constexpr int CH = 64, NCH = S / CH;
constexpr float RMS_EPS = 1e-6f;
constexpr float SB_THRESH = 30.0f;

constexpr size_t MiB = 1u << 20;
constexpr size_t WS_CTL = 0, CTL_ZERO_BYTES = 1 * MiB;
constexpr size_t WS_SSMT = 1 * MiB;
constexpr size_t WS_MOE = 2 * MiB;
constexpr size_t WS_XE = 4 * MiB;
constexpr size_t WS_W = 12 * MiB;
constexpr size_t W_IN = 0, W_GLU = 32 * MiB, W_PA = 34 * MiB, W_PS = 38 * MiB, W_OUT = 42 * MiB, W_FFN = 50 * MiB;
constexpr size_t W_GU = W_FFN, W_DN_DENSE = W_FFN + 32 * MiB, W_DN_MOE = W_FFN + 64 * MiB;
constexpr size_t WS_XN = 158 * MiB;
constexpr size_t WS_Y = 158 * MiB, WS_OSSM = 190 * MiB;
constexpr size_t WS_Q = 222 * MiB;
constexpr size_t WS_GA = 350 * MiB, WS_GB = 414 * MiB;
constexpr size_t WS_ACT = 222 * MiB;
constexpr size_t WS_MOEY = 350 * MiB;
constexpr size_t WS_OATT = 478 * MiB;
constexpr size_t WS_END = 510 * MiB;

constexpr int CW_BAR = 4096;
constexpr int CW_MOECNT = 16384;

constexpr size_t ST_ABAR = 0;
constexpr size_t ST_ABARL = 32768;
constexpr size_t ST_BBF = 65536;
constexpr size_t ST_CTF = 65536 + 262144;

constexpr int NWAVES = 8, NTHR = 512;
constexpr int RING_BYTES = 131072, LDSCTL_OFF = RING_BYTES, MISC_OFF = LDSCTL_OFF + 320, LDS_BYTES = 147456;

#define RLX_AGENT __ATOMIC_RELAXED, __HIP_MEMORY_SCOPE_AGENT
#define LDS_WAIT() asm volatile("s_waitcnt lgkmcnt(0)" ::: "memory")
#define VM_WAIT() asm volatile("s_waitcnt vmcnt(0)" ::: "memory")

__device__ __forceinline__ unsigned f2bf(float f) { unsigned u = __builtin_bit_cast(unsigned, f); return (u + 0x7fffu + ((u >> 16) & 1u)) >> 16; }
__device__ __forceinline__ unsigned pk2(float lo, float hi) { return f2bf(lo) | (f2bf(hi) << 16); }
typedef float f32x2_t __attribute__((ext_vector_type(2)));
typedef __bf16 bf16x2_t __attribute__((ext_vector_type(2)));
__device__ __forceinline__ unsigned cvt_pk_bf16(float lo, float hi) { const f32x2_t v = {lo, hi}; const bf16x2_t b = __builtin_convertvector(v, bf16x2_t); return __builtin_bit_cast(unsigned, b); }
__device__ __forceinline__ float bflo(unsigned w) { return __builtin_bit_cast(float, w << 16); }
__device__ __forceinline__ float bfhi(unsigned w) { return __builtin_bit_cast(float, w & 0xffff0000u); }
__device__ __forceinline__ float bf2f(bf16 b) { return __builtin_bit_cast(float, ((unsigned)b) << 16); }
__device__ __forceinline__ float sigmoidf_(float x) { return __builtin_amdgcn_rcpf(1.0f + __expf(-x)); }
__device__ __forceinline__ float wave_sum(float v) {
#pragma unroll
    for (int o = 1; o < 64; o <<= 1) v += __shfl_xor(v, o);
    return v;
}

#define XB_TMO      128
#define XB_XCNT(j)  (256  + 64 * (j))
#define XB_XSUB(j)  (1280 + 64 * (j))
#define XB_XGEN(j)  (2304 + 64 * (j))
#define XB_TOP      3328
#define XB_TOPGEN   3392
#define XCD_BAR_WORDS 3456
#define XB_SPIN_CAP (1u << 18)
__device__ __forceinline__ unsigned xb_ld(unsigned* p)              { return __hip_atomic_load(p, __ATOMIC_RELAXED, __HIP_MEMORY_SCOPE_AGENT); }
__device__ __forceinline__ unsigned xb_add(unsigned* p, unsigned v) { return __hip_atomic_fetch_add(p, v, __ATOMIC_RELAXED, __HIP_MEMORY_SCOPE_AGENT); }
__device__ __forceinline__ unsigned xb_xcc_id() { return (unsigned)__builtin_amdgcn_s_getreg((3 << 11) | 20) & 0xFu; }
#define XB_SPIN(cond, bar) do { unsigned _sp = 0; while (cond) { __builtin_amdgcn_s_sleep(1); \
    if ((++_sp & 255u) == 0u) { if (xb_ld(&(bar)[XB_TMO])) break; if (_sp > XB_SPIN_CAP) { atomicAdd(&(bar)[XB_TMO], 1u); break; } } } } while (0)
struct XcdBarrier { unsigned* bar; unsigned x; volatile LAS unsigned* st; };
__device__ __forceinline__ XcdBarrier xcd_barrier_post(unsigned* bar, volatile LAS unsigned* st) {
    XcdBarrier b; b.bar = bar; b.x = xb_xcc_id(); b.st = st;
    if (threadIdx.x == 0) (void)xb_add(&bar[XB_XCNT(b.x)], 1u);
    return b;
}
__device__ __forceinline__ void xcd_barrier_complete(unsigned* bar, unsigned x, unsigned& nloc, unsigned& nx) {
    const unsigned G = gridDim.x * gridDim.y * gridDim.z;
    unsigned sum, cnt, mine, sp = 0u;
    for (;;) {
        sum = 0u; cnt = 0u; mine = 0u;
#pragma unroll
        for (unsigned j = 0; j < 16; ++j) { const unsigned c = xb_ld(&bar[XB_XCNT(j)]); sum += c; cnt += (c > 0u) ? 1u : 0u; mine = (j == x) ? c : mine; }
        if (sum == G) break;
        __builtin_amdgcn_s_sleep(1);
        if ((++sp & 255u) == 0u) { if (xb_ld(&bar[XB_TMO])) break; if (sp > XB_SPIN_CAP) { atomicAdd(&bar[XB_TMO], 1u); break; } }
    }
    nloc = mine > 0u ? mine : 1u; nx = cnt > 0u ? cnt : 1u;
}
__device__ __forceinline__ void xcd_barrier(const XcdBarrier& b) {
    asm volatile("s_waitcnt vmcnt(0)" ::: "memory");
    __syncthreads();
    if (threadIdx.x == 0) {
        unsigned* bar = b.bar;
        __builtin_amdgcn_s_waitcnt(0);
        unsigned nloc = b.st[0], nx = b.st[1];
        if (nloc == 0u) { xcd_barrier_complete(bar, b.x, nloc, nx); b.st[0] = nloc; b.st[1] = nx; }
        const unsigned old = xb_add(&bar[XB_XSUB(b.x)], 1u);
        const unsigned gen = old / nloc;
        if (old + 1u == (gen + 1u) * nloc) {
            __builtin_amdgcn_fence(__ATOMIC_RELEASE, "agent");
            asm volatile("s_waitcnt vmcnt(0)" ::: "memory");
            const unsigned og = xb_add(&bar[XB_TOP], 1u);
            const unsigned tg = og / nx;
            if (og + 1u == (tg + 1u) * nx) xb_add(&bar[XB_TOPGEN], 1u);
            else XB_SPIN(xb_ld(&bar[XB_TOPGEN]) == tg, bar);
            __builtin_amdgcn_fence(__ATOMIC_ACQUIRE, "agent");
            xb_add(&bar[XB_XGEN(b.x)], 1u);
            asm volatile("s_waitcnt vmcnt(0)" ::: "memory");
        } else {
            XB_SPIN(xb_ld(&bar[XB_XGEN(b.x)]) == gen, bar);
            __builtin_amdgcn_fence(__ATOMIC_ACQUIRE, "agent");
            asm volatile("s_waitcnt vmcnt(0)" ::: "memory");
        }
    }
    __syncthreads();
}

namespace pg8 {
constexpr int BM = 256, BK = 64, HALF = 128, HTB = HALF * BK * 2, STAGE_BYTES = 8 * HTB, NXCD = 8, WGM = 8;
__host__ __device__ __forceinline__ int lds_byte(int r, int c) { const int st = (r >> 4) * 2 + (c >> 5), rr = r & 15, cc = c & 31, ob = rr * 64 + cc * 2; return st * 1024 + (ob ^ (((ob >> 9) & 1) << 5)); }
__host__ __device__ __forceinline__ void stage_rc(int b, int& R, int& C) { const int st = b / 1024, sb = b % 1024, swz = sb ^ (((sb >> 9) & 1) << 5); R = (st >> 1) * 16 + swz / 64; C = (st & 1) * 32 + (swz % 64) / 2; }
__host__ __device__ __forceinline__ int perm32(int rho) { const int n = rho >> 4, i = rho & 15; return 8 * (i >> 2) + 4 * n + (i & 3); }

struct Unit { int pm, pn, e, nv; };

struct StaticOrder {
    int nM, nN, nwg, G, c;
    __device__ void init(int M, int N, int G_, int c_) { nM = M / BM; nN = N / BM; nwg = nM * nN; G = G_; c = c_; }
    __device__ bool next(int i, Unit& u) const {
        const long L = (long)i * G + c; if (L >= nwg) return false;
        int wgid = (int)L; { const int q = nwg / NXCD, r = nwg % NXCD, xcd = wgid % NXCD, off = wgid / NXCD; wgid = (xcd < r ? xcd * (q + 1) : r * (q + 1) + (xcd - r) * q) + off; }
        const int nig = WGM * nN, gid = wgid / nig, fm = gid * WGM, gsz = (nM - fm) < WGM ? (nM - fm) : WGM;
        u.pm = fm + ((wgid % nig) % gsz); u.pn = (wgid % nig) / gsz; u.e = 0; u.nv = 256; return true;
    }
};
struct DenseSched {
    StaticOrder so; const bf16* A; const bf16* Bt; int K;
    __device__ __forceinline__ bool next(int i, Unit& u) const { return so.next(i, u); }
    __device__ __forceinline__ const char* abase(const Unit& u) const { return (const char*)A + (size_t)u.pm * 256 * K * 2; }
    __device__ __forceinline__ const char* bbase(const Unit& u) const { return (const char*)Bt + (size_t)u.pn * 256 * K * 2; }
    __device__ __forceinline__ void aoff(const Unit&, const int (&R)[2], const int (&C)[2], unsigned (&v)[2][2]) const {
#pragma unroll
        for (int h = 0; h < 2; ++h)
#pragma unroll
            for (int i = 0; i < 2; ++i) v[h][i] = (unsigned)((h * HALF + R[i]) * K + C[i]) * 2u;
    }
};
struct MoeSched {
    const bf16* A; const bf16* Bt; int K; int G, c; bool gather;
    const int* lists; int cnt[NE]; int cum[NE + 1];
    __device__ void init(const unsigned* cntw, int G_, int c_) {
        G = G_; c = c_; int a = 0;
#pragma unroll
        for (int e = 0; e < NE; ++e) { cnt[e] = __builtin_amdgcn_readfirstlane((int)__hip_atomic_load(cntw + 64 * e, RLX_AGENT)); cum[e] = a; a += (cnt[e] + 255) >> 8; }
        cum[NE] = a;
    }
    __device__ __forceinline__ bool next(int i, Unit& u) const {
        const int L = i * G + c; if (L >= cum[NE] * 8) return false;
        const int gp = L >> 3; u.pn = L & 7; u.pm = gp; int e = 0;
#pragma unroll
        for (int k = 1; k < NE; ++k) e += (gp >= cum[k]) ? 1 : 0;
        u.e = e; int c_e = 0, b_e = 0;
#pragma unroll
        for (int k = 0; k < NE; ++k) { c_e = (k == e) ? cnt[k] : c_e; b_e = (k == e) ? cum[k] : b_e; }
        const int p = gp - b_e; int nv = c_e - 256 * p; u.nv = nv > 256 ? 256 : nv; return true;
    }
    __device__ __forceinline__ const char* abase(const Unit& u) const { return gather ? (const char*)A : (const char*)A + (size_t)u.pm * 256 * K * 2; }
    __device__ __forceinline__ const char* bbase(const Unit& u) const { return (const char*)Bt + ((size_t)u.e * 2048 + (size_t)u.pn * 256) * K * 2; }
    __device__ __forceinline__ void aoff(const Unit& u, const int (&R)[2], const int (&C)[2], unsigned (&v)[2][2]) const {
        int b_e = 0;
#pragma unroll
        for (int k = 0; k < NE; ++k) b_e = (k == u.e) ? cum[k] : b_e;
        const int p = u.pm - b_e;
#pragma unroll
        for (int h = 0; h < 2; ++h)
#pragma unroll
            for (int i = 0; i < 2; ++i) {
                const int r = h * HALF + R[i];
                if (gather) { int tok = 0; if (r < u.nv) tok = lists[u.e * S + 256 * p + r] >> 1; v[h][i] = (unsigned)(tok * K + C[i]) * 2u; }
                else v[h][i] = (unsigned)(r * K + C[i]) * 2u;
            }
    }
};

template <class Epi, class Sched, bool ALIGN_EPI>
__device__ __forceinline__ void gemm_phase(LAS unsigned char* lds, const int K, const Sched& S_, const Epi& E) {
    int tid_ = threadIdx.x; asm volatile("" : "+v"(tid_));
    const int tid = tid_, wid = __builtin_amdgcn_readfirstlane(tid >> 6), lane = tid & 63, wr = wid >> 2, wc = wid & 3, fr = lane & 15, fq = lane >> 4;
    const int nt = K / BK;
    int Rr[2], Cc[2]; unsigned voffB[2];
#pragma unroll
    for (int i = 0; i < 2; ++i) { int R, C; stage_rc(tid * 16 + i * 8192, R, C); Rr[i] = R; Cc[i] = C; const int Rb = Epi::PERM ? ((R & ~31) + perm32(R & 31)) : R; voffB[i] = (unsigned)(Rb * K + C) * 2u; }
    const size_t kstep = (size_t)(BK * 2);
    const size_t hstep = (size_t)HALF * K * 2;
    const unsigned ldsw = (unsigned)wid * 1024u;
    const int aoff = lds_byte(wr * 64 + fr, fq * 8), boff = lds_byte(wc * 32 + fr, fq * 8);
#define PG8_SA(b, h) (((b) * 2 + (h)) * HTB)
#define PG8_SB(b, h) ((4 + (b) * 2 + (h)) * HTB)
#define PG8_STAGE(bufoff, gbase, voff) do { _Pragma("unroll") for (int _i = 0; _i < 2; ++_i) \
        __builtin_amdgcn_global_load_lds((const unsigned*)((const char*)(gbase) + (voff)[_i]), (LAS unsigned*)(lds + (bufoff) + ldsw + _i * 8192), 16, 0, 0); } while (0)
#define PG8_LDA(dst, b, h) do { _Pragma("unroll") for (int m = 0; m < 4; ++m) _Pragma("unroll") for (int k = 0; k < 2; ++k) dst[m][k] = *(const LAS bf16x8*)(lds + PG8_SA(b, h) + aoff + m * 2048 + k * 1024); } while (0)
#define PG8_LDB(dst, b, h) do { _Pragma("unroll") for (int n = 0; n < 2; ++n) _Pragma("unroll") for (int k = 0; k < 2; ++k) dst[n][k] = *(const LAS bf16x8*)(lds + PG8_SB(b, h) + boff + n * 2048 + k * 1024); } while (0)
#define PG8_MMA(ai, bj, At, Bt) do { __builtin_amdgcn_s_setprio(1); _Pragma("unroll") for (int m = 0; m < 4; ++m) _Pragma("unroll") for (int n = 0; n < 2; ++n) _Pragma("unroll") for (int k = 0; k < 2; ++k) \
        acc[ai][bj][m][n] = __builtin_amdgcn_mfma_f32_16x16x32_bf16(Bt[n][k], At[m][k], acc[ai][bj][m][n], 0, 0, 0); __builtin_amdgcn_s_setprio(0); } while (0)
#define PG8_WAIT_V(n) asm volatile("s_waitcnt vmcnt(" #n ")" ::: "memory")
#define PG8_WAIT_L(n) asm volatile("s_waitcnt lgkmcnt(" #n ")" ::: "memory")
#define PG8_BAR __builtin_amdgcn_s_barrier()
#define PG8_SCHED __builtin_amdgcn_sched_barrier(0)
    Unit cur, nxt; int ui = 0;
    if (!S_.next(0, cur)) return;
    f32x4 acc[2][2][4][2];
#pragma unroll
    for (int a = 0; a < 2; ++a)
#pragma unroll
        for (int b = 0; b < 2; ++b)
#pragma unroll
            for (int m = 0; m < 4; ++m)
#pragma unroll
                for (int n = 0; n < 2; ++n) acc[a][b][m][n] = (f32x4){0.f, 0.f, 0.f, 0.f};
    bf16x8 At[4][2], B0[2][2], B1[2][2];
    const char* cA = S_.abase(cur); const char* cB = S_.bbase(cur);
    unsigned vA[2][2], nvA[2][2]; S_.aoff(cur, Rr, Cc, vA);
    PG8_STAGE(PG8_SB(0, 0), cB, voffB); PG8_STAGE(PG8_SB(0, 1), cB + hstep, voffB); PG8_STAGE(PG8_SA(0, 0), cA, vA[0]); PG8_STAGE(PG8_SA(0, 1), cA, vA[1]);
    if (wr == 1) PG8_BAR;
    PG8_WAIT_V(2); PG8_BAR;
    PG8_STAGE(PG8_SB(1, 0), cB + kstep, voffB); PG8_STAGE(PG8_SA(1, 0), cA + kstep, vA[0]); PG8_STAGE(PG8_SB(1, 1), cB + hstep + kstep, voffB);
    PG8_WAIT_V(6); PG8_BAR;
    for (;;) {
        const bool has_next = S_.next(ui + 1, nxt);
        const char* nA = has_next ? S_.abase(nxt) : cA; const char* nB = has_next ? S_.bbase(nxt) : cB;
        if (has_next) S_.aoff(nxt, Rr, Cc, nvA); else {
#pragma unroll
            for (int h = 0; h < 2; ++h)
#pragma unroll
                for (int i = 0; i < 2; ++i) nvA[h][i] = vA[h][i]; }
        for (int t = 0; t < nt; t += 2) {
            const bool last = (t == nt - 2);
            const char* a1 = cA + (size_t)(t + 1) * kstep;
            const char* a2 = last ? nA : cA + (size_t)(t + 2) * kstep; const char* b2 = last ? nB : cB + (size_t)(t + 2) * kstep;
            const char* a3 = a2 + kstep; const char* b3 = b2 + kstep;
            unsigned wA[2][2];
#pragma unroll
            for (int h = 0; h < 2; ++h)
#pragma unroll
                for (int i = 0; i < 2; ++i) wA[h][i] = last ? nvA[h][i] : vA[h][i];
            PG8_LDB(B0, 0, 0); PG8_LDB(B1, 0, 1); PG8_SCHED; PG8_LDA(At, 0, 0); PG8_STAGE(PG8_SA(1, 1), a1, vA[1]);
            PG8_WAIT_V(8); PG8_WAIT_L(0); PG8_BAR; PG8_MMA(0, 0, At, B0); PG8_MMA(0, 1, At, B1); PG8_BAR; PG8_SCHED;
            PG8_LDA(At, 0, 1); PG8_STAGE(PG8_SB(0, 0), b2, voffB); PG8_STAGE(PG8_SB(0, 1), b2 + hstep, voffB); PG8_STAGE(PG8_SA(0, 0), a2, wA[0]);
            PG8_WAIT_V(8); PG8_WAIT_L(0); PG8_BAR; PG8_MMA(1, 0, At, B0); PG8_MMA(1, 1, At, B1); PG8_BAR; PG8_SCHED;
            PG8_LDB(B0, 1, 0); PG8_LDB(B1, 1, 1); PG8_SCHED; PG8_LDA(At, 1, 0); PG8_STAGE(PG8_SA(0, 1), a2, wA[1]);
            PG8_WAIT_V(8); PG8_WAIT_L(0); PG8_BAR; PG8_MMA(0, 0, At, B0); PG8_MMA(0, 1, At, B1); PG8_BAR; PG8_SCHED;
            PG8_LDA(At, 1, 1); PG8_STAGE(PG8_SB(1, 0), b3, voffB); PG8_STAGE(PG8_SB(1, 1), b3 + hstep, voffB); PG8_STAGE(PG8_SA(1, 0), a3, wA[0]);
            PG8_WAIT_V(8); PG8_WAIT_L(0); PG8_BAR; PG8_MMA(1, 0, At, B0); PG8_MMA(1, 1, At, B1); PG8_BAR; PG8_SCHED;
        }
        if constexpr (ALIGN_EPI) { if (wr == 0) PG8_BAR; }
        E(acc, cur, wr, wc, fr, fq);
        if (!has_next) break;
#pragma unroll
        for (int a = 0; a < 2; ++a)
#pragma unroll
            for (int b = 0; b < 2; ++b)
#pragma unroll
                for (int m = 0; m < 4; ++m)
#pragma unroll
                    for (int n = 0; n < 2; ++n) acc[a][b][m][n] = (f32x4){0.f, 0.f, 0.f, 0.f};
        cur = nxt; cA = nA; cB = nB; ++ui;
#pragma unroll
        for (int h = 0; h < 2; ++h)
#pragma unroll
            for (int i = 0; i < 2; ++i) vA[h][i] = nvA[h][i];
        if constexpr (ALIGN_EPI) { if (wr == 1) PG8_BAR; }
    }
    PG8_WAIT_V(0);
    if constexpr (!ALIGN_EPI) { if (wr == 0) PG8_BAR; }
    PG8_BAR;
#undef PG8_SA
#undef PG8_SB
#undef PG8_STAGE
#undef PG8_LDA
#undef PG8_LDB
#undef PG8_MMA
#undef PG8_WAIT_V
#undef PG8_WAIT_L
#undef PG8_BAR
#undef PG8_SCHED
}

typedef const f32x4 (&AccRef)[2][2][4][2];

struct EpiProj {
    static constexpr bool PERM = true;
    bf16* Q; bf16* GA;
    __device__ __forceinline__ void operator()(AccRef acc, const Unit& u, int wr, int wc, int fr, int fq) const {
        const int row0 = u.pm * BM + wr * 64 + fr;
        if (u.pn < 16) {
            bf16* base = Q + (size_t)(u.pn >> 2) * ((size_t)S * 1024) + (u.pn & 3) * 256 + wc * 32 + 8 * fq;
#pragma unroll
            for (int ai = 0; ai < 2; ++ai)
#pragma unroll
                for (int m = 0; m < 4; ++m) { bf16* rowp = base + (size_t)(row0 + ai * HALF + m * 16) * 1024;
#pragma unroll
                    for (int bj = 0; bj < 2; ++bj) { const f32x4 v0 = acc[ai][bj][m][0], v1 = acc[ai][bj][m][1];
                        u32x4 w; w.x = cvt_pk_bf16(v0[0], v0[1]); w.y = cvt_pk_bf16(v0[2], v0[3]); w.z = cvt_pk_bf16(v1[0], v1[1]); w.w = cvt_pk_bf16(v1[2], v1[3]);
                        *(u32x4*)(rowp + bj * HALF) = w; } }
        } else {
            const int pg = u.pn - 16;
            bf16* base = GA + (size_t)(pg >> 3) * ((size_t)S * 2048) + (pg & 7) * 256 + wc * 32 + 8 * fq;
#pragma unroll
            for (int ai = 0; ai < 2; ++ai)
#pragma unroll
                for (int m = 0; m < 4; ++m) { bf16* rowp = base + (size_t)(row0 + ai * HALF + m * 16) * 2048;
#pragma unroll
                    for (int bj = 0; bj < 2; ++bj) { f32x4 v0 = acc[ai][bj][m][0], v1 = acc[ai][bj][m][1];
#pragma unroll
                        for (int j = 0; j < 4; ++j) { v0[j] = sigmoidf_(v0[j]); v1[j] = sigmoidf_(v1[j]); }
                        u32x4 w; w.x = cvt_pk_bf16(v0[0], v0[1]); w.y = cvt_pk_bf16(v0[2], v0[3]); w.z = cvt_pk_bf16(v1[0], v1[1]); w.w = cvt_pk_bf16(v1[2], v1[3]);
                        *(u32x4*)(rowp + bj * HALF) = w; } }
        }
    }
};
template <int MODE> struct EpiGate {
    static constexpr bool PERM = true;
    const bf16* G; bf16* O; int ld;
    __device__ __forceinline__ void operator()(AccRef acc, const Unit& u, int wr, int wc, int fr, int fq) const {
        const int row0 = u.pm * BM + wr * 64 + fr, col0 = u.pn * BM + wc * 32 + 8 * fq;
#pragma unroll
        for (int ai = 0; ai < 2; ++ai)
#pragma unroll
            for (int m = 0; m < 4; ++m) { const size_t off = (size_t)(row0 + ai * HALF + m * 16) * ld + col0;
#pragma unroll
                for (int bj = 0; bj < 2; ++bj) { const f32x4 v0 = acc[ai][bj][m][0], v1 = acc[ai][bj][m][1];
                    const u32x4 g = *(const u32x4*)(G + off + bj * HALF);
                    float a[8] = {v0[0], v0[1], v0[2], v0[3], v1[0], v1[1], v1[2], v1[3]};
                    const float gg[8] = {bflo(g.x), bfhi(g.x), bflo(g.y), bfhi(g.y), bflo(g.z), bfhi(g.z), bflo(g.w), bfhi(g.w)};
                    if (MODE == 1) {
#pragma unroll
                        for (int j = 0; j < 8; ++j) a[j] = gg[j] * sigmoidf_(a[j]);
                    } else if (MODE == 0) {
#pragma unroll
                        for (int j = 0; j < 8; ++j) a[j] = gg[j] * a[j];
                    } else {
                        const u32x4 o = *(const u32x4*)(O + off + bj * HALF);
                        const float oo[8] = {bflo(o.x), bfhi(o.x), bflo(o.y), bfhi(o.y), bflo(o.z), bfhi(o.z), bflo(o.w), bfhi(o.w)};
#pragma unroll
                        for (int j = 0; j < 8; ++j) a[j] = oo[j] + gg[j] * a[j];
                    }
                    u32x4 w; w.x = cvt_pk_bf16(a[0], a[1]); w.y = cvt_pk_bf16(a[2], a[3]); w.z = cvt_pk_bf16(a[4], a[5]); w.w = cvt_pk_bf16(a[6], a[7]);
                    *(u32x4*)(O + off + bj * HALF) = w; }
                asm volatile("" ::: "memory"); }
    }
};
struct EpiResid {
    static constexpr bool PERM = false;
    const float* xin; float* xout;
    __device__ __forceinline__ void operator()(AccRef acc, const Unit& u, int wr, int wc, int fr, int fq) const {
        const int row0 = u.pm * BM + wr * 64 + fr, col0 = u.pn * BM + wc * 32 + 4 * fq;
#pragma unroll
        for (int ai = 0; ai < 2; ++ai)
#pragma unroll
            for (int m = 0; m < 4; ++m) { const size_t off = (size_t)(row0 + ai * HALF + m * 16) * D + col0;
#pragma unroll
                for (int bj = 0; bj < 2; ++bj)
#pragma unroll
                    for (int n = 0; n < 2; ++n) { const f32x4 xv = *(const f32x4*)(xin + off + bj * HALF + n * 16); *(f32x4*)(xout + off + bj * HALF + n * 16) = xv + acc[ai][bj][m][n]; }
                asm volatile("" ::: "memory"); }
    }
};
struct EpiSwiglu {
    static constexpr bool PERM = true;
    bf16* O; int ld;
    __device__ __forceinline__ void operator()(AccRef acc, const Unit& u, int wr, int wc, int fr, int fq) const {
        const int row0 = u.pm * BM + wr * 64 + fr, col0 = u.pn * HALF + wc * 32 + 8 * fq;
#pragma unroll
        for (int ai = 0; ai < 2; ++ai)
#pragma unroll
            for (int m = 0; m < 4; ++m) { bf16* rowp = O + (size_t)(row0 + ai * HALF + m * 16) * ld + col0;
                float a[8];
#pragma unroll
                for (int n = 0; n < 2; ++n)
#pragma unroll
                    for (int j = 0; j < 4; ++j) { const float g = acc[ai][0][m][n][j], up = acc[ai][1][m][n][j]; a[n * 4 + j] = g * sigmoidf_(g) * up; }
                u32x4 w; w.x = cvt_pk_bf16(a[0], a[1]); w.y = cvt_pk_bf16(a[2], a[3]); w.z = cvt_pk_bf16(a[4], a[5]); w.w = cvt_pk_bf16(a[6], a[7]);
                *(u32x4*)rowp = w; }
    }
};
struct EpiMoeDown {
    static constexpr bool PERM = true;
    bf16* O; const int* lists; const float* gw; int cumv[NE];
    __device__ __forceinline__ void operator()(AccRef acc, const Unit& u, int wr, int wc, int fr, int fq) const {
        int b_e = 0;
#pragma unroll
        for (int k = 0; k < NE; ++k) b_e = (k == u.e) ? cumv[k] : b_e;
        const int p = u.pm - b_e; const int col0 = u.pn * BM + wc * 32 + 8 * fq;
#pragma unroll
        for (int ai = 0; ai < 2; ++ai)
#pragma unroll
            for (int m = 0; m < 4; ++m) { const int r = ai * HALF + wr * 64 + m * 16 + fr;
                if (r < u.nv) { const int slot = lists[u.e * S + 256 * p + r]; const float g = gw[slot]; bf16* rowp = O + (size_t)slot * D + col0;
#pragma unroll
                    for (int bj = 0; bj < 2; ++bj) { const f32x4 v0 = acc[ai][bj][m][0] * g, v1 = acc[ai][bj][m][1] * g;
                        u32x4 w; w.x = cvt_pk_bf16(v0[0], v0[1]); w.y = cvt_pk_bf16(v0[2], v0[3]); w.z = cvt_pk_bf16(v1[0], v1[1]); w.w = cvt_pk_bf16(v1[2], v1[3]);
                        *(u32x4*)(rowp + bj * HALF) = w; } } }
    }
};
}

struct Args { const float* in[24]; float* out; unsigned char* ws; int ph_lo, ph_hi; };
struct Frame {
    LAS unsigned char* lds;
    gu32* ctl;
    unsigned char* ws;
    int tid, lane, wave, vcu, G, bid;
    const struct Args __attribute__((address_space(4)))* ka;
};

__device__ __forceinline__ void transpose_item(const float* W, int K, int N, bf16* WT, int k0, int n0, int drow0, LAS float* scr, int lane) {
#pragma unroll 8
    for (int i = 0; i < 32; ++i) { const int kk = 2 * i + (lane >> 5); scr[kk * 33 + (lane & 31)] = W[(size_t)(k0 + kk) * N + n0 + (lane & 31)]; }
    LDS_WAIT(); asm volatile("" ::: "memory");
    const int c = lane & 7;
#pragma unroll
    for (int j = 0; j < 4; ++j) { const int n = (lane >> 3) + 8 * j; const LAS float* s = scr + (8 * c) * 33 + n;
        u32x4 o; o.x = pk2(s[0 * 33], s[1 * 33]); o.y = pk2(s[2 * 33], s[3 * 33]); o.z = pk2(s[4 * 33], s[5 * 33]); o.w = pk2(s[6 * 33], s[7 * 33]);
        *(GAS u32x4*)(WT + (size_t)(drow0 + n) * K + k0 + 8 * c) = o; }
    LDS_WAIT(); asm volatile("" ::: "memory");
}
__device__ __forceinline__ void transpose_mat(Frame& F, const float* W, int K, int N, bf16* WT, int il  , int item, LAS float* scr) {
    const int nblk = N / 32, kb = item / nblk, nb = item % nblk, k0 = 64 * kb, n0 = 32 * nb;
    const int drow0 = il ? ((n0 >> 7) * 256 + (n0 & 127) + (il == 2 ? 128 : 0)) : n0;
    transpose_item(W, K, N, WT, k0, n0, drow0, scr, F.lane);
}
__device__ __forceinline__ void rms_row_to_bf16(Frame& F, const float* xrow, const float* g, bf16* orow) {
    const GAS f32x4* xr = (const GAS f32x4*)xrow + F.lane; const GAS f32x4* gr = (const GAS f32x4*)g + F.lane;
    f32x4 v[8]; float s = 0.f;
#pragma unroll
    for (int j = 0; j < 8; ++j) { v[j] = xr[64 * j]; s += (v[j].x * v[j].x + v[j].y * v[j].y) + (v[j].z * v[j].z + v[j].w * v[j].w); }
    const float rstd = 1.0f / sqrtf(wave_sum(s) * (1.f / D) + RMS_EPS);
    GAS unsigned long long* o8 = (GAS unsigned long long*)orow + F.lane;
#pragma unroll
    for (int j = 0; j < 8; ++j) { const f32x4 gg = gr[64 * j]; o8[64 * j] = (unsigned long long)pk2(v[j].x * rstd * gg.x, v[j].y * rstd * gg.y) | ((unsigned long long)pk2(v[j].z * rstd * gg.z, v[j].w * rstd * gg.w) << 32); }
}

__device__ __forceinline__ void cis_d(double th, float& c, float& s) {
    const double TWO_PI = 6.283185307179586476925286766559;
    const double k = rint(th / TWO_PI); const float r = (float)(th - k * TWO_PI);
    c = cosf(r); s = sinf(r);
}
__device__ __forceinline__ void ssm_tables_group(Frame& F, int g, const float* a_re, const float* a_im, const float* log_dt, const float* b_re, const float* b_im,
                                                 const float* c_re, const float* c_im) {
    const int n = F.lane;
    const double dt = exp((double)log_dt[g]); const double ar = (double)a_re[g * SN + n], ai = (double)a_im[g * SN + n];
    float cr, sr; cis_d(dt * ai, cr, sr); const float mag = (float)exp(dt * ar);
    const float abr = mag * cr, abi = mag * sr;
    float cl, sl; cis_d(dt * ai * (double)CH, cl, sl); const float magl = (float)exp(dt * ar * (double)CH);
    float* abar = (float*)(F.ws + WS_SSMT + ST_ABAR); float* abarl = (float*)(F.ws + WS_SSMT + ST_ABARL);
    abar[(g * SN + n) * 2] = abr; abar[(g * SN + n) * 2 + 1] = abi; abarl[(g * SN + n) * 2] = magl * cl; abarl[(g * SN + n) * 2 + 1] = magl * sl;
    const float arf = (float)ar, aif = (float)ai; const float den = arf * arf + aif * aif; const float nre = abr - 1.0f;
    const float zre = (nre * arf + abi * aif) / den, zim = (abi * arf - nre * aif) / den;
    bf16* bbf = (bf16*)(F.ws + WS_SSMT + ST_BBF);
#pragma unroll
    for (int q = 0; q < SP; ++q) {
        const float br = b_re[(g * SN + n) * SP + q], bi = b_im[(g * SN + n) * SP + q];
        const float re = zre * br - zim * bi, im = zre * bi + zim * br;
        const int l = (n & 31) + 32 * (q >> 3), j = q & 7;
        bbf[((size_t)(g * 4 + (n >> 5)) * 64 + l) * 8 + j] = (bf16)f2bf(re);
        bbf[((size_t)(g * 4 + 2 + (n >> 5)) * 64 + l) * 8 + j] = (bf16)f2bf(im);
    }
    bf16* ctf = (bf16*)(F.ws + WS_SSMT + ST_CTF);
    for (int kk = 0; kk < 4; ++kk)
#pragma unroll
        for (int j = 0; j < 8; ++j) { const int l = F.lane, kp = 32 * kk + 8 * (l >> 4) + j, st = kp >> 1, p = l & 15;
            const float v = (kp & 1) ? -c_im[(g * SP + p) * SN + st] : c_re[(g * SP + p) * SN + st];
            ctf[((size_t)(g * 4 + kk) * 64 + l) * 8 + j] = (bf16)f2bf(v); }
}

constexpr int XROWB = 272;
template <bool READOUT>
__device__ __forceinline__ void ssm_run(Frame& F, int g, int c0, const bf16* U, bf16* Y, const float* dskip, LAS unsigned char* xl) {
    const int lane = F.lane, ci = lane & 31, hh = lane >> 5;
    const float* abar = (const float*)(F.ws + WS_SSMT + ST_ABAR); const float* abarl = (const float*)(F.ws + WS_SSMT + ST_ABARL);
    float* XE = (float*)(F.ws + WS_XE) + (size_t)g * NCH * 128;
    float ar[2], ai[2], lr[2], li[2];
#pragma unroll
    for (int s = 0; s < 2; ++s) { const int n = ci + 32 * s; ar[s] = abar[(g * SN + n) * 2]; ai[s] = abar[(g * SN + n) * 2 + 1]; lr[s] = abarl[(g * SN + n) * 2]; li[s] = abarl[(g * SN + n) * 2 + 1]; }
    bf16x8 bfr[4], ctf[4];
#pragma unroll
    for (int nt = 0; nt < 4; ++nt) bfr[nt] = *(const bf16x8*)((const bf16*)(F.ws + WS_SSMT + ST_BBF) + ((size_t)(g * 4 + nt) * 64 + lane) * 8);
    float dsk = 0.f;
    if (READOUT) {
#pragma unroll
        for (int kk = 0; kk < 4; ++kk) ctf[kk] = *(const bf16x8*)((const bf16*)(F.ws + WS_SSMT + ST_CTF) + ((size_t)(g * 4 + kk) * 64 + lane) * 8);
        dsk = dskip[g * SP + (lane & 15)];
    }
    float xr[2] = {0.f, 0.f}, xi[2] = {0.f, 0.f};
    if (READOUT) {
        const int cm = c0 + hh;
        for (int cc = 0; cc < cm; ++cc) {
#pragma unroll
            for (int s = 0; s < 2; ++s) { const float er = XE[cc * 128 + ci + 32 * s], ei = XE[cc * 128 + 64 + ci + 32 * s];
                const float nr = lr[s] * xr[s] - li[s] * xi[s] + er, ni = lr[s] * xi[s] + li[s] * xr[s] + ei; xr[s] = nr; xi[s] = ni; }
        }
    }
    for (int u = 0; u < 4; ++u) {
        const int cA = c0 + 2 * u, cm = cA + hh;
        if (!READOUT) { xr[0] = xr[1] = xi[0] = xi[1] = 0.f; }
        else if (u > 0) {
#pragma unroll
            for (int s = 0; s < 2; ++s) { const float er = XE[(cm - 1) * 128 + ci + 32 * s], ei = XE[(cm - 1) * 128 + 64 + ci + 32 * s];
                const float nr = lr[s] * xr[s] - li[s] * xi[s] + er, ni = lr[s] * xi[s] + li[s] * xr[s] + ei; xr[s] = nr; xi[s] = ni; }
        }
        for (int k = 0; k < 4; ++k) {
            const int seg = (ci >> 2) & 1, tok = 16 * k + 4 * (ci >> 3) + (ci & 3);
            const bf16x8 af = *(const bf16x8*)(U + (size_t)((cA + seg) * CH + tok) * SSMW + g * SP + 8 * hh);
            f32x16 bu[4];
#pragma unroll
            for (int nt = 0; nt < 4; ++nt) { f32x16 z;
#pragma unroll
                for (int r = 0; r < 16; ++r) z[r] = 0.f;
                bu[nt] = __builtin_amdgcn_mfma_f32_32x32x16_bf16(af, bfr[nt], z, 0, 0, 0); }
#pragma unroll
            for (int r = 0; r < 16; ++r) {
#pragma unroll
                for (int s = 0; s < 2; ++s) {
                    const float nr = ar[s] * xr[s] - ai[s] * xi[s] + bu[s][r], ni = ar[s] * xi[s] + ai[s] * xr[s] + bu[2 + s][r]; xr[s] = nr; xi[s] = ni;
                    if (READOUT) *(LAS unsigned*)(xl + (hh * 16 + r) * XROWB + (ci + 32 * s) * 4) = cvt_pk_bf16(nr, ni);
                }
            }
            if (READOUT) {
                LDS_WAIT();
#pragma unroll
                for (int sg = 0; sg < 2; ++sg) {
                    f32x4 y = (f32x4){0.f, 0.f, 0.f, 0.f};
#pragma unroll
                    for (int kk = 0; kk < 4; ++kk) { const bf16x8 xa = *(const LAS bf16x8*)(xl + (sg * 16 + (lane & 15)) * XROWB + (32 * kk + 8 * (lane >> 4)) * 2);
                        y = __builtin_amdgcn_mfma_f32_16x16x32_bf16(xa, ctf[kk], y, 0, 0, 0); }
#pragma unroll
                    for (int r = 0; r < 4; ++r) { const size_t idx = (size_t)((cA + sg) * CH + 16 * k + 4 * (lane >> 4) + r) * SSMW + g * SP + (lane & 15);
                        const float v = y[r] + dsk * bf2f(U[idx]);
                        const float t = tanhf(0.7978845608028654f * (v + 0.044715f * v * v * v));
                        Y[idx] = (bf16)f2bf(0.5f * v * (1.0f + t)); }
                }
                LDS_WAIT();
            }
        }
        if (!READOUT) {
#pragma unroll
            for (int s = 0; s < 2; ++s) { XE[cm * 128 + ci + 32 * s] = xr[s]; XE[cm * 128 + 64 + ci + 32 * s] = xi[s]; }
        }
    }
}

__device__ __forceinline__ void attn_item(Frame& F, int h, int qt, const bf16* Q, const bf16* K, const bf16* V, bf16* O) {
    const int lane = F.lane, ci = lane & 31, hh = lane >> 5, t0 = qt * 32;
    bf16x8 qf[8];
    { const bf16* qrow = Q + (size_t)(t0 + ci) * SBW + h * HD + 8 * hh;
#pragma unroll
      for (int ks = 0; ks < 8; ++ks) qf[ks] = *(const bf16x8*)(qrow + 16 * ks); }
    f32x16 o[4];
#pragma unroll
    for (int dt = 0; dt < 4; ++dt)
#pragma unroll
        for (int r = 0; r < 16; ++r) o[dt][r] = 0.f;
    float carry = 0.f;
    for (int kt = qt; kt >= 0; --kt) {
        const int k0 = kt * 32;
        bf16x8 kf[8];
        { const bf16* krow = K + (size_t)(k0 + ci) * SBW + h * HD + 8 * hh;
#pragma unroll
          for (int ks = 0; ks < 8; ++ks) kf[ks] = *(const bf16x8*)(krow + 16 * ks); }
        unsigned vv[2][8][2];
#pragma unroll
        for (int s = 0; s < 2; ++s)
#pragma unroll
            for (int j = 0; j < 8; ++j) { const bf16* vrow = V + (size_t)(k0 + 16 * s + 8 * (j >> 2) + 4 * hh + (j & 3)) * SBW + h * HD + 2 * ci;
                vv[s][j][0] = *(const unsigned*)vrow; vv[s][j][1] = *(const unsigned*)(vrow + 64); }
        f32x16 c;
#pragma unroll
        for (int r = 0; r < 16; ++r) c[r] = 0.f;
#pragma unroll
        for (int ks = 0; ks < 8; ++ks) c = __builtin_amdgcn_mfma_f32_32x32x16_bf16(kf[ks], qf[ks], c, 0, 0, 0);
        float z[16], sp[16];
        const bool diag = (kt == qt);
#pragma unroll
        for (int r = 0; r < 16; ++r) { const int i = (r & 3) + 8 * (r >> 2) + 4 * hh; z[r] = c[r] * 0.08838834764831845f;
            const bool valid = !diag || (i < ci);
            sp[r] = valid ? (fmaxf(z[r], 0.f) + __logf(1.0f + __expf(-fabsf(z[r])))) : 0.f; }
        float gs[4], pg[4];
#pragma unroll
        for (int g = 0; g < 4; ++g) { gs[g] = (sp[4 * g] + sp[4 * g + 1]) + (sp[4 * g + 2] + sp[4 * g + 3]); pg[g] = __shfl_xor(gs[g], 32); }
        float w[16]; float above = 0.f;
#pragma unroll
        for (int g = 3; g >= 0; --g) {
            float run = carry + above + (hh == 0 ? pg[g] : 0.f);
#pragma unroll
            for (int q = 3; q >= 0; --q) { const int r = 4 * g + q, i = q + 8 * g + 4 * hh; run += sp[r];
                const bool valid = !diag || (i < ci); w[r] = valid ? __expf(z[r] - run) : 0.f; }
            above += gs[g] + pg[g];
        }
        carry += above;
        bf16x8 pb[2];
#pragma unroll
        for (int s = 0; s < 2; ++s) { u32x4 t; t.x = cvt_pk_bf16(w[8 * s], w[8 * s + 1]); t.y = cvt_pk_bf16(w[8 * s + 2], w[8 * s + 3]); t.z = cvt_pk_bf16(w[8 * s + 4], w[8 * s + 5]); t.w = cvt_pk_bf16(w[8 * s + 6], w[8 * s + 7]);
            pb[s] = __builtin_bit_cast(bf16x8, t); }
#pragma unroll
        for (int dt = 0; dt < 4; ++dt)
#pragma unroll
            for (int s = 0; s < 2; ++s) { const unsigned sel = (dt & 1) ? 0x07060302u : 0x05040100u; u32x4 t;
                t.x = __builtin_amdgcn_perm(vv[s][1][dt >> 1], vv[s][0][dt >> 1], sel); t.y = __builtin_amdgcn_perm(vv[s][3][dt >> 1], vv[s][2][dt >> 1], sel);
                t.z = __builtin_amdgcn_perm(vv[s][5][dt >> 1], vv[s][4][dt >> 1], sel); t.w = __builtin_amdgcn_perm(vv[s][7][dt >> 1], vv[s][6][dt >> 1], sel);
                o[dt] = __builtin_amdgcn_mfma_f32_32x32x16_bf16(__builtin_bit_cast(bf16x8, t), pb[s], o[dt], 0, 0, 0); }
        if (__all(carry > SB_THRESH)) break;
    }
    bf16* orow = O + (size_t)(t0 + ci) * SBW + h * HD + 8 * hh;
#pragma unroll
    for (int dp = 0; dp < 2; ++dp)
#pragma unroll
        for (int g = 0; g < 4; ++g) { u32x4 t;
            t.x = cvt_pk_bf16(o[2 * dp][4 * g], o[2 * dp + 1][4 * g]); t.y = cvt_pk_bf16(o[2 * dp][4 * g + 1], o[2 * dp + 1][4 * g + 1]);
            t.z = cvt_pk_bf16(o[2 * dp][4 * g + 2], o[2 * dp + 1][4 * g + 2]); t.w = cvt_pk_bf16(o[2 * dp][4 * g + 3], o[2 * dp + 1][4 * g + 3]);
            *(u32x4*)(orow + 64 * dp + 16 * g) = t; }
}

constexpr int NPHASE = 21;

__device__ __forceinline__ Frame mk_frame() {
    Frame F; int t_ = threadIdx.x; asm volatile("" : "+v"(t_)); int b_ = blockIdx.x; asm volatile("" : "+s"(b_));
    const Args __attribute__((address_space(4)))* ka = (const Args __attribute__((address_space(4)))*)__builtin_amdgcn_kernarg_segment_ptr(); asm volatile("" : "+s"(ka));
    extern __shared__ __attribute__((aligned(16))) unsigned char lds[];
    F.ka = ka; unsigned char* w_ = ka->ws;
    F.lds = (LAS unsigned char*)lds; F.ws = w_; F.ctl = (gu32*)(w_ + WS_CTL);
    F.tid = t_; F.lane = t_ & 63; F.wave = __builtin_amdgcn_readfirstlane(t_ >> 6);
    F.G = gridDim.x; F.vcu = (F.G % 8 == 0) ? (b_ % 8) * (F.G / 8) + b_ / 8 : b_; F.bid = b_;
    return F;
}
#define WSP(off) ((bf16*)(F.ws + (off)))

#if MK_ONE_LAUNCH
#define GRID_BAR() xcd_barrier(bar)
#else
#define GRID_BAR() do { } while (0)
#endif
#ifndef PHMASK
#define PHMASK 0x7FF
#endif
#ifndef DUP
#define DUP 0ull
#endif
#define REPS(k) (1 + (int)(((DUP) >> (k)) & 1ull))
#define IN(k) (lo <= (k) && (k) < hi)
#define SEAM(k) do { if (IN(k) && IN((k) + 1)) GRID_BAR(); } while (0)
template <int l> __device__ __forceinline__ void layer_phases(const int lo, const int hi, const XcdBarrier& bar) {
    constexpr int pb = l * 10;
        for (int rep_ = 0; rep_ < REPS(pb + 0); ++rep_) if (((PHMASK >> 0) & 1) && IN(pb + 0)) { if (rep_ > 0) GRID_BAR();
            Frame F = mk_frame(); const int gw = F.vcu * NWAVES + F.wave, NGW = F.G * NWAVES; LAS float* scr = (LAS float*)(F.lds + F.wave * 16384);
            float* xres = F.ka->out; const float* xin = (l == 0) ? F.ka->in[0] : xres;
            bf16* Win_t = WSP(WS_W + W_IN); bf16* Wglu_t = WSP(WS_W + W_GLU); bf16* Pa_t = WSP(WS_W + W_PA); bf16* Ps_t = WSP(WS_W + W_PS);
            bf16* Wout_t = WSP(WS_W + W_OUT); bf16* Wgu_t = WSP(WS_W + W_GU); bf16* Wdn_t = WSP(WS_W + W_DN_DENSE); bf16* Wdnm_t = WSP(WS_W + W_DN_MOE);
            const float* w_in = F.ka->in[4] + (size_t)l * D * INC; const float* w_glu = F.ka->in[13] + (size_t)l * SSMW * SSMW;
            const float* p_attn = F.ka->in[14] + (size_t)l * SBW * D; const float* p_ssm = F.ka->in[15] + (size_t)l * SSMW * D; const float* w_out = F.ka->in[16] + (size_t)l * D * D;
            constexpr int I_IN = (D / 64) * (INC / 32), I_GLU = (SSMW / 64) * (SSMW / 32), I_PA = (SBW / 64) * (D / 32), I_OUT = (D / 64) * (D / 32);
            constexpr int I_FG = (D / 64) * (FFD / 32), I_FD = (FFD / 64) * (D / 32);
            constexpr int I_MG = (D / 64) * (FFE / 32), I_MD = (FFE / 64) * (D / 32);
            const int n_ffn = (l == 0) ? (2 * I_FG + I_FD) : NE * (2 * I_MG + I_MD);
            const int NITEMS = I_IN + I_GLU + 2 * I_PA + I_OUT + n_ffn;
            for (int it = gw; it < NITEMS; it += NGW) {
                int r = it;
                if (r < I_IN) { transpose_mat(F, w_in, D, INC, Win_t, 0, r, scr); continue; } r -= I_IN;
                if (r < I_GLU) { transpose_mat(F, w_glu, SSMW, SSMW, Wglu_t, 0, r, scr); continue; } r -= I_GLU;
                if (r < I_PA) { transpose_mat(F, p_attn, SBW, D, Pa_t, 0, r, scr); continue; } r -= I_PA;
                if (r < I_PA) { transpose_mat(F, p_ssm, SSMW, D, Ps_t, 0, r, scr); continue; } r -= I_PA;
                if (r < I_OUT) { transpose_mat(F, w_out, D, D, Wout_t, 0, r, scr); continue; } r -= I_OUT;
                if (l == 0) {
                    if (r < I_FG) { transpose_mat(F, F.ka->in[17], D, FFD, Wgu_t, 1, r, scr); continue; } r -= I_FG;
                    if (r < I_FG) { transpose_mat(F, F.ka->in[18], D, FFD, Wgu_t, 2, r, scr); continue; } r -= I_FG;
                    transpose_mat(F, F.ka->in[19], FFD, D, Wdn_t, 0, r, scr);
                } else {
                    const int per = 2 * I_MG + I_MD, e = r / per; r -= e * per;
                    if (r < I_MG) { transpose_mat(F, F.ka->in[21] + (size_t)e * D * FFE, D, FFE, Wgu_t + (size_t)e * 2048 * D, 1, r, scr); continue; } r -= I_MG;
                    if (r < I_MG) { transpose_mat(F, F.ka->in[22] + (size_t)e * D * FFE, D, FFE, Wgu_t + (size_t)e * 2048 * D, 2, r, scr); continue; } r -= I_MG;
                    transpose_mat(F, F.ka->in[23] + (size_t)e * FFE * D, FFE, D, Wdnm_t + (size_t)e * 2048 * FFE, 0, r, scr);
                }
            }
            if (gw < SG) ssm_tables_group(F, gw, F.ka->in[5] + l * SG * SN, F.ka->in[6] + l * SG * SN, F.ka->in[7] + l * SG, F.ka->in[8] + (size_t)l * SG * SN * SP, F.ka->in[9] + (size_t)l * SG * SN * SP,
                                          F.ka->in[10] + (size_t)l * SG * SP * SN, F.ka->in[11] + (size_t)l * SG * SP * SN);
            const float* gnorm = F.ka->in[1] + l * D; bf16* XN = WSP(WS_XN);
            for (int m = gw; m < S; m += NGW) rms_row_to_bf16(F, xin + (size_t)m * D, gnorm, XN + (size_t)m * D);
        }
        SEAM(pb + 0);
        for (int rep_ = 0; rep_ < REPS(pb + 1); ++rep_) if (((PHMASK >> 1) & 1) && IN(pb + 1)) { if (rep_ > 0) GRID_BAR();
            Frame F = mk_frame();
            pg8::DenseSched Sd; Sd.so.init(S, INC, F.G, F.bid); Sd.A = WSP(WS_XN); Sd.Bt = WSP(WS_W + W_IN); Sd.K = D;
            pg8::EpiProj E{WSP(WS_Q), WSP(WS_GA)};
            pg8::gemm_phase<pg8::EpiProj, pg8::DenseSched, true>(F.lds, D, Sd, E);
        }
        SEAM(pb + 1);
        for (int rep_ = 0; rep_ < REPS(pb + 2); ++rep_) if (((PHMASK >> 2) & 1) && IN(pb + 2)) { if (rep_ > 0) GRID_BAR();
            Frame F = mk_frame(); const int gw = F.vcu * NWAVES + F.wave, NGW = F.G * NWAVES;
            bf16* Qb = WSP(WS_Q); bf16* Kb = Qb + (size_t)S * 1024; bf16* Vb = Kb + (size_t)S * 1024; bf16* Ub = Vb + (size_t)S * 1024;
            { const int g = gw >> 5, c0 = (gw & 31) * 8; if (gw < SG * 32) ssm_run<false>(F, g, c0, Ub, WSP(WS_Y), nullptr, F.lds + F.wave * 16384); }
            bf16* OATT = WSP(WS_OATT);
            for (int it = gw; it < NH * (S / 32); it += NGW) { const int h = it & 7, qt = it >> 3; attn_item(F, h, qt, Qb, Kb, Vb, OATT); }
        }
        SEAM(pb + 2);
        for (int rep_ = 0; rep_ < REPS(pb + 3); ++rep_) if (((PHMASK >> 3) & 1) && IN(pb + 3)) { if (rep_ > 0) GRID_BAR();
            Frame F = mk_frame(); const int gw = F.vcu * NWAVES + F.wave;
            const int g = gw >> 5, c0 = (gw & 31) * 8; if (gw < SG * 32) ssm_run<true>(F, g, c0, WSP(WS_Q) + (size_t)3 * S * 1024, WSP(WS_Y), F.ka->in[12] + l * SG * SP, F.lds + F.wave * 16384);
        }
        SEAM(pb + 3);
        for (int rep_ = 0; rep_ < REPS(pb + 4); ++rep_) if (((PHMASK >> 4) & 1) && IN(pb + 4)) { if (rep_ > 0) GRID_BAR();
#ifndef DBG_P4
#define DBG_P4 3
#endif
            if (DBG_P4 & 1) { Frame F = mk_frame();
              pg8::DenseSched Sd; Sd.so.init(S, D, F.G, F.bid); Sd.A = WSP(WS_OATT); Sd.Bt = WSP(WS_W + W_PA); Sd.K = SBW;
              pg8::EpiGate<0> E{WSP(WS_GA), WSP(WS_GA), D};
              pg8::gemm_phase<pg8::EpiGate<0>, pg8::DenseSched, true>(F.lds, SBW, Sd, E); }
            if (DBG_P4 & 2) { Frame F = mk_frame();
              pg8::DenseSched Sd; Sd.so.init(S, SSMW, F.G, F.bid); Sd.A = WSP(WS_Y); Sd.Bt = WSP(WS_W + W_GLU); Sd.K = SSMW;
              pg8::EpiGate<1> E{WSP(WS_Y), WSP(WS_OSSM), SSMW};
              pg8::gemm_phase<pg8::EpiGate<1>, pg8::DenseSched, true>(F.lds, SSMW, Sd, E); }
        }
        SEAM(pb + 4);
        for (int rep_ = 0; rep_ < REPS(pb + 5); ++rep_) if (((PHMASK >> 5) & 1) && IN(pb + 5)) { if (rep_ > 0) GRID_BAR();
            Frame F = mk_frame();
            pg8::DenseSched Sd; Sd.so.init(S, D, F.G, F.bid); Sd.A = WSP(WS_OSSM); Sd.Bt = WSP(WS_W + W_PS); Sd.K = SSMW;
            pg8::EpiGate<2> E{WSP(WS_GB), WSP(WS_GA), D};
            pg8::gemm_phase<pg8::EpiGate<2>, pg8::DenseSched, true>(F.lds, SSMW, Sd, E);
        }
        SEAM(pb + 5);
        for (int rep_ = 0; rep_ < REPS(pb + 6); ++rep_) if (((PHMASK >> 6) & 1) && IN(pb + 6)) { if (rep_ > 0) GRID_BAR();
            Frame F = mk_frame();
            pg8::DenseSched Sd; Sd.so.init(S, D, F.G, F.bid); Sd.A = WSP(WS_GA); Sd.Bt = WSP(WS_W + W_OUT); Sd.K = D;
            float* xres = F.ka->out; const float* xin = (l == 0) ? F.ka->in[0] : xres;
            pg8::EpiResid E{xin, xres};
            pg8::gemm_phase<pg8::EpiResid, pg8::DenseSched, true>(F.lds, D, Sd, E);
        }
        SEAM(pb + 6);
        for (int rep_ = 0; rep_ < REPS(pb + 7); ++rep_) if (((PHMASK >> 7) & 1) && IN(pb + 7)) { if (rep_ > 0) GRID_BAR();
            Frame F = mk_frame(); const int gw = F.vcu * NWAVES + F.wave, NGW = F.G * NWAVES;
            const float* gnorm = F.ka->in[2] + l * D; bf16* XN = WSP(WS_XN); float* xres = F.ka->out;
            if (l == 0) { for (int m = gw; m < S; m += NGW) rms_row_to_bf16(F, xres + (size_t)m * D, gnorm, XN + (size_t)m * D); }
            else {
                const float* wrt = F.ka->in[20]; int* lists = (int*)(F.ws + WS_MOE); float* gatew = (float*)(F.ws + WS_MOE + (size_t)NE * S * 4);
                for (int m = gw; m < S; m += NGW) {
                    const GAS f32x4* xr = (const GAS f32x4*)(xres + (size_t)m * D) + F.lane; const GAS f32x4* gr = (const GAS f32x4*)gnorm + F.lane;
                    f32x4 v[8]; float s = 0.f; float lg[NE];
#pragma unroll
                    for (int e = 0; e < NE; ++e) lg[e] = 0.f;
                    const char* wbase = (const char*)wrt + (size_t)F.lane * (4 * NE * 4);
#pragma unroll
                    for (int j = 0; j < 8; ++j) { v[j] = xr[64 * j]; s += (v[j].x * v[j].x + v[j].y * v[j].y) + (v[j].z * v[j].z + v[j].w * v[j].w);
                        const f32x4 xg = v[j] * gr[64 * j];
                        const char* wb = wbase + (size_t)j * (256 * NE * 4); asm volatile("" : "+v"(wb) :: "memory");
                        const GAS f32x4* wp = (const GAS f32x4*)wb;
#pragma unroll
                        for (int q = 0; q < 4; ++q) { const f32x4 w0 = wp[2 * q], w1 = wp[2 * q + 1]; const float hq = xg[q];
                            lg[0] += hq * w0.x; lg[1] += hq * w0.y; lg[2] += hq * w0.z; lg[3] += hq * w0.w; lg[4] += hq * w1.x; lg[5] += hq * w1.y; lg[6] += hq * w1.z; lg[7] += hq * w1.w; } }
                    const float rstd = 1.0f / sqrtf(wave_sum(s) * (1.f / D) + RMS_EPS);
                    GAS unsigned long long* o8 = (GAS unsigned long long*)(XN + (size_t)m * D) + F.lane;
#pragma unroll
                    for (int j = 0; j < 8; ++j) { const f32x4 gg = gr[64 * j]; const f32x4 hv = v[j] * rstd * gg;
                        o8[64 * j] = (unsigned long long)pk2(hv.x, hv.y) | ((unsigned long long)pk2(hv.z, hv.w) << 32); }
#pragma unroll
                    for (int e = 0; e < NE; ++e) lg[e] = wave_sum(lg[e]) * rstd;
                    int i1 = 0; float v1 = lg[0];
#pragma unroll
                    for (int e = 1; e < NE; ++e) if (lg[e] > v1) { v1 = lg[e]; i1 = e; }
                    int i2 = (i1 == 0) ? 1 : 0; float v2 = -3.0e38f;
#pragma unroll
                    for (int e = 0; e < NE; ++e) if (e != i1 && lg[e] > v2) { v2 = lg[e]; i2 = e; }
                    if (F.lane == 0) {
                        const float e2 = __expf(v2 - v1); const float g1 = 1.0f / (1.0f + e2), g2 = e2 / (1.0f + e2);
                        const unsigned p1 = __hip_atomic_fetch_add((unsigned*)(F.ctl + CW_MOECNT + 64 * i1), 1u, RLX_AGENT);
                        const unsigned p2 = __hip_atomic_fetch_add((unsigned*)(F.ctl + CW_MOECNT + 64 * i2), 1u, RLX_AGENT);
                        lists[i1 * S + (int)p1] = 2 * m; lists[i2 * S + (int)p2] = 2 * m + 1; gatew[2 * m] = g1; gatew[2 * m + 1] = g2;
                    }
                }
            }
        }
        SEAM(pb + 7);
        if (l == 0) {
            for (int rep_ = 0; rep_ < REPS(pb + 8); ++rep_) if (((PHMASK >> 8) & 1) && IN(pb + 8)) { if (rep_ > 0) GRID_BAR();
                Frame F = mk_frame();
                pg8::DenseSched Sd; Sd.so.init(S, 2 * FFD, F.G, F.bid); Sd.A = WSP(WS_XN); Sd.Bt = WSP(WS_W + W_GU); Sd.K = D;
                pg8::EpiSwiglu E{WSP(WS_ACT), FFD};
                pg8::gemm_phase<pg8::EpiSwiglu, pg8::DenseSched, true>(F.lds, D, Sd, E);
            }
            SEAM(pb + 8);
            for (int rep_ = 0; rep_ < REPS(pb + 9); ++rep_) if (((PHMASK >> 9) & 1) && IN(pb + 9)) { if (rep_ > 0) GRID_BAR();
                Frame F = mk_frame();
                pg8::DenseSched Sd; Sd.so.init(S, D, F.G, F.bid); Sd.A = WSP(WS_ACT); Sd.Bt = WSP(WS_W + W_DN_DENSE); Sd.K = FFD;
                float* xres = F.ka->out;
                pg8::EpiResid E{xres, xres};
                pg8::gemm_phase<pg8::EpiResid, pg8::DenseSched, true>(F.lds, FFD, Sd, E);
            }
            SEAM(pb + 9);
        } else {
            for (int rep_ = 0; rep_ < REPS(pb + 8); ++rep_) if (((PHMASK >> 8) & 1) && IN(pb + 8)) { if (rep_ > 0) GRID_BAR();
                Frame F = mk_frame(); const int* lists = (const int*)(F.ws + WS_MOE);
                pg8::MoeSched Sm; Sm.A = WSP(WS_XN); Sm.Bt = WSP(WS_W + W_GU); Sm.K = D; Sm.gather = true; Sm.lists = lists; Sm.init((const unsigned*)(F.ctl + CW_MOECNT), F.G, F.bid);
                pg8::EpiSwiglu E{WSP(WS_ACT), FFE};
                pg8::gemm_phase<pg8::EpiSwiglu, pg8::MoeSched, true>(F.lds, D, Sm, E);
            }
            SEAM(pb + 8);
            for (int rep_ = 0; rep_ < REPS(pb + 9); ++rep_) if (((PHMASK >> 9) & 1) && IN(pb + 9)) { if (rep_ > 0) GRID_BAR();
                Frame F = mk_frame(); const int* lists = (const int*)(F.ws + WS_MOE); const float* gatew = (const float*)(F.ws + WS_MOE + (size_t)NE * S * 4);
                pg8::MoeSched Sm; Sm.A = WSP(WS_ACT); Sm.Bt = WSP(WS_W + W_DN_MOE); Sm.K = FFE; Sm.gather = false; Sm.lists = lists; Sm.init((const unsigned*)(F.ctl + CW_MOECNT), F.G, F.bid);
                pg8::EpiMoeDown E; E.O = WSP(WS_MOEY); E.lists = lists; E.gw = gatew;
#pragma unroll
                for (int e = 0; e < NE; ++e) E.cumv[e] = Sm.cum[e];
                pg8::gemm_phase<pg8::EpiMoeDown, pg8::MoeSched, true>(F.lds, FFE, Sm, E);
            }
            SEAM(pb + 9);
        }
}

__global__ void __launch_bounds__(NTHR, 2) trunk_fwd(Args args) {
    extern __shared__ __attribute__((aligned(16))) unsigned char lds[];
    {
        LAS unsigned char* l0 = (LAS unsigned char*)lds;
        for (int u = threadIdx.x; u < (LDS_BYTES - LDSCTL_OFF) / 4; u += NTHR) ((LAS unsigned*)(l0 + LDSCTL_OFF))[u] = 0u;
        __syncthreads();
    }
#if MK_ONE_LAUNCH
    XcdBarrier bar = xcd_barrier_post((unsigned*)(args.ws + WS_CTL) + CW_BAR, (volatile LAS unsigned*)((LAS unsigned char*)lds + MISC_OFF) + 8);
#else
    XcdBarrier bar; bar.bar = nullptr; bar.x = 0; bar.st = nullptr;
#endif
    const int lo = args.ph_lo, hi = args.ph_hi;
    layer_phases<0>(lo, hi, bar);
    layer_phases<1>(lo, hi, bar);

    if (((PHMASK >> 10) & 1) && IN(20)) {
        Frame F = mk_frame(); const int gw = F.vcu * NWAVES + F.wave, NGW = F.G * NWAVES;
        const float* gnorm = F.ka->in[3]; const bf16* MOEY = WSP(WS_MOEY); float* xres = F.ka->out;
        for (int m = gw; m < S; m += NGW) {
            GAS f32x4* xr = (GAS f32x4*)(xres + (size_t)m * D) + F.lane; const GAS f32x4* gr = (const GAS f32x4*)gnorm + F.lane;
            const GAS u32x2* y0 = (const GAS u32x2*)(MOEY + (size_t)(2 * m) * D) + F.lane; const GAS u32x2* y1 = (const GAS u32x2*)(MOEY + (size_t)(2 * m + 1) * D) + F.lane;
            f32x4 v[8]; float s = 0.f;
#pragma unroll
            for (int j = 0; j < 8; ++j) { v[j] = xr[64 * j]; const u32x2 a = y0[64 * j], b = y1[64 * j];
                v[j].x += bflo(a.x) + bflo(b.x); v[j].y += bfhi(a.x) + bfhi(b.x); v[j].z += bflo(a.y) + bflo(b.y); v[j].w += bfhi(a.y) + bfhi(b.y);
                s += (v[j].x * v[j].x + v[j].y * v[j].y) + (v[j].z * v[j].z + v[j].w * v[j].w); }
            const float rstd = 1.0f / sqrtf(wave_sum(s) * (1.f / D) + RMS_EPS);
#pragma unroll
            for (int j = 0; j < 8; ++j) { const f32x4 gg = gr[64 * j]; xr[64 * j] = v[j] * rstd * gg; }
        }
    }
#undef IN
#undef SEAM
}


#ifdef DBG_LAST
__global__ void dbg_dump(const unsigned short* buf, float* out, int ld, int f32src) {
    for (size_t i = (size_t)blockIdx.x * blockDim.x + threadIdx.x; i < (size_t)S * D; i += (size_t)gridDim.x * blockDim.x) {
        const size_t r = i / D, c = i % D;
        if (f32src) out[i] = ((const float*)buf)[r * ld + (c % ld)];
        else out[i] = __builtin_bit_cast(float, ((unsigned)buf[r * ld + (c % ld)]) << 16);
    }
}
#endif
extern "C" void kernel_launch(void* const* d_in, const int* in_sizes, int n_in, void* d_out, int out_size, void* d_ws, size_t ws_size, hipStream_t stream) {
    static int grid = 0;
    if (grid == 0) {
        if (n_in != 24 || out_size != S * D || ws_size < WS_END) { fprintf(stderr, "kernel_launch: unexpected problem (n_in %d, out %d, ws %zu); nothing launched\n", n_in, out_size, ws_size); grid = -1; return; }
        int dev = 0, cus = 0, per_cu = 0;
        if (hipGetDevice(&dev) != hipSuccess || hipDeviceGetAttribute(&cus, hipDeviceAttributeMultiprocessorCount, dev) != hipSuccess) { grid = -1; return; }
        if (hipFuncSetAttribute((const void*)trunk_fwd, hipFuncAttributeMaxDynamicSharedMemorySize, LDS_BYTES) != hipSuccess) { fprintf(stderr, "kernel_launch: hipFuncSetAttribute failed\n"); grid = -1; return; }
        if (hipOccupancyMaxActiveBlocksPerMultiprocessor(&per_cu, (const void*)trunk_fwd, NTHR, LDS_BYTES) != hipSuccess || per_cu < 1)
            fprintf(stderr, "kernel_launch: note: occupancy query reports %d workgroups per CU\n", per_cu);
        (void)hipGetLastError();
        grid = cus;
    }
    if (grid < 0) return;
    if (hipMemsetAsync((char*)d_ws + WS_CTL, 0, CTL_ZERO_BYTES, stream) != hipSuccess) return;
    Args a{};
    for (int i = 0; i < 24; ++i) a.in[i] = (const float*)d_in[i];
    a.out = (float*)d_out; a.ws = (unsigned char*)d_ws;
#if MK_ONE_LAUNCH
    a.ph_lo = 0; a.ph_hi = NPHASE;
    hipLaunchKernelGGL(trunk_fwd, dim3(grid), dim3(NTHR), LDS_BYTES, stream, a);
#else
#ifdef DBG_LAST
    for (int p = 0; p <= DBG_LAST; ++p) { a.ph_lo = p; a.ph_hi = p + 1; hipLaunchKernelGGL(trunk_fwd, dim3(grid), dim3(NTHR), LDS_BYTES, stream, a); }
    hipLaunchKernelGGL(dbg_dump, dim3(2048), dim3(256), 0, stream, (const unsigned short*)((const char*)d_ws + DBG_OFF), (float*)d_out, DBG_LD, DBG_F32);
#else
    for (int p = 0; p < NPHASE; ++p) { a.ph_lo = p; a.ph_hi = p + 1; hipLaunchKernelGGL(trunk_fwd, dim3(grid), dim3(NTHR), LDS_BYTES, stream, a); }
#endif
#endif
}
```

```cpp
#include <hip/hip_runtime.h>
#include <cstdio>
#include <cstdint>

#ifndef MK_ONE_LAUNCH
#define MK_ONE_LAUNCH 1
#endif

#define GAS __attribute__((address_space(1)))
#define LAS __attribute__((address_space(3)))
typedef unsigned short bf16;
typedef short bf16x8 __attribute__((ext_vector_type(8)));
typedef float f32x4 __attribute__((ext_vector_type(4)));
typedef float f32x16 __attribute__((ext_vector_type(16)));
typedef unsigned u32x4 __attribute__((ext_vector_type(4)));
typedef unsigned u32x2 __attribute__((ext_vector_type(2)));
typedef GAS unsigned gu32;

constexpr int S = 16384, D = 2048, INC = 8192, SBW = 1024, SSMW = 1024, NH = 8, HD = 128;
constexpr int SG = 64, SN = 64, SP = 16;
constexpr int FFD = 4096, NE = 8, FFE = 1024;
constexpr int CH = 64, NCH = S / CH;
constexpr float RMS_EPS = 1e-6f;
constexpr float SB_THRESH = 30.0f;

constexpr size_t MiB = 1u << 20;
constexpr size_t WS_CTL = 0, CTL_ZERO_BYTES = 1 * MiB;
constexpr size_t WS_SSMT = 1 * MiB;
constexpr size_t WS_MOE = 2 * MiB;
constexpr size_t WS_XE = 4 * MiB;
constexpr size_t WS_W = 12 * MiB;
constexpr size_t W_IN = 0, W_GLU = 32 * MiB, W_PA = 34 * MiB, W_PS = 38 * MiB, W_OUT = 42 * MiB, W_FFN = 50 * MiB;
constexpr size_t W_GU = W_FFN, W_DN_DENSE = W_FFN + 32 * MiB, W_DN_MOE = W_FFN + 64 * MiB;
constexpr size_t WS_XN = 158 * MiB;
constexpr size_t WS_Y = 510 * MiB, WS_OSSM = 542 * MiB;
constexpr size_t WS_Q = 222 * MiB;
constexpr size_t WS_GA = 350 * MiB, WS_GB = 414 * MiB;
constexpr size_t WS_ACT = 222 * MiB;
constexpr size_t WS_MOEY = 350 * MiB;
constexpr size_t WS_OATT = 478 * MiB;
constexpr size_t WS_END = 576 * MiB;

constexpr int CW_BAR = 4096;
constexpr int CW_MOECNT = 16384;

constexpr size_t ST_ABAR = 0;
constexpr size_t ST_ABARL = 32768;
constexpr size_t ST_BBF = 65536;
constexpr size_t ST_CTF = 65536 + 262144;

constexpr int NWAVES = 8, NTHR = 512;
constexpr int RING_BYTES = 131072, LDSCTL_OFF = RING_BYTES, MISC_OFF = LDSCTL_OFF + 320, LDS_BYTES = 147456;

#define RLX_AGENT __ATOMIC_RELAXED, __HIP_MEMORY_SCOPE_AGENT
#define LDS_WAIT() asm volatile("s_waitcnt lgkmcnt(0)" ::: "memory")
#define VM_WAIT() asm volatile("s_waitcnt vmcnt(0)" ::: "memory")

__device__ __forceinline__ unsigned f2bf(float f) { unsigned u = __builtin_bit_cast(unsigned, f); return (u + 0x7fffu + ((u >> 16) & 1u)) >> 16; }
__device__ __forceinline__ unsigned pk2(float lo, float hi) { return f2bf(lo) | (f2bf(hi) << 16); }
typedef float f32x2_t __attribute__((ext_vector_type(2)));
typedef __bf16 bf16x2_t __attribute__((ext_vector_type(2)));
__device__ __forceinline__ unsigned cvt_pk_bf16(float lo, float hi) { const f32x2_t v = {lo, hi}; const bf16x2_t b = __builtin_convertvector(v, bf16x2_t); return __builtin_bit_cast(unsigned, b); }
#define MFMA_SETTLE4(a, b, c, d) asm volatile("s_nop 15\n\ts_nop 15\n\ts_nop 15\n\ts_nop 15" : "+v"(a), "+v"(b), "+v"(c), "+v"(d))
#define MFMA_PRE(a) asm volatile("s_nop 7" : "+v"(a))
#define MFMA_SETTLE1(a) asm volatile("s_nop 15\n\ts_nop 15\n\ts_nop 15\n\ts_nop 15" : "+v"(a))
__device__ __forceinline__ float bflo(unsigned w) { return __builtin_bit_cast(float, w << 16); }
__device__ __forceinline__ float bfhi(unsigned w) { return __builtin_bit_cast(float, w & 0xffff0000u); }
__device__ __forceinline__ float bf2f(bf16 b) { return __builtin_bit_cast(float, ((unsigned)b) << 16); }
__device__ __forceinline__ float sigmoidf_(float x) { return __builtin_amdgcn_rcpf(1.0f + __expf(-x)); }
__device__ __forceinline__ float wave_sum(float v) {
#pragma unroll
    for (int o = 1; o < 64; o <<= 1) v += __shfl_xor(v, o);
    return v;
}

#define XB_TMO      128
#define XB_XCNT(j)  (256  + 64 * (j))
#define XB_XSUB(j)  (1280 + 64 * (j))
#define XB_XGEN(j)  (2304 + 64 * (j))
#define XB_TOP      3328
#define XB_TOPGEN   3392
#define XCD_BAR_WORDS 3456
#define XB_SPIN_CAP (1u << 18)
__device__ __forceinline__ unsigned xb_ld(unsigned* p)              { return __hip_atomic_load(p, __ATOMIC_RELAXED, __HIP_MEMORY_SCOPE_AGENT); }
__device__ __forceinline__ unsigned xb_add(unsigned* p, unsigned v) { return __hip_atomic_fetch_add(p, v, __ATOMIC_RELAXED, __HIP_MEMORY_SCOPE_AGENT); }
__device__ __forceinline__ unsigned xb_xcc_id() { return (unsigned)__builtin_amdgcn_s_getreg((3 << 11) | 20) & 0xFu; }
#define XB_SPIN(cond, bar) do { unsigned _sp = 0; while (cond) { __builtin_amdgcn_s_sleep(1); \
    if ((++_sp & 255u) == 0u) { if (xb_ld(&(bar)[XB_TMO])) break; if (_sp > XB_SPIN_CAP) { atomicAdd(&(bar)[XB_TMO], 1u); break; } } } } while (0)
struct XcdBarrier { unsigned* bar; unsigned x; volatile LAS unsigned* st; };
__device__ __forceinline__ XcdBarrier xcd_barrier_post(unsigned* bar, volatile LAS unsigned* st) {
    XcdBarrier b; b.bar = bar; b.x = xb_xcc_id(); b.st = st;
    if (threadIdx.x == 0) (void)xb_add(&bar[XB_XCNT(b.x)], 1u);
    return b;
}
__device__ __forceinline__ void xcd_barrier_complete(unsigned* bar, unsigned x, unsigned& nloc, unsigned& nx) {
    const unsigned G = gridDim.x * gridDim.y * gridDim.z;
    unsigned sum, cnt, mine, sp = 0u;
    for (;;) {
        sum = 0u; cnt = 0u; mine = 0u;
#pragma unroll
        for (unsigned j = 0; j < 16; ++j) { const unsigned c = xb_ld(&bar[XB_XCNT(j)]); sum += c; cnt += (c > 0u) ? 1u : 0u; mine = (j == x) ? c : mine; }
        if (sum == G) break;
        __builtin_amdgcn_s_sleep(1);
        if ((++sp & 255u) == 0u) { if (xb_ld(&bar[XB_TMO])) break; if (sp > XB_SPIN_CAP) { atomicAdd(&bar[XB_TMO], 1u); break; } }
    }
    nloc = mine > 0u ? mine : 1u; nx = cnt > 0u ? cnt : 1u;
}
__device__ __forceinline__ void xcd_barrier(const XcdBarrier& b) {
    asm volatile("s_waitcnt vmcnt(0)" ::: "memory");
    __syncthreads();
    if (threadIdx.x == 0) {
        unsigned* bar = b.bar;
        __builtin_amdgcn_s_waitcnt(0);
        unsigned nloc = b.st[0], nx = b.st[1];
        if (nloc == 0u) { xcd_barrier_complete(bar, b.x, nloc, nx); b.st[0] = nloc; b.st[1] = nx; }
        const unsigned old = xb_add(&bar[XB_XSUB(b.x)], 1u);
        const unsigned gen = old / nloc;
        if (old + 1u == (gen + 1u) * nloc) {
            __builtin_amdgcn_fence(__ATOMIC_RELEASE, "");
            asm volatile("s_waitcnt vmcnt(0)" ::: "memory");
            const unsigned og = xb_add(&bar[XB_TOP], 1u);
            const unsigned tg = og / nx;
            if (og + 1u == (tg + 1u) * nx) xb_add(&bar[XB_TOPGEN], 1u);
            else XB_SPIN(xb_ld(&bar[XB_TOPGEN]) == tg, bar);
            __builtin_amdgcn_fence(__ATOMIC_ACQUIRE, "");
            xb_add(&bar[XB_XGEN(b.x)], 1u);
            asm volatile("s_waitcnt vmcnt(0)" ::: "memory");
        } else {
            XB_SPIN(xb_ld(&bar[XB_XGEN(b.x)]) == gen, bar);
            __builtin_amdgcn_fence(__ATOMIC_ACQUIRE, "");
            asm volatile("s_waitcnt vmcnt(0)" ::: "memory");
        }
    }
    __syncthreads();
}

namespace pg8 {
constexpr int BM = 256, BK = 64, HALF = 128, HTB = HALF * BK * 2, STAGE_BYTES = 8 * HTB, NXCD = 8, WGM = 8;
__host__ __device__ __forceinline__ int lds_byte(int r, int c) { const int st = (r >> 4) * 2 + (c >> 5), rr = r & 15, cc = c & 31, ob = rr * 64 + cc * 2; return st * 1024 + (ob ^ (((ob >> 9) & 1) << 5)); }
__host__ __device__ __forceinline__ void stage_rc(int b, int& R, int& C) { const int st = b / 1024, sb = b % 1024, swz = sb ^ (((sb >> 9) & 1) << 5); R = (st >> 1) * 16 + swz / 64; C = (st & 1) * 32 + (swz % 64) / 2; }
__host__ __device__ __forceinline__ int perm32(int rho) { const int n = rho >> 4, i = rho & 15; return 8 * (i >> 2) + 4 * n + (i & 3); }

struct Unit { int pm, pn, e, nv; };

struct StaticOrder {
    int nM, nN, nwg, G, c;
    __device__ void init(int M, int N, int G_, int c_) { nM = M / BM; nN = N / BM; nwg = nM * nN; G = G_; c = c_; }
    __device__ bool next(int i, Unit& u) const {
        const long L = (long)i * G + c; if (L >= nwg) return false;
        int wgid = (int)L; { const int q = nwg / NXCD, r = nwg % NXCD, xcd = wgid % NXCD, off = wgid / NXCD; wgid = (xcd < r ? xcd * (q + 1) : r * (q + 1) + (xcd - r) * q) + off; }
        const int nig = WGM * nN, gid = wgid / nig, fm = gid * WGM, gsz = (nM - fm) < WGM ? (nM - fm) : WGM;
        u.pm = fm + ((wgid % nig) % gsz); u.pn = (wgid % nig) / gsz; u.e = 0; u.nv = 256; return true;
    }
};
struct DenseSched {
    StaticOrder so; const bf16* A; const bf16* Bt; int K;
    __device__ __forceinline__ bool next(int i, Unit& u) const { return so.next(i, u); }
    __device__ __forceinline__ const char* abase(const Unit& u) const { return (const char*)A + (size_t)u.pm * 256 * K * 2; }
    __device__ __forceinline__ const char* bbase(const Unit& u) const { return (const char*)Bt + (size_t)u.pn * 256 * K * 2; }
    __device__ __forceinline__ void aoff(const Unit&, const int (&R)[2], const int (&C)[2], unsigned (&v)[2][2]) const {
#pragma unroll
        for (int h = 0; h < 2; ++h)
#pragma unroll
            for (int i = 0; i < 2; ++i) v[h][i] = (unsigned)((h * HALF + R[i]) * K + C[i]) * 2u;
    }
};
struct MoeSched {
    const bf16* A; const bf16* Bt; int K; int G, c; bool gather;
    const int* lists; int cnt[NE]; int cum[NE + 1];
    __device__ void init(const unsigned* cntw, int G_, int c_) {
        G = G_; c = c_; int a = 0;
#pragma unroll
        for (int e = 0; e < NE; ++e) { cnt[e] = __builtin_amdgcn_readfirstlane((int)__hip_atomic_load(cntw + 64 * e, RLX_AGENT)); cum[e] = a; a += (cnt[e] + 255) >> 8; }
        cum[NE] = a;
    }
    __device__ __forceinline__ bool next(int i, Unit& u) const {
        const int L = i * G + c; if (L >= cum[NE] * 8) return false;
        const int gp = L >> 3; u.pn = L & 7; u.pm = gp; int e = 0;
#pragma unroll
        for (int k = 1; k < NE; ++k) e += (gp >= cum[k]) ? 1 : 0;
        u.e = e; int c_e = 0, b_e = 0;
#pragma unroll
        for (int k = 0; k < NE; ++k) { c_e = (k == e) ? cnt[k] : c_e; b_e = (k == e) ? cum[k] : b_e; }
        const int p = gp - b_e; int nv = c_e - 256 * p; u.nv = nv > 256 ? 256 : nv; return true;
    }
    __device__ __forceinline__ const char* abase(const Unit& u) const { return gather ? (const char*)A : (const char*)A + (size_t)u.pm * 256 * K * 2; }
    __device__ __forceinline__ const char* bbase(const Unit& u) const { return (const char*)Bt + ((size_t)u.e * 2048 + (size_t)u.pn * 256) * K * 2; }
    __device__ __forceinline__ void aoff(const Unit& u, const int (&R)[2], const int (&C)[2], unsigned (&v)[2][2]) const {
        int b_e = 0;
#pragma unroll
        for (int k = 0; k < NE; ++k) b_e = (k == u.e) ? cum[k] : b_e;
        const int p = u.pm - b_e;
#pragma unroll
        for (int h = 0; h < 2; ++h)
#pragma unroll
            for (int i = 0; i < 2; ++i) {
                const int r = h * HALF + R[i];
                if (gather) { int tok = 0; if (r < u.nv) tok = lists[u.e * S + 256 * p + r] >> 1; v[h][i] = (unsigned)(tok * K + C[i]) * 2u; }
                else v[h][i] = (unsigned)(r * K + C[i]) * 2u;
            }
    }
};

template <class Epi, class Sched, bool ALIGN_EPI>
__device__ __forceinline__ void gemm_phase(LAS unsigned char* lds, const int K, const Sched& S_, const Epi& E) {
    int tid_ = threadIdx.x; asm volatile("" : "+v"(tid_));
    const int tid = tid_, wid = __builtin_amdgcn_readfirstlane(tid >> 6), lane = tid & 63, wr = wid >> 2, wc = wid & 3, fr = lane & 15, fq = lane >> 4;
    const int nt = K / BK;
    int Rr[2], Cc[2]; unsigned voffB[2];
#pragma unroll
    for (int i = 0; i < 2; ++i) { int R, C; stage_rc(tid * 16 + i * 8192, R, C); Rr[i] = R; Cc[i] = C; const int Rb = Epi::PERM ? ((R & ~31) + perm32(R & 31)) : R; voffB[i] = (unsigned)(Rb * K + C) * 2u; }
    const size_t kstep = (size_t)(BK * 2);
    const size_t hstep = (size_t)HALF * K * 2;
    const unsigned ldsw = (unsigned)wid * 1024u;
    const int aoff = lds_byte(wr * 64 + fr, fq * 8), boff = lds_byte(wc * 32 + fr, fq * 8);
#define PG8_SA(b, h) (((b) * 2 + (h)) * HTB)
#define PG8_SB(b, h) ((4 + (b) * 2 + (h)) * HTB)
#define PG8_STAGE(bufoff, gbase, voff) do { _Pragma("unroll") for (int _i = 0; _i < 2; ++_i) \
        __builtin_amdgcn_global_load_lds((const unsigned*)((const char*)(gbase) + (voff)[_i]), (LAS unsigned*)(lds + (bufoff) + ldsw + _i * 8192), 16, 0, 0); } while (0)
#define PG8_LDA(dst, b, h) do { _Pragma("unroll") for (int m = 0; m < 4; ++m) _Pragma("unroll") for (int k = 0; k < 2; ++k) dst[m][k] = *(const LAS bf16x8*)(lds + PG8_SA(b, h) + aoff + m * 2048 + k * 1024); } while (0)
#define PG8_LDB(dst, b, h) do { _Pragma("unroll") for (int n = 0; n < 2; ++n) _Pragma("unroll") for (int k = 0; k < 2; ++k) dst[n][k] = *(const LAS bf16x8*)(lds + PG8_SB(b, h) + boff + n * 2048 + k * 1024); } while (0)
#define PG8_MMA(ai, bj, At, Bt) do { __builtin_amdgcn_s_setprio(1); _Pragma("unroll") for (int m = 0; m < 4; ++m) _Pragma("unroll") for (int n = 0; n < 2; ++n) _Pragma("unroll") for (int k = 0; k < 2; ++k) \
        acc[ai][bj][m][n] = __builtin_amdgcn_mfma_f32_16x16x32_bf16(Bt[n][k], At[m][k], acc[ai][bj][m][n], 0, 0, 0); __builtin_amdgcn_s_setprio(0); } while (0)
#define PG8_WAIT_V(n) asm volatile("s_waitcnt vmcnt(" #n ")" ::: "memory")
#define PG8_WAIT_L(n) asm volatile("s_waitcnt lgkmcnt(" #n ")" ::: "memory")
#define PG8_BAR __builtin_amdgcn_s_barrier()
#define PG8_SCHED __builtin_amdgcn_sched_barrier(0)
    Unit cur, nxt; int ui = 0;
#ifdef DBG_ZERO_LDS
    for (int z_ = tid; z_ < STAGE_BYTES / 16; z_ += 512) *(LAS u32x4*)(lds + z_ * 16) = (u32x4){0u, 0u, 0u, 0u};
    __syncthreads();
#endif
    if (!S_.next(0, cur)) return;
    f32x4 acc[2][2][4][2];
#pragma unroll
    for (int a = 0; a < 2; ++a)
#pragma unroll
        for (int b = 0; b < 2; ++b)
#pragma unroll
            for (int m = 0; m < 4; ++m)
#pragma unroll
                for (int n = 0; n < 2; ++n) acc[a][b][m][n] = (f32x4){0.f, 0.f, 0.f, 0.f};
    bf16x8 At[4][2], B0[2][2], B1[2][2];
    const char* cA = S_.abase(cur); const char* cB = S_.bbase(cur);
    unsigned vA[2][2], nvA[2][2]; S_.aoff(cur, Rr, Cc, vA);
    PG8_STAGE(PG8_SB(0, 0), cB, voffB); PG8_STAGE(PG8_SB(0, 1), cB + hstep, voffB); PG8_STAGE(PG8_SA(0, 0), cA, vA[0]); PG8_STAGE(PG8_SA(0, 1), cA, vA[1]);
    if (wr == 1) PG8_BAR;
    PG8_WAIT_V(2); PG8_BAR;
    PG8_STAGE(PG8_SB(1, 0), cB + kstep, voffB); PG8_STAGE(PG8_SA(1, 0), cA + kstep, vA[0]); PG8_STAGE(PG8_SB(1, 1), cB + hstep + kstep, voffB);
    PG8_WAIT_V(6); PG8_BAR;
    for (;;) {
        const bool has_next = S_.next(ui + 1, nxt);
        const char* nA = has_next ? S_.abase(nxt) : cA; const char* nB = has_next ? S_.bbase(nxt) : cB;
        if (has_next) S_.aoff(nxt, Rr, Cc, nvA); else {
#pragma unroll
            for (int h = 0; h < 2; ++h)
#pragma unroll
                for (int i = 0; i < 2; ++i) nvA[h][i] = vA[h][i]; }
        for (int t = 0; t < nt; t += 2) {
            const bool last = (t == nt - 2);
            const char* a1 = cA + (size_t)(t + 1) * kstep;
            const char* a2 = last ? nA : cA + (size_t)(t + 2) * kstep; const char* b2 = last ? nB : cB + (size_t)(t + 2) * kstep;
            const char* a3 = a2 + kstep; const char* b3 = b2 + kstep;
            unsigned wA[2][2];
#pragma unroll
            for (int h = 0; h < 2; ++h)
#pragma unroll
                for (int i = 0; i < 2; ++i) wA[h][i] = last ? nvA[h][i] : vA[h][i];
            PG8_LDB(B0, 0, 0); PG8_LDB(B1, 0, 1); PG8_SCHED; PG8_LDA(At, 0, 0); PG8_STAGE(PG8_SA(1, 1), a1, vA[1]);
            PG8_WAIT_V(8); PG8_WAIT_L(0); PG8_BAR; PG8_MMA(0, 0, At, B0); PG8_MMA(0, 1, At, B1); PG8_BAR; PG8_SCHED;
            PG8_LDA(At, 0, 1); PG8_STAGE(PG8_SB(0, 0), b2, voffB); PG8_STAGE(PG8_SB(0, 1), b2 + hstep, voffB); PG8_STAGE(PG8_SA(0, 0), a2, wA[0]);
            PG8_WAIT_V(8); PG8_WAIT_L(0); PG8_BAR; PG8_MMA(1, 0, At, B0); PG8_MMA(1, 1, At, B1); PG8_BAR; PG8_SCHED;
            PG8_LDB(B0, 1, 0); PG8_LDB(B1, 1, 1); PG8_SCHED; PG8_LDA(At, 1, 0); PG8_STAGE(PG8_SA(0, 1), a2, wA[1]);
            PG8_WAIT_V(8); PG8_WAIT_L(0); PG8_BAR; PG8_MMA(0, 0, At, B0); PG8_MMA(0, 1, At, B1); PG8_BAR; PG8_SCHED;
            PG8_LDA(At, 1, 1); PG8_STAGE(PG8_SB(1, 0), b3, voffB); PG8_STAGE(PG8_SB(1, 1), b3 + hstep, voffB); PG8_STAGE(PG8_SA(1, 0), a3, wA[0]);
            PG8_WAIT_V(8); PG8_WAIT_L(0); PG8_BAR; PG8_MMA(1, 0, At, B0); PG8_MMA(1, 1, At, B1); PG8_BAR; PG8_SCHED;
        }
        if constexpr (ALIGN_EPI) { if (wr == 0) PG8_BAR; }
        asm volatile("s_nop 15\n\ts_nop 15\n\ts_nop 15\n\ts_nop 15" ::: "memory");
        E(acc, cur, wr, wc, fr, fq);
        if (!has_next) break;
#pragma unroll
        for (int a = 0; a < 2; ++a)
#pragma unroll
            for (int b = 0; b < 2; ++b)
#pragma unroll
                for (int m = 0; m < 4; ++m)
#pragma unroll
                    for (int n = 0; n < 2; ++n) acc[a][b][m][n] = (f32x4){0.f, 0.f, 0.f, 0.f};
        cur = nxt; cA = nA; cB = nB; ++ui;
#pragma unroll
        for (int h = 0; h < 2; ++h)
#pragma unroll
            for (int i = 0; i < 2; ++i) vA[h][i] = nvA[h][i];
        if constexpr (ALIGN_EPI) { if (wr == 1) PG8_BAR; }
    }
    PG8_WAIT_V(0);
    if constexpr (!ALIGN_EPI) { if (wr == 0) PG8_BAR; }
    PG8_BAR;
#undef PG8_SA
#undef PG8_SB
#undef PG8_STAGE
#undef PG8_LDA
#undef PG8_LDB
#undef PG8_MMA
#undef PG8_WAIT_V
#undef PG8_WAIT_L
#undef PG8_BAR
#undef PG8_SCHED
}

typedef const f32x4 (&AccRef)[2][2][4][2];

struct EpiProj {
    static constexpr bool PERM = true;
    bf16* Q; bf16* GA;
    __device__ __forceinline__ void operator()(AccRef acc, const Unit& u, int wr, int wc, int fr, int fq) const {
        const int row0 = u.pm * BM + wr * 64 + fr;
        if (u.pn < 16) {
            bf16* base = Q + (size_t)(u.pn >> 2) * ((size_t)S * 1024) + (u.pn & 3) * 256 + wc * 32 + 8 * fq;
#pragma unroll
            for (int ai = 0; ai < 2; ++ai)
#pragma unroll
                for (int m = 0; m < 4; ++m) { bf16* rowp = base + (size_t)(row0 + ai * HALF + m * 16) * 1024;
#pragma unroll
                    for (int bj = 0; bj < 2; ++bj) { const f32x4 v0 = acc[ai][bj][m][0], v1 = acc[ai][bj][m][1];
                        u32x4 w; w.x = cvt_pk_bf16(v0[0], v0[1]); w.y = cvt_pk_bf16(v0[2], v0[3]); w.z = cvt_pk_bf16(v1[0], v1[1]); w.w = cvt_pk_bf16(v1[2], v1[3]);
                        *(u32x4*)(rowp + bj * HALF) = w; } }
        } else {
            const int pg = u.pn - 16;
            bf16* base = GA + (size_t)(pg >> 3) * ((size_t)S * 2048) + (pg & 7) * 256 + wc * 32 + 8 * fq;
#pragma unroll
            for (int ai = 0; ai < 2; ++ai)
#pragma unroll
                for (int m = 0; m < 4; ++m) { bf16* rowp = base + (size_t)(row0 + ai * HALF + m * 16) * 2048;
#pragma unroll
                    for (int bj = 0; bj < 2; ++bj) { f32x4 v0 = acc[ai][bj][m][0], v1 = acc[ai][bj][m][1];
#pragma unroll
                        for (int j = 0; j < 4; ++j) { v0[j] = sigmoidf_(v0[j]); v1[j] = sigmoidf_(v1[j]); }
                        u32x4 w; w.x = cvt_pk_bf16(v0[0], v0[1]); w.y = cvt_pk_bf16(v0[2], v0[3]); w.z = cvt_pk_bf16(v1[0], v1[1]); w.w = cvt_pk_bf16(v1[2], v1[3]);
                        *(u32x4*)(rowp + bj * HALF) = w; } }
        }
    }
};
template <int MODE> struct EpiGate {
    static constexpr bool PERM = true;
    const bf16* G; bf16* O; int ld;
    __device__ __forceinline__ void operator()(AccRef acc, const Unit& u, int wr, int wc, int fr, int fq) const {
        const int row0 = u.pm * BM + wr * 64 + fr, col0 = u.pn * BM + wc * 32 + 8 * fq;
#pragma unroll
        for (int ai = 0; ai < 2; ++ai) {
            u32x4 gv[4][2], ov[4][2];
#pragma unroll
            for (int m = 0; m < 4; ++m)
#pragma unroll
                for (int bj = 0; bj < 2; ++bj) { const size_t off = (size_t)(row0 + ai * HALF + m * 16) * ld + col0 + bj * HALF;
                    gv[m][bj] = *(const u32x4*)(G + off); if (MODE == 2) ov[m][bj] = *(const u32x4*)(O + off); }
#pragma unroll
            for (int m = 0; m < 4; ++m)
#pragma unroll
                for (int bj = 0; bj < 2; ++bj) { const size_t off = (size_t)(row0 + ai * HALF + m * 16) * ld + col0 + bj * HALF;
                    const f32x4 v0 = acc[ai][bj][m][0], v1 = acc[ai][bj][m][1]; const u32x4 g = gv[m][bj];
                    float a[8] = {v0[0], v0[1], v0[2], v0[3], v1[0], v1[1], v1[2], v1[3]};
                    const float gg[8] = {bflo(g.x), bfhi(g.x), bflo(g.y), bfhi(g.y), bflo(g.z), bfhi(g.z), bflo(g.w), bfhi(g.w)};
                    if (MODE == 1) {
#pragma unroll
                        for (int j = 0; j < 8; ++j) a[j] = gg[j] * sigmoidf_(a[j]);
                    } else if (MODE == 0) {
#pragma unroll
                        for (int j = 0; j < 8; ++j) a[j] = gg[j] * a[j];
                    } else {
                        const u32x4 o = ov[m][bj];
                        const float oo[8] = {bflo(o.x), bfhi(o.x), bflo(o.y), bfhi(o.y), bflo(o.z), bfhi(o.z), bflo(o.w), bfhi(o.w)};
#pragma unroll
                        for (int j = 0; j < 8; ++j) a[j] = oo[j] + gg[j] * a[j];
                    }
                    u32x4 w; w.x = cvt_pk_bf16(a[0], a[1]); w.y = cvt_pk_bf16(a[2], a[3]); w.z = cvt_pk_bf16(a[4], a[5]); w.w = cvt_pk_bf16(a[6], a[7]);
                    *(u32x4*)(O + off) = w; }
            asm volatile("" ::: "memory");
        }
    }
};
struct EpiResid {
    static constexpr bool PERM = false;
    const float* xin; float* xout;
    __device__ __forceinline__ void operator()(AccRef acc, const Unit& u, int wr, int wc, int fr, int fq) const {
        const int row0 = u.pm * BM + wr * 64 + fr, col0 = u.pn * BM + wc * 32 + 4 * fq;
#pragma unroll
        for (int ai = 0; ai < 2; ++ai) {
            f32x4 xv[4][2][2];
#pragma unroll
            for (int m = 0; m < 4; ++m)
#pragma unroll
                for (int bj = 0; bj < 2; ++bj)
#pragma unroll
                    for (int n = 0; n < 2; ++n) xv[m][bj][n] = *(const f32x4*)(xin + (size_t)(row0 + ai * HALF + m * 16) * D + col0 + bj * HALF + n * 16);
#pragma unroll
            for (int m = 0; m < 4; ++m)
#pragma unroll
                for (int bj = 0; bj < 2; ++bj)
#pragma unroll
                    for (int n = 0; n < 2; ++n) *(f32x4*)(xout + (size_t)(row0 + ai * HALF + m * 16) * D + col0 + bj * HALF + n * 16) = xv[m][bj][n] + acc[ai][bj][m][n];
            asm volatile("" ::: "memory");
        }
    }
};
struct EpiSwiglu {
    static constexpr bool PERM = true;
    bf16* O; int ld;
    __device__ __forceinline__ void operator()(AccRef acc, const Unit& u, int wr, int wc, int fr, int fq) const {
        const int row0 = u.pm * BM + wr * 64 + fr, col0 = u.pn * HALF + wc * 32 + 8 * fq;
#pragma unroll
        for (int ai = 0; ai < 2; ++ai)
#pragma unroll
            for (int m = 0; m < 4; ++m) { bf16* rowp = O + (size_t)(row0 + ai * HALF + m * 16) * ld + col0;
                float a[8];
#pragma unroll
                for (int n = 0; n < 2; ++n)
#pragma unroll
                    for (int j = 0; j < 4; ++j) { const float g = acc[ai][0][m][n][j], up = acc[ai][1][m][n][j]; a[n * 4 + j] = g * sigmoidf_(g) * up; }
                u32x4 w; w.x = cvt_pk_bf16(a[0], a[1]); w.y = cvt_pk_bf16(a[2], a[3]); w.z = cvt_pk_bf16(a[4], a[5]); w.w = cvt_pk_bf16(a[6], a[7]);
                *(u32x4*)rowp = w; }
    }
};
struct EpiMoeDown {
    static constexpr bool PERM = true;
    bf16* O; const int* lists; const float* gw; int cumv[NE];
    __device__ __forceinline__ void operator()(AccRef acc, const Unit& u, int wr, int wc, int fr, int fq) const {
        int b_e = 0;
#pragma unroll
        for (int k = 0; k < NE; ++k) b_e = (k == u.e) ? cumv[k] : b_e;
        const int p = u.pm - b_e; const int col0 = u.pn * BM + wc * 32 + 8 * fq;
#pragma unroll
        for (int ai = 0; ai < 2; ++ai)
#pragma unroll
            for (int m = 0; m < 4; ++m) { const int r = ai * HALF + wr * 64 + m * 16 + fr;
                if (r < u.nv) { const int slot = lists[u.e * S + 256 * p + r]; const float g = gw[slot]; bf16* rowp = O + (size_t)slot * D + col0;
#pragma unroll
                    for (int bj = 0; bj < 2; ++bj) { const f32x4 v0 = acc[ai][bj][m][0] * g, v1 = acc[ai][bj][m][1] * g;
                        u32x4 w; w.x = cvt_pk_bf16(v0[0], v0[1]); w.y = cvt_pk_bf16(v0[2], v0[3]); w.z = cvt_pk_bf16(v1[0], v1[1]); w.w = cvt_pk_bf16(v1[2], v1[3]);
                        *(u32x4*)(rowp + bj * HALF) = w; } } }
    }
};
}

struct Args { const float* in[24]; float* out; unsigned char* ws; int ph_lo, ph_hi; };
struct Frame {
    LAS unsigned char* lds;
    gu32* ctl;
    unsigned char* ws;
    int tid, lane, wave, vcu, G, bid;
    const struct Args __attribute__((address_space(4)))* ka;
};

__device__ __forceinline__ void transpose_item(const float* W, int K, int N, bf16* WT, int k0, int n0, int drow0, LAS float* scr, int lane) {
#pragma unroll 8
    for (int i = 0; i < 32; ++i) { const int kk = 2 * i + (lane >> 5); scr[kk * 33 + (lane & 31)] = W[(size_t)(k0 + kk) * N + n0 + (lane & 31)]; }
    LDS_WAIT(); asm volatile("" ::: "memory");
    const int c = lane & 7;
#pragma unroll
    for (int j = 0; j < 4; ++j) { const int n = (lane >> 3) + 8 * j; const LAS float* s = scr + (8 * c) * 33 + n;
        u32x4 o; o.x = pk2(s[0 * 33], s[1 * 33]); o.y = pk2(s[2 * 33], s[3 * 33]); o.z = pk2(s[4 * 33], s[5 * 33]); o.w = pk2(s[6 * 33], s[7 * 33]);
        *(GAS u32x4*)(WT + (size_t)(drow0 + n) * K + k0 + 8 * c) = o; }
    LDS_WAIT(); asm volatile("" ::: "memory");
}
__device__ __forceinline__ void transpose_mat(Frame& F, const float* W, int K, int N, bf16* WT, int il  , int item, LAS float* scr) {
    const int nblk = N / 32, kb = item / nblk, nb = item % nblk, k0 = 64 * kb, n0 = 32 * nb;
    const int drow0 = il ? ((n0 >> 7) * 256 + (n0 & 127) + (il == 2 ? 128 : 0)) : n0;
    transpose_item(W, K, N, WT, k0, n0, drow0, scr, F.lane);
}
__device__ __forceinline__ void rms_row_to_bf16(Frame& F, const float* xrow, const float* g, bf16* orow) {
    const GAS f32x4* xr = (const GAS f32x4*)xrow + F.lane; const GAS f32x4* gr = (const GAS f32x4*)g + F.lane;
    f32x4 v[8]; float s = 0.f;
#pragma unroll
    for (int j = 0; j < 8; ++j) { v[j] = xr[64 * j]; s += (v[j].x * v[j].x + v[j].y * v[j].y) + (v[j].z * v[j].z + v[j].w * v[j].w); }
    const float rstd = 1.0f / sqrtf(wave_sum(s) * (1.f / D) + RMS_EPS);
    GAS unsigned long long* o8 = (GAS unsigned long long*)orow + F.lane;
#pragma unroll
    for (int j = 0; j < 8; ++j) { const f32x4 gg = gr[64 * j]; o8[64 * j] = (unsigned long long)pk2(v[j].x * rstd * gg.x, v[j].y * rstd * gg.y) | ((unsigned long long)pk2(v[j].z * rstd * gg.z, v[j].w * rstd * gg.w) << 32); }
}

__device__ __forceinline__ void cis_d(double th, float& c, float& s) {
    const double TWO_PI = 6.283185307179586476925286766559;
    const double k = rint(th / TWO_PI); const float r = (float)(th - k * TWO_PI);
    c = cosf(r); s = sinf(r);
}
__device__ __forceinline__ void ssm_tables_group(Frame& F, int g, const float* a_re, const float* a_im, const float* log_dt, const float* b_re, const float* b_im,
                                                 const float* c_re, const float* c_im) {
    const int n = F.lane;
    const double dt = exp((double)log_dt[g]); const double ar = (double)a_re[g * SN + n], ai = (double)a_im[g * SN + n];
    float cr, sr; cis_d(dt * ai, cr, sr); const float mag = (float)exp(dt * ar);
    const float abr = mag * cr, abi = mag * sr;
    float cl, sl; cis_d(dt * ai * (double)CH, cl, sl); const float magl = (float)exp(dt * ar * (double)CH);
    float* abar = (float*)(F.ws + WS_SSMT + ST_ABAR); float* abarl = (float*)(F.ws + WS_SSMT + ST_ABARL);
    abar[(g * SN + n) * 2] = abr; abar[(g * SN + n) * 2 + 1] = abi; abarl[(g * SN + n) * 2] = magl * cl; abarl[(g * SN + n) * 2 + 1] = magl * sl;
    const float arf = (float)ar, aif = (float)ai; const float den = arf * arf + aif * aif; const float nre = abr - 1.0f;
    const float zre = (nre * arf + abi * aif) / den, zim = (abi * arf - nre * aif) / den;
    bf16* bbf = (bf16*)(F.ws + WS_SSMT + ST_BBF);
#pragma unroll
    for (int q = 0; q < SP; ++q) {
        const float br = b_re[(g * SN + n) * SP + q], bi = b_im[(g * SN + n) * SP + q];
        const float re = zre * br - zim * bi, im = zre * bi + zim * br;
        const int l = (n & 31) + 32 * (q >> 3), j = q & 7;
        bbf[((size_t)(g * 4 + (n >> 5)) * 64 + l) * 8 + j] = (bf16)f2bf(re);
        bbf[((size_t)(g * 4 + 2 + (n >> 5)) * 64 + l) * 8 + j] = (bf16)f2bf(im);
    }
    bf16* ctf = (bf16*)(F.ws + WS_SSMT + ST_CTF);
    for (int kk = 0; kk < 4; ++kk)
#pragma unroll
        for (int j = 0; j < 8; ++j) { const int l = F.lane, kp = 32 * kk + 8 * (l >> 4) + j, st = kp >> 1, p = l & 15;
            const float v = (kp & 1) ? -c_im[(g * SP + p) * SN + st] : c_re[(g * SP + p) * SN + st];
            ctf[((size_t)(g * 4 + kk) * 64 + l) * 8 + j] = (bf16)f2bf(v); }
}

constexpr int XROWB = 272;
constexpr size_t WS_RT = 574 * MiB;
__device__ __forceinline__ void cmul_acc(float& xr, float& xi, float ar, float ai, float br, float bi) {
    const float nr = ar * xr - ai * xi + br, ni = ar * xi + ai * xr + bi; xr = nr; xi = ni;
}
template <bool READOUT>
__device__ __forceinline__ void ssm_run(Frame& F, int g, int run, const bf16* U, bf16* Y, const float* dskip, LAS unsigned char* xl) {
    const int lane = F.lane, ci = lane & 31, hh = lane >> 5, c0 = run * 8;
    const float* abar = (const float*)(F.ws + WS_SSMT + ST_ABAR); const float* abarl = (const float*)(F.ws + WS_SSMT + ST_ABARL);
    float* XE = (float*)(F.ws + WS_XE) + (size_t)g * NCH * 128;
    float* RT = (float*)(F.ws + WS_RT) + (size_t)g * 64 * 128;
    float ar[2], ai[2], lr[2], li[2];
#pragma unroll
    for (int s = 0; s < 2; ++s) { const int n = ci + 32 * s; ar[s] = abar[(g * SN + n) * 2]; ai[s] = abar[(g * SN + n) * 2 + 1]; lr[s] = abarl[(g * SN + n) * 2]; li[s] = abarl[(g * SN + n) * 2 + 1]; }
    bf16x8 bfr[4], ctf[4];
#pragma unroll
    for (int nt = 0; nt < 4; ++nt) bfr[nt] = *(const bf16x8*)((const bf16*)(F.ws + WS_SSMT + ST_BBF) + ((size_t)(g * 4 + nt) * 64 + lane) * 8);
    float dsk = 0.f;
    float xr[2] = {0.f, 0.f}, xi[2] = {0.f, 0.f};
    float xer[4][2], xei[4][2];
    float l2r[2], l2i[2];
#pragma unroll
    for (int s = 0; s < 2; ++s) { l2r[s] = lr[s] * lr[s] - li[s] * li[s]; l2i[s] = 2.f * lr[s] * li[s]; }
    if (READOUT) {
#pragma unroll
        for (int kk = 0; kk < 4; ++kk) ctf[kk] = *(const bf16x8*)((const bf16*)(F.ws + WS_SSMT + ST_CTF) + ((size_t)(g * 4 + kk) * 64 + lane) * 8);
        dsk = dskip[g * SP + (lane & 15)];
#pragma unroll
        for (int u = 0; u < 4; ++u)
#pragma unroll
            for (int s = 0; s < 2; ++s) { const int cx = (u == 0) ? c0 : (c0 + 2 * u + hh - 1); xer[u][s] = XE[cx * 128 + ci + 32 * s]; xei[u][s] = XE[cx * 128 + 64 + ci + 32 * s]; }
        float l8r[2], l8i[2];
#pragma unroll
        for (int s = 0; s < 2; ++s) { const float l4r = l2r[s] * l2r[s] - l2i[s] * l2i[s], l4i = 2.f * l2r[s] * l2i[s]; l8r[s] = l4r * l4r - l4i * l4i; l8i[s] = 2.f * l4r * l4i; }
        for (int rb = 0; rb < run; rb += 8) {
            float tr[8][2], ti[8][2];
#pragma unroll
            for (int q = 0; q < 8; ++q)
#pragma unroll
                for (int s = 0; s < 2; ++s) { const int rr = (rb + q < run) ? rb + q : 0; tr[q][s] = RT[rr * 128 + ci + 32 * s] + RT[(32 + rr) * 128 + ci + 32 * s]; ti[q][s] = RT[rr * 128 + 64 + ci + 32 * s] + RT[(32 + rr) * 128 + 64 + ci + 32 * s]; }
#pragma unroll
            for (int q = 0; q < 8; ++q) if (rb + q < run) {
#pragma unroll
                for (int s = 0; s < 2; ++s) cmul_acc(xr[s], xi[s], l8r[s], l8i[s], tr[q][s], ti[q][s]); }
        }
        if (hh) {
#pragma unroll
            for (int s = 0; s < 2; ++s) cmul_acc(xr[s], xi[s], lr[s], li[s], xer[0][s], xei[0][s]); }
    }
    float hr[2] = {0.f, 0.f}, hi2[2] = {0.f, 0.f};
    for (int u = 0; u < 4; ++u) {
        const int cA = c0 + 2 * u, cm = cA + hh;
        if (!READOUT) { xr[0] = xr[1] = xi[0] = xi[1] = 0.f; }
        else if (u > 0) {
#pragma unroll
            for (int s = 0; s < 2; ++s) cmul_acc(xr[s], xi[s], lr[s], li[s], xer[u][s], xei[u][s]);
        }
        bf16x8 af[4];
        { const int seg = (ci >> 2) & 1, tk = 4 * (ci >> 3) + (ci & 3);
#pragma unroll
          for (int k = 0; k < 4; ++k) af[k] = *(const bf16x8*)(U + (size_t)((cA + seg) * CH + 16 * k + tk) * SSMW + g * SP + 8 * hh); }
#pragma unroll
        for (int k = 0; k < 4; ++k) {
            float uv[2][4];
            if (READOUT) {
#pragma unroll
                for (int sg = 0; sg < 2; ++sg)
#pragma unroll
                    for (int r = 0; r < 4; ++r) uv[sg][r] = bf2f(U[(size_t)((cA + sg) * CH + 16 * k + 4 * (lane >> 4) + r) * SSMW + g * SP + (lane & 15)]);
            }
            f32x16 bu[4];
            { f32x16 z;
#pragma unroll
              for (int r = 0; r < 16; ++r) z[r] = 0.f;
              MFMA_PRE(z); MFMA_PRE(af[k]);
#pragma unroll
              for (int nt = 0; nt < 4; ++nt) bu[nt] = __builtin_amdgcn_mfma_f32_32x32x16_bf16(af[k], bfr[nt], z, 0, 0, 0); }
            MFMA_SETTLE4(bu[0], bu[1], bu[2], bu[3]);
#pragma unroll
            for (int r = 0; r < 16; ++r) {
#pragma unroll
                for (int s = 0; s < 2; ++s) {
                    cmul_acc(xr[s], xi[s], ar[s], ai[s], bu[s][r], bu[2 + s][r]);
                    if (READOUT) *(LAS unsigned*)(xl + (hh * 16 + r) * XROWB + (ci + 32 * s) * 4) = cvt_pk_bf16(xr[s], xi[s]);
                }
            }
            if (READOUT) {
                LDS_WAIT();
#pragma unroll
                for (int sg = 0; sg < 2; ++sg) {
                    f32x4 y = (f32x4){0.f, 0.f, 0.f, 0.f};
                    bf16x8 xa[4];
#pragma unroll
                    for (int kk = 0; kk < 4; ++kk) xa[kk] = *(const LAS bf16x8*)(xl + (sg * 16 + (lane & 15)) * XROWB + (32 * kk + 8 * (lane >> 4)) * 2);
                    LDS_WAIT(); MFMA_PRE(y); MFMA_PRE(xa[0]); MFMA_PRE(xa[1]); MFMA_PRE(xa[2]); MFMA_PRE(xa[3]);
#pragma unroll
                    for (int kk = 0; kk < 4; ++kk) y = __builtin_amdgcn_mfma_f32_16x16x32_bf16(xa[kk], ctf[kk], y, 0, 0, 0);
                    MFMA_SETTLE1(y);
#pragma unroll
                    for (int r = 0; r < 4; ++r) { const size_t idx = (size_t)((cA + sg) * CH + 16 * k + 4 * (lane >> 4) + r) * SSMW + g * SP + (lane & 15);
                        const float v = y[r] + dsk * uv[sg][r];
                        const float e = __expf(-1.5957691216057308f * (v + 0.044715f * v * v * v));
                        Y[idx] = (bf16)f2bf(v * __builtin_amdgcn_rcpf(1.0f + e)); }
                }
                LDS_WAIT();
            }
        }
        if (!READOUT) {
#pragma unroll
            for (int s = 0; s < 2; ++s) { XE[cm * 128 + ci + 32 * s] = xr[s]; XE[cm * 128 + 64 + ci + 32 * s] = xi[s];
                cmul_acc(hr[s], hi2[s], l2r[s], l2i[s], xr[s], xi[s]); }
        }
    }
    if (!READOUT) {
#pragma unroll
        for (int s = 0; s < 2; ++s) {
            float er = hr[s], ei = hi2[s];
            if (!hh) { const float nr = lr[s] * er - li[s] * ei, ni = lr[s] * ei + li[s] * er; er = nr; ei = ni; }
            RT[(hh * 32 + run) * 128 + ci + 32 * s] = er; RT[(hh * 32 + run) * 128 + 64 + ci + 32 * s] = ei;
        }
    }
}

__device__ __forceinline__ void attn_item(Frame& F, int h, int qt, const bf16* Q, const bf16* K, const bf16* V, bf16* O) {
    const int lane = F.lane, ci = lane & 31, hh = lane >> 5, t0 = qt * 32;
    bf16x8 qf[8];
    { const bf16* qrow = Q + (size_t)(t0 + ci) * SBW + h * HD + 8 * hh;
#pragma unroll
      for (int ks = 0; ks < 8; ++ks) qf[ks] = *(const bf16x8*)(qrow + 16 * ks); }
    f32x16 o[4];
#pragma unroll
    for (int dt = 0; dt < 4; ++dt)
#pragma unroll
        for (int r = 0; r < 16; ++r) o[dt][r] = 0.f;
    float carry = 0.f;
    for (int kt = qt; kt >= 0; --kt) {
        const int k0 = kt * 32;
        bf16x8 kf[8];
        { const bf16* krow = K + (size_t)(k0 + ci) * SBW + h * HD + 8 * hh;
#pragma unroll
          for (int ks = 0; ks < 8; ++ks) kf[ks] = *(const bf16x8*)(krow + 16 * ks); }
        unsigned vv[2][8][2];
#pragma unroll
        for (int s = 0; s < 2; ++s)
#pragma unroll
            for (int j = 0; j < 8; ++j) { const bf16* vrow = V + (size_t)(k0 + 16 * s + 8 * (j >> 2) + 4 * hh + (j & 3)) * SBW + h * HD + 2 * ci;
                vv[s][j][0] = *(const unsigned*)vrow; vv[s][j][1] = *(const unsigned*)(vrow + 64); }
        f32x16 c;
#pragma unroll
        for (int r = 0; r < 16; ++r) c[r] = 0.f;
        MFMA_PRE(c);
#pragma unroll
        for (int ks = 0; ks < 8; ++ks) c = __builtin_amdgcn_mfma_f32_32x32x16_bf16(kf[ks], qf[ks], c, 0, 0, 0);
        MFMA_SETTLE1(c);
        float z[16], sp[16];
        const bool diag = (kt == qt);
#pragma unroll
        for (int r = 0; r < 16; ++r) { const int i = (r & 3) + 8 * (r >> 2) + 4 * hh; z[r] = c[r] * 0.08838834764831845f;
            const bool valid = !diag || (i < ci);
            sp[r] = valid ? (fmaxf(z[r], 0.f) + __logf(1.0f + __expf(-fabsf(z[r])))) : 0.f; }
        float gs[4], pg[4];
#pragma unroll
        for (int g = 0; g < 4; ++g) { gs[g] = (sp[4 * g] + sp[4 * g + 1]) + (sp[4 * g + 2] + sp[4 * g + 3]); pg[g] = __shfl_xor(gs[g], 32); }
        float w[16]; float above = 0.f;
#pragma unroll
        for (int g = 3; g >= 0; --g) {
            float run = carry + above + (hh == 0 ? pg[g] : 0.f);
#pragma unroll
            for (int q = 3; q >= 0; --q) { const int r = 4 * g + q, i = q + 8 * g + 4 * hh; run += sp[r];
                const bool valid = !diag || (i < ci); w[r] = valid ? __expf(z[r] - run) : 0.f; }
            above += gs[g] + pg[g];
        }
        carry += above;
        bf16x8 pb[2];
#pragma unroll
        for (int s = 0; s < 2; ++s) { u32x4 t; t.x = cvt_pk_bf16(w[8 * s], w[8 * s + 1]); t.y = cvt_pk_bf16(w[8 * s + 2], w[8 * s + 3]); t.z = cvt_pk_bf16(w[8 * s + 4], w[8 * s + 5]); t.w = cvt_pk_bf16(w[8 * s + 6], w[8 * s + 7]);
            pb[s] = __builtin_bit_cast(bf16x8, t); MFMA_PRE(pb[s]); }
#pragma unroll
        for (int dt = 0; dt < 4; ++dt)
#pragma unroll
            for (int s = 0; s < 2; ++s) { const unsigned sel = (dt & 1) ? 0x07060302u : 0x05040100u; u32x4 t;
                t.x = __builtin_amdgcn_perm(vv[s][1][dt >> 1], vv[s][0][dt >> 1], sel); t.y = __builtin_amdgcn_perm(vv[s][3][dt >> 1], vv[s][2][dt >> 1], sel);
                t.z = __builtin_amdgcn_perm(vv[s][5][dt >> 1], vv[s][4][dt >> 1], sel); t.w = __builtin_amdgcn_perm(vv[s][7][dt >> 1], vv[s][6][dt >> 1], sel);
                bf16x8 va = __builtin_bit_cast(bf16x8, t); MFMA_PRE(va);
                o[dt] = __builtin_amdgcn_mfma_f32_32x32x16_bf16(va, pb[s], o[dt], 0, 0, 0); }
        if (__all(carry > SB_THRESH)) break;
    }
    MFMA_SETTLE4(o[0], o[1], o[2], o[3]);
    bf16* orow = O + (size_t)(t0 + ci) * SBW + h * HD + 8 * hh;
#pragma unroll
    for (int dp = 0; dp < 2; ++dp)
#pragma unroll
        for (int g = 0; g < 4; ++g) { u32x4 t;
            t.x = cvt_pk_bf16(o[2 * dp][4 * g], o[2 * dp + 1][4 * g]); t.y = cvt_pk_bf16(o[2 * dp][4 * g + 1], o[2 * dp + 1][4 * g + 1]);
            t.z = cvt_pk_bf16(o[2 * dp][4 * g + 2], o[2 * dp + 1][4 * g + 2]); t.w = cvt_pk_bf16(o[2 * dp][4 * g + 3], o[2 * dp + 1][4 * g + 3]);
            *(u32x4*)(orow + 64 * dp + 16 * g) = t; }
}

constexpr int NPHASE = 21;

__device__ __forceinline__ Frame mk_frame() {
    Frame F; int t_ = threadIdx.x; asm volatile("" : "+v"(t_)); int b_ = blockIdx.x; asm volatile("" : "+s"(b_));
    const Args __attribute__((address_space(4)))* ka = (const Args __attribute__((address_space(4)))*)__builtin_amdgcn_kernarg_segment_ptr(); asm volatile("" : "+s"(ka));
    extern __shared__ __attribute__((aligned(16))) unsigned char lds[];
    F.ka = ka; unsigned char* w_ = ka->ws;
    F.lds = (LAS unsigned char*)lds; F.ws = w_; F.ctl = (gu32*)(w_ + WS_CTL);
    F.tid = t_; F.lane = t_ & 63; F.wave = __builtin_amdgcn_readfirstlane(t_ >> 6);
    F.G = gridDim.x; F.vcu = (F.G % 8 == 0) ? (b_ % 8) * (F.G / 8) + b_ / 8 : b_; F.bid = b_;
    return F;
}
#define WSP(off) ((bf16*)(F.ws + (off)))

#if MK_ONE_LAUNCH
#define GRID_BAR() xcd_barrier(bar)
#else
#define GRID_BAR() do { } while (0)
#endif
#ifndef PHMASK
#define PHMASK 0x7FF
#endif
#ifndef DUP
#define DUP 0ull
#endif
#define REPS(k) (1 + (int)(((DUP) >> (k)) & 1ull))
#define IN(k) (lo <= (k) && (k) < hi)
#define SEAM(k) do { if (IN(k) && IN((k) + 1)) GRID_BAR(); } while (0)
template <int l> __device__ __forceinline__ void layer_phases(const int lo, const int hi, const XcdBarrier& bar) {
    constexpr int pb = l * 10;
        for (int rep_ = 0; rep_ < REPS(pb + 0); ++rep_) if (((PHMASK >> 0) & 1) && IN(pb + 0)) { if (rep_ > 0) GRID_BAR();
            Frame F = mk_frame(); const int gw = F.vcu * NWAVES + F.wave, NGW = F.G * NWAVES; LAS float* scr = (LAS float*)(F.lds + F.wave * 16384);
            float* xres = F.ka->out; const float* xin = (l == 0) ? F.ka->in[0] : xres;
            bf16* Win_t = WSP(WS_W + W_IN); bf16* Wglu_t = WSP(WS_W + W_GLU); bf16* Pa_t = WSP(WS_W + W_PA); bf16* Ps_t = WSP(WS_W + W_PS);
            bf16* Wout_t = WSP(WS_W + W_OUT); bf16* Wgu_t = WSP(WS_W + W_GU); bf16* Wdn_t = WSP(WS_W + W_DN_DENSE); bf16* Wdnm_t = WSP(WS_W + W_DN_MOE);
            const float* w_in = F.ka->in[4] + (size_t)l * D * INC; const float* w_glu = F.ka->in[13] + (size_t)l * SSMW * SSMW;
            const float* p_attn = F.ka->in[14] + (size_t)l * SBW * D; const float* p_ssm = F.ka->in[15] + (size_t)l * SSMW * D; const float* w_out = F.ka->in[16] + (size_t)l * D * D;
            constexpr int I_IN = (D / 64) * (INC / 32), I_GLU = (SSMW / 64) * (SSMW / 32), I_PA = (SBW / 64) * (D / 32), I_OUT = (D / 64) * (D / 32);
            constexpr int I_FG = (D / 64) * (FFD / 32), I_FD = (FFD / 64) * (D / 32);
            constexpr int I_MG = (D / 64) * (FFE / 32), I_MD = (FFE / 64) * (D / 32);
            const int n_ffn = (l == 0) ? (2 * I_FG + I_FD) : NE * (2 * I_MG + I_MD);
            const int NITEMS = I_IN + I_GLU + 2 * I_PA + I_OUT + n_ffn;
            for (int it = gw; it < NITEMS; it += NGW) {
                int r = it;
                if (r < I_IN) { transpose_mat(F, w_in, D, INC, Win_t, 0, r, scr); continue; } r -= I_IN;
                if (r < I_GLU) { transpose_mat(F, w_glu, SSMW, SSMW, Wglu_t, 0, r, scr); continue; } r -= I_GLU;
                if (r < I_PA) { transpose_mat(F, p_attn, SBW, D, Pa_t, 0, r, scr); continue; } r -= I_PA;
                if (r < I_PA) { transpose_mat(F, p_ssm, SSMW, D, Ps_t, 0, r, scr); continue; } r -= I_PA;
                if (r < I_OUT) { transpose_mat(F, w_out, D, D, Wout_t, 0, r, scr); continue; } r -= I_OUT;
                if (l == 0) {
                    if (r < I_FG) { transpose_mat(F, F.ka->in[17], D, FFD, Wgu_t, 1, r, scr); continue; } r -= I_FG;
                    if (r < I_FG) { transpose_mat(F, F.ka->in[18], D, FFD, Wgu_t, 2, r, scr); continue; } r -= I_FG;
                    transpose_mat(F, F.ka->in[19], FFD, D, Wdn_t, 0, r, scr);
                } else {
                    const int per = 2 * I_MG + I_MD, e = r / per; r -= e * per;
                    if (r < I_MG) { transpose_mat(F, F.ka->in[21] + (size_t)e * D * FFE, D, FFE, Wgu_t + (size_t)e * 2048 * D, 1, r, scr); continue; } r -= I_MG;
                    if (r < I_MG) { transpose_mat(F, F.ka->in[22] + (size_t)e * D * FFE, D, FFE, Wgu_t + (size_t)e * 2048 * D, 2, r, scr); continue; } r -= I_MG;
                    transpose_mat(F, F.ka->in[23] + (size_t)e * FFE * D, FFE, D, Wdnm_t + (size_t)e * 2048 * FFE, 0, r, scr);
                }
            }
            if (gw < SG) ssm_tables_group(F, gw, F.ka->in[5] + l * SG * SN, F.ka->in[6] + l * SG * SN, F.ka->in[7] + l * SG, F.ka->in[8] + (size_t)l * SG * SN * SP, F.ka->in[9] + (size_t)l * SG * SN * SP,
                                          F.ka->in[10] + (size_t)l * SG * SP * SN, F.ka->in[11] + (size_t)l * SG * SP * SN);
            const float* gnorm = F.ka->in[1] + l * D; bf16* XN = WSP(WS_XN);
            for (int m = gw; m < S; m += NGW) rms_row_to_bf16(F, xin + (size_t)m * D, gnorm, XN + (size_t)m * D);
        }
        SEAM(pb + 0);
        for (int rep_ = 0; rep_ < REPS(pb + 1); ++rep_) if (((PHMASK >> 1) & 1) && IN(pb + 1)) { if (rep_ > 0) GRID_BAR();
            Frame F = mk_frame();
            pg8::DenseSched Sd; Sd.so.init(S, INC, F.G, F.bid); Sd.A = WSP(WS_XN); Sd.Bt = WSP(WS_W + W_IN); Sd.K = D;
            pg8::EpiProj E{WSP(WS_Q), WSP(WS_GA)};
            pg8::gemm_phase<pg8::EpiProj, pg8::DenseSched, true>(F.lds, D, Sd, E);
        }
        SEAM(pb + 1);
        for (int rep_ = 0; rep_ < REPS(pb + 2); ++rep_) if (((PHMASK >> 2) & 1) && IN(pb + 2)) { if (rep_ > 0) GRID_BAR();
            Frame F = mk_frame(); const int gw = F.vcu * NWAVES + F.wave, NGW = F.G * NWAVES;
            bf16* Qb = WSP(WS_Q); bf16* Kb = Qb + (size_t)S * 1024; bf16* Vb = Kb + (size_t)S * 1024; bf16* Ub = Vb + (size_t)S * 1024;
            { const int g = gw >> 5, run = gw & 31; if (gw < SG * 32) ssm_run<false>(F, g, run, Ub, WSP(WS_Y), nullptr, F.lds + F.wave * 16384); }
            bf16* OATT = WSP(WS_OATT);
#ifndef DBG_NOATT
            for (int it = gw; it < NH * (S / 32); it += NGW) { const int h = it & 7, qt = it >> 3; attn_item(F, h, qt, Qb, Kb, Vb, OATT); }
#endif
        }
        SEAM(pb + 2);
        for (int rep_ = 0; rep_ < REPS(pb + 3); ++rep_) if (((PHMASK >> 3) & 1) && IN(pb + 3)) { if (rep_ > 0) GRID_BAR();
            Frame F = mk_frame(); const int gw = F.vcu * NWAVES + F.wave;
            const int g = gw >> 5, run = gw & 31; if (gw < SG * 32) ssm_run<true>(F, g, run, WSP(WS_Q) + (size_t)3 * S * 1024, WSP(WS_Y), F.ka->in[12] + l * SG * SP, F.lds + F.wave * 16384);
        }
        SEAM(pb + 3);
        for (int rep_ = 0; rep_ < REPS(pb + 4); ++rep_) if (((PHMASK >> 4) & 1) && IN(pb + 4)) { if (rep_ > 0) GRID_BAR();
#ifndef DBG_P4
#define DBG_P4 3
#endif
            if (DBG_P4 & 1) { Frame F = mk_frame();
              pg8::DenseSched Sd; Sd.so.init(S, D, F.G, F.bid); Sd.A = WSP(WS_OATT); Sd.Bt = WSP(WS_W + W_PA); Sd.K = SBW;
              pg8::EpiGate<0> E{WSP(WS_GA), WSP(WS_GA), D};
              pg8::gemm_phase<pg8::EpiGate<0>, pg8::DenseSched, true>(F.lds, SBW, Sd, E); }
            if (DBG_P4 & 2) { Frame F = mk_frame();
              pg8::DenseSched Sd; Sd.so.init(S, SSMW, F.G, F.bid); Sd.A = WSP(WS_Y); Sd.Bt = WSP(WS_W + W_GLU); Sd.K = SSMW;
              pg8::EpiGate<1> E{WSP(WS_Y), WSP(WS_OSSM), SSMW};
              pg8::gemm_phase<pg8::EpiGate<1>, pg8::DenseSched, true>(F.lds, SSMW, Sd, E); }
        }
        SEAM(pb + 4);
        for (int rep_ = 0; rep_ < REPS(pb + 5); ++rep_) if (((PHMASK >> 5) & 1) && IN(pb + 5)) { if (rep_ > 0) GRID_BAR();
            Frame F = mk_frame();
            pg8::DenseSched Sd; Sd.so.init(S, D, F.G, F.bid); Sd.A = WSP(WS_OSSM); Sd.Bt = WSP(WS_W + W_PS); Sd.K = SSMW;
            pg8::EpiGate<2> E{WSP(WS_GB), WSP(WS_GA), D};
            pg8::gemm_phase<pg8::EpiGate<2>, pg8::DenseSched, true>(F.lds, SSMW, Sd, E);
        }
        SEAM(pb + 5);
        for (int rep_ = 0; rep_ < REPS(pb + 6); ++rep_) if (((PHMASK >> 6) & 1) && IN(pb + 6)) { if (rep_ > 0) GRID_BAR();
            Frame F = mk_frame();
            pg8::DenseSched Sd; Sd.so.init(S, D, F.G, F.bid); Sd.A = WSP(WS_GA); Sd.Bt = WSP(WS_W + W_OUT); Sd.K = D;
            float* xres = F.ka->out; const float* xin = (l == 0) ? F.ka->in[0] : xres;
            pg8::EpiResid E{xin, xres};
            pg8::gemm_phase<pg8::EpiResid, pg8::DenseSched, true>(F.lds, D, Sd, E);
        }
        SEAM(pb + 6);
        for (int rep_ = 0; rep_ < REPS(pb + 7); ++rep_) if (((PHMASK >> 7) & 1) && IN(pb + 7)) { if (rep_ > 0) GRID_BAR();
            Frame F = mk_frame(); const int gw = F.vcu * NWAVES + F.wave, NGW = F.G * NWAVES;
            const float* gnorm = F.ka->in[2] + l * D; bf16* XN = WSP(WS_XN); float* xres = F.ka->out;
            if (l == 0) { for (int m = gw; m < S; m += NGW) rms_row_to_bf16(F, xres + (size_t)m * D, gnorm, XN + (size_t)m * D); }
            else {
                const float* wrt = F.ka->in[20]; int* lists = (int*)(F.ws + WS_MOE); float* gatew = (float*)(F.ws + WS_MOE + (size_t)NE * S * 4);
                for (int m = gw; m < S; m += NGW) {
                    const GAS f32x4* xr = (const GAS f32x4*)(xres + (size_t)m * D) + F.lane; const GAS f32x4* gr = (const GAS f32x4*)gnorm + F.lane;
                    f32x4 v[8]; float s = 0.f; float lg[NE];
#pragma unroll
                    for (int e = 0; e < NE; ++e) lg[e] = 0.f;
                    const char* wbase = (const char*)wrt + (size_t)F.lane * (4 * NE * 4);
#pragma unroll
                    for (int j = 0; j < 8; ++j) { v[j] = xr[64 * j]; s += (v[j].x * v[j].x + v[j].y * v[j].y) + (v[j].z * v[j].z + v[j].w * v[j].w);
                        const f32x4 xg = v[j] * gr[64 * j];
                        const char* wb = wbase + (size_t)j * (256 * NE * 4); asm volatile("" : "+v"(wb) :: "memory");
                        const GAS f32x4* wp = (const GAS f32x4*)wb;
#pragma unroll
                        for (int q = 0; q < 4; ++q) { const f32x4 w0 = wp[2 * q], w1 = wp[2 * q + 1]; const float hq = xg[q];
                            lg[0] += hq * w0.x; lg[1] += hq * w0.y; lg[2] += hq * w0.z; lg[3] += hq * w0.w; lg[4] += hq * w1.x; lg[5] += hq * w1.y; lg[6] += hq * w1.z; lg[7] += hq * w1.w; } }
                    const float rstd = 1.0f / sqrtf(wave_sum(s) * (1.f / D) + RMS_EPS);
                    GAS unsigned long long* o8 = (GAS unsigned long long*)(XN + (size_t)m * D) + F.lane;
#pragma unroll
                    for (int j = 0; j < 8; ++j) { const f32x4 gg = gr[64 * j]; const f32x4 hv = v[j] * rstd * gg;
                        o8[64 * j] = (unsigned long long)pk2(hv.x, hv.y) | ((unsigned long long)pk2(hv.z, hv.w) << 32); }
#pragma unroll
                    for (int e = 0; e < NE; ++e) lg[e] = wave_sum(lg[e]) * rstd;
                    int i1 = 0; float v1 = lg[0];
#pragma unroll
                    for (int e = 1; e < NE; ++e) if (lg[e] > v1) { v1 = lg[e]; i1 = e; }
                    int i2 = (i1 == 0) ? 1 : 0; float v2 = -3.0e38f;
#pragma unroll
                    for (int e = 0; e < NE; ++e) if (e != i1 && lg[e] > v2) { v2 = lg[e]; i2 = e; }
                    if (F.lane == 0) {
                        const float e2 = __expf(v2 - v1); const float g1 = 1.0f / (1.0f + e2), g2 = e2 / (1.0f + e2);
                        const unsigned p1 = __hip_atomic_fetch_add((unsigned*)(F.ctl + CW_MOECNT + 64 * i1), 1u, RLX_AGENT);
                        const unsigned p2 = __hip_atomic_fetch_add((unsigned*)(F.ctl + CW_MOECNT + 64 * i2), 1u, RLX_AGENT);
                        lists[i1 * S + (int)p1] = 2 * m; lists[i2 * S + (int)p2] = 2 * m + 1; gatew[2 * m] = g1; gatew[2 * m + 1] = g2;
                    }
                }
            }
        }
        SEAM(pb + 7);
        if (l == 0) {
            for (int rep_ = 0; rep_ < REPS(pb + 8); ++rep_) if (((PHMASK >> 8) & 1) && IN(pb + 8)) { if (rep_ > 0) GRID_BAR();
                Frame F = mk_frame();
                pg8::DenseSched Sd; Sd.so.init(S, 2 * FFD, F.G, F.bid); Sd.A = WSP(WS_XN); Sd.Bt = WSP(WS_W + W_GU); Sd.K = D;
                pg8::EpiSwiglu E{WSP(WS_ACT), FFD};
                pg8::gemm_phase<pg8::EpiSwiglu, pg8::DenseSched, true>(F.lds, D, Sd, E);
            }
            SEAM(pb + 8);
            for (int rep_ = 0; rep_ < REPS(pb + 9); ++rep_) if (((PHMASK >> 9) & 1) && IN(pb + 9)) { if (rep_ > 0) GRID_BAR();
                Frame F = mk_frame();
                pg8::DenseSched Sd; Sd.so.init(S, D, F.G, F.bid); Sd.A = WSP(WS_ACT); Sd.Bt = WSP(WS_W + W_DN_DENSE); Sd.K = FFD;
                float* xres = F.ka->out;
                pg8::EpiResid E{xres, xres};
                pg8::gemm_phase<pg8::EpiResid, pg8::DenseSched, true>(F.lds, FFD, Sd, E);
            }
            SEAM(pb + 9);
        } else {
            for (int rep_ = 0; rep_ < REPS(pb + 8); ++rep_) if (((PHMASK >> 8) & 1) && IN(pb + 8)) { if (rep_ > 0) GRID_BAR();
                Frame F = mk_frame(); const int* lists = (const int*)(F.ws + WS_MOE);
                pg8::MoeSched Sm; Sm.A = WSP(WS_XN); Sm.Bt = WSP(WS_W + W_GU); Sm.K = D; Sm.gather = true; Sm.lists = lists; Sm.init((const unsigned*)(F.ctl + CW_MOECNT), F.G, F.bid);
                pg8::EpiSwiglu E{WSP(WS_ACT), FFE};
                pg8::gemm_phase<pg8::EpiSwiglu, pg8::MoeSched, true>(F.lds, D, Sm, E);
            }
            SEAM(pb + 8);
            for (int rep_ = 0; rep_ < REPS(pb + 9); ++rep_) if (((PHMASK >> 9) & 1) && IN(pb + 9)) { if (rep_ > 0) GRID_BAR();
                Frame F = mk_frame(); const int* lists = (const int*)(F.ws + WS_MOE); const float* gatew = (const float*)(F.ws + WS_MOE + (size_t)NE * S * 4);
                pg8::MoeSched Sm; Sm.A = WSP(WS_ACT); Sm.Bt = WSP(WS_W + W_DN_MOE); Sm.K = FFE; Sm.gather = false; Sm.lists = lists; Sm.init((const unsigned*)(F.ctl + CW_MOECNT), F.G, F.bid);
                pg8::EpiMoeDown E; E.O = WSP(WS_MOEY); E.lists = lists; E.gw = gatew;
#pragma unroll
                for (int e = 0; e < NE; ++e) E.cumv[e] = Sm.cum[e];
                pg8::gemm_phase<pg8::EpiMoeDown, pg8::MoeSched, true>(F.lds, FFE, Sm, E);
            }
            SEAM(pb + 9);
        }
}

__global__ void __launch_bounds__(NTHR, 2) trunk_fwd(Args args) {
    extern __shared__ __attribute__((aligned(16))) unsigned char lds[];
    {
        LAS unsigned char* l0 = (LAS unsigned char*)lds;
        for (int u = threadIdx.x; u < (LDS_BYTES - LDSCTL_OFF) / 4; u += NTHR) ((LAS unsigned*)(l0 + LDSCTL_OFF))[u] = 0u;
        __syncthreads();
    }
#if MK_ONE_LAUNCH
    XcdBarrier bar = xcd_barrier_post((unsigned*)(args.ws + WS_CTL) + CW_BAR, (volatile LAS unsigned*)((LAS unsigned char*)lds + MISC_OFF) + 8);
#else
    XcdBarrier bar; bar.bar = nullptr; bar.x = 0; bar.st = nullptr;
#endif
    const int lo = args.ph_lo, hi = args.ph_hi;
    layer_phases<0>(lo, hi, bar);
    layer_phases<1>(lo, hi, bar);

    if (((PHMASK >> 10) & 1) && IN(20)) {
        Frame F = mk_frame(); const int gw = F.vcu * NWAVES + F.wave, NGW = F.G * NWAVES;
        const float* gnorm = F.ka->in[3]; const bf16* MOEY = WSP(WS_MOEY); float* xres = F.ka->out;
        for (int m = gw; m < S; m += NGW) {
            GAS f32x4* xr = (GAS f32x4*)(xres + (size_t)m * D) + F.lane; const GAS f32x4* gr = (const GAS f32x4*)gnorm + F.lane;
            const GAS u32x2* y0 = (const GAS u32x2*)(MOEY + (size_t)(2 * m) * D) + F.lane; const GAS u32x2* y1 = (const GAS u32x2*)(MOEY + (size_t)(2 * m + 1) * D) + F.lane;
            f32x4 v[8]; float s = 0.f;
#pragma unroll
            for (int j = 0; j < 8; ++j) { v[j] = xr[64 * j]; const u32x2 a = y0[64 * j], b = y1[64 * j];
                v[j].x += bflo(a.x) + bflo(b.x); v[j].y += bfhi(a.x) + bfhi(b.x); v[j].z += bflo(a.y) + bflo(b.y); v[j].w += bfhi(a.y) + bfhi(b.y);
                s += (v[j].x * v[j].x + v[j].y * v[j].y) + (v[j].z * v[j].z + v[j].w * v[j].w); }
            const float rstd = 1.0f / sqrtf(wave_sum(s) * (1.f / D) + RMS_EPS);
#pragma unroll
            for (int j = 0; j < 8; ++j) { const f32x4 gg = gr[64 * j]; xr[64 * j] = v[j] * rstd * gg; }
        }
    }
#undef IN
#undef SEAM
}


#ifdef DBG_LAST
__global__ void dbg_dump(const unsigned short* buf, float* out, int ld, int f32src) {
    for (size_t i = (size_t)blockIdx.x * blockDim.x + threadIdx.x; i < (size_t)S * D; i += (size_t)gridDim.x * blockDim.x) {
        const size_t r = i / D, c = i % D;
        if (f32src) out[i] = ((const float*)buf)[r * ld + (c % ld)];
        else { unsigned short hv_ = buf[r * ld + (c % ld)];
#ifdef DBG_SEL
            if (!(DBG_SEL)) hv_ = 0;
#endif
 out[i] = (float)((hv_ * 2654435761u) >> 16) * (1.0f / 65536.0f); }
    }
}
#endif
extern "C" void kernel_launch(void* const* d_in, const int* in_sizes, int n_in, void* d_out, int out_size, void* d_ws, size_t ws_size, hipStream_t stream) {
    static int grid = 0;
    if (grid == 0) {
        if (n_in != 24 || out_size != S * D || ws_size < WS_END) { fprintf(stderr, "kernel_launch: unexpected problem (n_in %d, out %d, ws %zu); nothing launched\n", n_in, out_size, ws_size); grid = -1; return; }
        int dev = 0, cus = 0, per_cu = 0;
        if (hipGetDevice(&dev) != hipSuccess || hipDeviceGetAttribute(&cus, hipDeviceAttributeMultiprocessorCount, dev) != hipSuccess) { grid = -1; return; }
        if (hipFuncSetAttribute((const void*)trunk_fwd, hipFuncAttributeMaxDynamicSharedMemorySize, LDS_BYTES) != hipSuccess) { fprintf(stderr, "kernel_launch: hipFuncSetAttribute failed\n"); grid = -1; return; }
        if (hipOccupancyMaxActiveBlocksPerMultiprocessor(&per_cu, (const void*)trunk_fwd, NTHR, LDS_BYTES) != hipSuccess || per_cu < 1)
            fprintf(stderr, "kernel_launch: note: occupancy query reports %d workgroups per CU\n", per_cu);
        (void)hipGetLastError();
        grid = cus;
    }
    if (grid < 0) return;
    if (hipMemsetAsync((char*)d_ws + WS_CTL, 0, CTL_ZERO_BYTES, stream) != hipSuccess) return;
    Args a{};
    for (int i = 0; i < 24; ++i) a.in[i] = (const float*)d_in[i];
    a.out = (float*)d_out; a.ws = (unsigned char*)d_ws;
#if MK_ONE_LAUNCH
#ifdef DBG_LAST
    a.ph_lo = 0; a.ph_hi = DBG_LAST + 1;
    hipLaunchKernelGGL(trunk_fwd, dim3(grid), dim3(NTHR), LDS_BYTES, stream, a);
    hipLaunchKernelGGL(dbg_dump, dim3(2048), dim3(256), 0, stream, (const unsigned short*)((const char*)d_ws + DBG_OFF), (float*)d_out, DBG_LD, DBG_F32);
#else
#ifdef CUTMASK
    { int lo_ = 0;
      for (int p = 0; p < NPHASE; ++p) if (p == NPHASE - 1 || ((CUTMASK >> p) & 1ull)) {
          a.ph_lo = lo_; a.ph_hi = p + 1;
          if (lo_ > 0) hipMemsetAsync((char*)d_ws + WS_CTL + CW_BAR * 4, 0, XCD_BAR_WORDS * 4, stream);
          hipLaunchKernelGGL(trunk_fwd, dim3(grid), dim3(NTHR), LDS_BYTES, stream, a); lo_ = p + 1; } }
#else
    a.ph_lo = 0; a.ph_hi = NPHASE;
    hipLaunchKernelGGL(trunk_fwd, dim3(grid), dim3(NTHR), LDS_BYTES, stream, a);
#endif
#endif
#else
#ifdef DBG_LAST
    for (int p = 0; p <= DBG_LAST; ++p) { a.ph_lo = p; a.ph_hi = p + 1; hipLaunchKernelGGL(trunk_fwd, dim3(grid), dim3(NTHR), LDS_BYTES, stream, a); }
    hipLaunchKernelGGL(dbg_dump, dim3(2048), dim3(256), 0, stream, (const unsigned short*)((const char*)d_ws + DBG_OFF), (float*)d_out, DBG_LD, DBG_F32);
#else
    for (int p = 0; p < NPHASE; ++p) { a.ph_lo = p; a.ph_hi = p + 1; hipLaunchKernelGGL(trunk_fwd, dim3(grid), dim3(NTHR), LDS_BYTES, stream, a); }
#endif
#endif
}
```

```cpp
#include <hip/hip_runtime.h>
#include <cstdio>
#include <cstdint>

#ifndef MK_ONE_LAUNCH
#define MK_ONE_LAUNCH 1
#endif

#define GAS __attribute__((address_space(1)))
#define LAS __attribute__((address_space(3)))
typedef unsigned short bf16;
typedef short bf16x8 __attribute__((ext_vector_type(8)));
typedef float f32x4 __attribute__((ext_vector_type(4)));
typedef float f32x16 __attribute__((ext_vector_type(16)));
typedef unsigned u32x4 __attribute__((ext_vector_type(4)));
typedef unsigned u32x2 __attribute__((ext_vector_type(2)));
typedef GAS unsigned gu32;

constexpr int S = 16384, D = 2048, INC = 8192, SBW = 1024, SSMW = 1024, NH = 8, HD = 128;
constexpr int SG = 64, SN = 64, SP = 16;
constexpr int FFD = 4096, NE = 8, FFE = 1024;
constexpr int CH = 64, NCH = S / CH;
constexpr float RMS_EPS = 1e-6f;
constexpr float SB_THRESH = 30.0f;

constexpr size_t MiB = 1u << 20;
constexpr size_t WS_CTL = 0, CTL_ZERO_BYTES = 1 * MiB;
constexpr size_t WS_SSMT = 1 * MiB;
constexpr size_t WS_MOE = 2 * MiB;
constexpr size_t WS_RSTDE = 3 * MiB + 256 * 1024;
constexpr size_t WS_RSTD = 3 * MiB;
constexpr size_t WS_XE = 4 * MiB;
constexpr size_t WS_W = 12 * MiB;
constexpr size_t W_IN = 0, W_GLU = 32 * MiB, W_PA = 34 * MiB, W_PS = 38 * MiB, W_OUT = 42 * MiB, W_FFN = 50 * MiB;
constexpr size_t W_GU = W_FFN, W_DN_DENSE = W_FFN + 32 * MiB, W_DN_MOE = W_FFN + 64 * MiB;
constexpr size_t WS_Y = 158 * MiB, WS_OSSM = 190 * MiB;
constexpr size_t WS_XB = 510 * MiB;
constexpr size_t WS_Q = 222 * MiB;
constexpr size_t WS_GA = 350 * MiB, WS_GB = 414 * MiB;
constexpr size_t WS_ACT = 222 * MiB;
constexpr size_t WS_MOEY = 350 * MiB;
constexpr size_t WS_OATT = 478 * MiB;
constexpr size_t WS_END = 576 * MiB;

constexpr int CW_BAR = 4096;
constexpr int CW_MOECNT = 16384;

constexpr size_t ST_ABAR = 0;
constexpr size_t ST_ABARL = 32768;
constexpr size_t ST_BBF = 65536;
constexpr size_t ST_CTF = 65536 + 262144;

constexpr int NWAVES = 8, NTHR = 512;
constexpr int RING_BYTES = 131072, LDSCTL_OFF = RING_BYTES, MISC_OFF = LDSCTL_OFF + 320, LDS_BYTES = 147456;

#define RLX_AGENT __ATOMIC_RELAXED, __HIP_MEMORY_SCOPE_AGENT
#define LDS_WAIT() asm volatile("s_waitcnt lgkmcnt(0)" ::: "memory")
#define VM_WAIT() asm volatile("s_waitcnt vmcnt(0)" ::: "memory")

__device__ __forceinline__ unsigned f2bf(float f) { unsigned u = __builtin_bit_cast(unsigned, f); return (u + 0x7fffu + ((u >> 16) & 1u)) >> 16; }

typedef float f32x2_t __attribute__((ext_vector_type(2)));
typedef __bf16 bf16x2_t __attribute__((ext_vector_type(2)));
__device__ __forceinline__ unsigned cvt_pk_bf16(float lo, float hi) { const f32x2_t v = {lo, hi}; const bf16x2_t b = __builtin_convertvector(v, bf16x2_t); return __builtin_bit_cast(unsigned, b); }
__device__ __forceinline__ unsigned pk2(float lo, float hi) { return cvt_pk_bf16(lo, hi); }
#define NOP64 "s_nop 15\n\ts_nop 15\n\ts_nop 15\n\ts_nop 15\n\t"
#define MFMA_SETTLE4(a, b, c, d) asm volatile(NOP64 NOP64 : "+v"(a), "+v"(b), "+v"(c), "+v"(d))
#define MFMA_PRE(a) asm volatile("s_nop 15" : "+v"(a))
#define MFMA_SETTLE1(a) asm volatile(NOP64 NOP64 : "+v"(a))
__device__ __forceinline__ void mfma32_x4_zero(f32x16& d0, f32x16& d1, f32x16& d2, f32x16& d3, bf16x8 a, bf16x8 b0, bf16x8 b1, bf16x8 b2, bf16x8 b3) {
    asm volatile("s_nop 7\n\tv_mfma_f32_32x32x16_bf16 %0, %4, %5, 0\n\tv_mfma_f32_32x32x16_bf16 %1, %4, %6, 0\n\tv_mfma_f32_32x32x16_bf16 %2, %4, %7, 0\n\tv_mfma_f32_32x32x16_bf16 %3, %4, %8, 0\n\t" NOP64 NOP64
                 : "=&v"(d0), "=&v"(d1), "=&v"(d2), "=&v"(d3) : "v"(a), "v"(b0), "v"(b1), "v"(b2), "v"(b3));
}
__device__ __forceinline__ f32x4 mfma16_chain4(bf16x8 a0, bf16x8 a1, bf16x8 a2, bf16x8 a3, bf16x8 b0, bf16x8 b1, bf16x8 b2, bf16x8 b3) {
    f32x4 y;
    asm volatile("s_nop 7\n\tv_mfma_f32_16x16x32_bf16 %0, %1, %5, 0\n\tv_mfma_f32_16x16x32_bf16 %0, %2, %6, %0\n\tv_mfma_f32_16x16x32_bf16 %0, %3, %7, %0\n\tv_mfma_f32_16x16x32_bf16 %0, %4, %8, %0\n\t" NOP64 NOP64
                 : "=&v"(y) : "v"(a0), "v"(a1), "v"(a2), "v"(a3), "v"(b0), "v"(b1), "v"(b2), "v"(b3));
    return y;
}
__device__ __forceinline__ f32x16 mfma32_chain8(const bf16x8 (&a)[8], const bf16x8 (&b)[8]) {
    f32x16 c;
    asm volatile("s_nop 7\n\tv_mfma_f32_32x32x16_bf16 %0, %1, %9, 0\n\tv_mfma_f32_32x32x16_bf16 %0, %2, %10, %0\n\tv_mfma_f32_32x32x16_bf16 %0, %3, %11, %0\n\tv_mfma_f32_32x32x16_bf16 %0, %4, %12, %0\n\t"
                 "v_mfma_f32_32x32x16_bf16 %0, %5, %13, %0\n\tv_mfma_f32_32x32x16_bf16 %0, %6, %14, %0\n\tv_mfma_f32_32x32x16_bf16 %0, %7, %15, %0\n\tv_mfma_f32_32x32x16_bf16 %0, %8, %16, %0\n\t" NOP64 NOP64
                 : "=&v"(c) : "v"(a[0]), "v"(a[1]), "v"(a[2]), "v"(a[3]), "v"(a[4]), "v"(a[5]), "v"(a[6]), "v"(a[7]), "v"(b[0]), "v"(b[1]), "v"(b[2]), "v"(b[3]), "v"(b[4]), "v"(b[5]), "v"(b[6]), "v"(b[7]));
    return c;
}
__device__ __forceinline__ void mfma32_pv(f32x16 (&o)[4], const bf16x8 (&va)[4][2], const bf16x8 (&pb)[2]) {
    asm volatile("s_nop 7\n\tv_mfma_f32_32x32x16_bf16 %0, %4, %12, %0\n\tv_mfma_f32_32x32x16_bf16 %1, %6, %12, %1\n\tv_mfma_f32_32x32x16_bf16 %2, %8, %12, %2\n\tv_mfma_f32_32x32x16_bf16 %3, %10, %12, %3\n\t"
                 "v_mfma_f32_32x32x16_bf16 %0, %5, %13, %0\n\tv_mfma_f32_32x32x16_bf16 %1, %7, %13, %1\n\tv_mfma_f32_32x32x16_bf16 %2, %9, %13, %2\n\tv_mfma_f32_32x32x16_bf16 %3, %11, %13, %3\n\ts_nop 7"
                 : "+v"(o[0]), "+v"(o[1]), "+v"(o[2]), "+v"(o[3]) : "v"(va[0][0]), "v"(va[0][1]), "v"(va[1][0]), "v"(va[1][1]), "v"(va[2][0]), "v"(va[2][1]), "v"(va[3][0]), "v"(va[3][1]), "v"(pb[0]), "v"(pb[1]));
}
__device__ __forceinline__ float bflo(unsigned w) { return __builtin_bit_cast(float, w << 16); }
__device__ __forceinline__ float bfhi(unsigned w) { return __builtin_bit_cast(float, w & 0xffff0000u); }
__device__ __forceinline__ float bf2f(bf16 b) { return __builtin_bit_cast(float, ((unsigned)b) << 16); }
__device__ __forceinline__ float sigmoidf_(float x) { return __builtin_amdgcn_rcpf(1.0f + __expf(-x)); }
__device__ __forceinline__ float wave_sum(float v) {
#pragma unroll
    for (int o = 1; o < 64; o <<= 1) v += __shfl_xor(v, o);
    return v;
}

#define XB_TMO      128
#define XB_XCNT(j)  (256  + 64 * (j))
#define XB_XSUB(j)  (1280 + 64 * (j))
#define XB_XGEN(j)  (2304 + 64 * (j))
#define XB_TOP      3328
#define XB_TOPGEN   3392
#define XCD_BAR_WORDS 3456
#define XB_SPIN_CAP (1u << 18)
__device__ __forceinline__ unsigned xb_ld(unsigned* p)              { return __hip_atomic_load(p, __ATOMIC_RELAXED, __HIP_MEMORY_SCOPE_AGENT); }
__device__ __forceinline__ unsigned xb_add(unsigned* p, unsigned v) { return __hip_atomic_fetch_add(p, v, __ATOMIC_RELAXED, __HIP_MEMORY_SCOPE_AGENT); }
__device__ __forceinline__ unsigned xb_xcc_id() { return (unsigned)__builtin_amdgcn_s_getreg((3 << 11) | 20) & 0xFu; }
#define XB_SPIN(cond, bar) do { unsigned _sp = 0; while (cond) { __builtin_amdgcn_s_sleep(1); \
    if ((++_sp & 255u) == 0u) { if (xb_ld(&(bar)[XB_TMO])) break; if (_sp > XB_SPIN_CAP) { atomicAdd(&(bar)[XB_TMO], 1u); break; } } } } while (0)
struct XcdBarrier { unsigned* bar; unsigned x; volatile LAS unsigned* st; };
__device__ __forceinline__ XcdBarrier xcd_barrier_post(unsigned* bar, volatile LAS unsigned* st) {
    XcdBarrier b; b.bar = bar; b.x = xb_xcc_id(); b.st = st;
    if (threadIdx.x == 0) (void)xb_add(&bar[XB_XCNT(b.x)], 1u);
    return b;
}
__device__ __forceinline__ void xcd_barrier_complete(unsigned* bar, unsigned x, unsigned& nloc, unsigned& nx) {
    const unsigned G = gridDim.x * gridDim.y * gridDim.z;
    unsigned sum, cnt, mine, sp = 0u;
    for (;;) {
        sum = 0u; cnt = 0u; mine = 0u;
#pragma unroll
        for (unsigned j = 0; j < 16; ++j) { const unsigned c = xb_ld(&bar[XB_XCNT(j)]); sum += c; cnt += (c > 0u) ? 1u : 0u; mine = (j == x) ? c : mine; }
        if (sum == G) break;
        __builtin_amdgcn_s_sleep(1);
        if ((++sp & 255u) == 0u) { if (xb_ld(&bar[XB_TMO])) break; if (sp > XB_SPIN_CAP) { atomicAdd(&bar[XB_TMO], 1u); break; } }
    }
    nloc = mine > 0u ? mine : 1u; nx = cnt > 0u ? cnt : 1u;
}
__device__ __forceinline__ void xcd_barrier(const XcdBarrier& b) {
    asm volatile("s_waitcnt vmcnt(0)" ::: "memory");
    __syncthreads();
    if (threadIdx.x == 0) {
        unsigned* bar = b.bar;
        __builtin_amdgcn_s_waitcnt(0);
        unsigned nloc = b.st[0], nx = b.st[1];
        if (nloc == 0u) { xcd_barrier_complete(bar, b.x, nloc, nx); b.st[0] = nloc; b.st[1] = nx; }
        const unsigned old = xb_add(&bar[XB_XSUB(b.x)], 1u);
        const unsigned gen = old / nloc;
        if (old + 1u == (gen + 1u) * nloc) {
            __builtin_amdgcn_fence(__ATOMIC_RELEASE, "");
            asm volatile("s_waitcnt vmcnt(0)" ::: "memory");
            const unsigned og = xb_add(&bar[XB_TOP], 1u);
            const unsigned tg = og / nx;
            if (og + 1u == (tg + 1u) * nx) xb_add(&bar[XB_TOPGEN], 1u);
            else XB_SPIN(xb_ld(&bar[XB_TOPGEN]) == tg, bar);
            __builtin_amdgcn_fence(__ATOMIC_ACQUIRE, "");
            xb_add(&bar[XB_XGEN(b.x)], 1u);
            asm volatile("s_waitcnt vmcnt(0)" ::: "memory");
        } else {
            XB_SPIN(xb_ld(&bar[XB_XGEN(b.x)]) == gen, bar);
            __builtin_amdgcn_fence(__ATOMIC_ACQUIRE, "");
            asm volatile("s_waitcnt vmcnt(0)" ::: "memory");
        }
    }
    __syncthreads();
}

namespace pg8 {
constexpr int BM = 256, BK = 64, HALF = 128, HTB = HALF * BK * 2, STAGE_BYTES = 8 * HTB, NXCD = 8, WGM = 8;
__host__ __device__ __forceinline__ int lds_byte(int r, int c) { const int st = (r >> 4) * 2 + (c >> 5), rr = r & 15, cc = c & 31, ob = rr * 64 + cc * 2; return st * 1024 + (ob ^ (((ob >> 9) & 1) << 5)); }
__host__ __device__ __forceinline__ void stage_rc(int b, int& R, int& C) { const int st = b / 1024, sb = b % 1024, swz = sb ^ (((sb >> 9) & 1) << 5); R = (st >> 1) * 16 + swz / 64; C = (st & 1) * 32 + (swz % 64) / 2; }
__host__ __device__ __forceinline__ int perm32(int rho) { const int n = rho >> 4, i = rho & 15; return 8 * (i >> 2) + 4 * n + (i & 3); }

struct Unit { int pm, pn, e, nv; };

struct StaticOrder {
    int nM, nN, nwg, G, c;
    __device__ void init(int M, int N, int G_, int c_) { nM = M / BM; nN = N / BM; nwg = nM * nN; G = G_; c = c_; }
    __device__ bool next(int i, Unit& u) const {
        const long L = (long)i * G + c; if (L >= nwg) return false;
        int wgid = (int)L; { const int q = nwg / NXCD, r = nwg % NXCD, xcd = wgid % NXCD, off = wgid / NXCD; wgid = (xcd < r ? xcd * (q + 1) : r * (q + 1) + (xcd - r) * q) + off; }
        const int nig = WGM * nN, gid = wgid / nig, fm = gid * WGM, gsz = (nM - fm) < WGM ? (nM - fm) : WGM;
        u.pm = fm + ((wgid % nig) % gsz); u.pn = (wgid % nig) / gsz; u.e = 0; u.nv = 256; return true;
    }
};
struct DenseSched {
    StaticOrder so; const bf16* A; const bf16* Bt; int K;
    __device__ __forceinline__ bool next(int i, Unit& u) const { return so.next(i, u); }
    __device__ __forceinline__ const char* abase(const Unit& u) const { return (const char*)A + (size_t)u.pm * 256 * K * 2; }
    __device__ __forceinline__ const char* bbase(const Unit& u) const { return (const char*)Bt + (size_t)u.pn * 256 * K * 2; }
    __device__ __forceinline__ void aoff(const Unit&, const int (&R)[2], const int (&C)[2], unsigned (&v)[2][2]) const {
#pragma unroll
        for (int h = 0; h < 2; ++h)
#pragma unroll
            for (int i = 0; i < 2; ++i) v[h][i] = (unsigned)((h * HALF + R[i]) * K + C[i]) * 2u;
    }
};
struct MoeSched {
    const bf16* A; const bf16* Bt; int K; int G, c; bool gather;
    const int* lists; int cnt[NE]; int cum[NE + 1];
    __device__ void init(const unsigned* cntw, int G_, int c_) {
        G = G_; c = c_; int a = 0;
#pragma unroll
        for (int e = 0; e < NE; ++e) { cnt[e] = __builtin_amdgcn_readfirstlane((int)__hip_atomic_load(cntw + 64 * e, RLX_AGENT)); cum[e] = a; a += (cnt[e] + 255) >> 8; }
        cum[NE] = a;
    }
    __device__ __forceinline__ bool next(int i, Unit& u) const {
        const int L = i * G + c; if (L >= cum[NE] * 8) return false;
        const int gp = L >> 3; u.pn = L & 7; u.pm = gp; int e = 0;
#pragma unroll
        for (int k = 1; k < NE; ++k) e += (gp >= cum[k]) ? 1 : 0;
        u.e = e; int c_e = 0, b_e = 0;
#pragma unroll
        for (int k = 0; k < NE; ++k) { c_e = (k == e) ? cnt[k] : c_e; b_e = (k == e) ? cum[k] : b_e; }
        const int p = gp - b_e; int nv = c_e - 256 * p; u.nv = nv > 256 ? 256 : nv; return true;
    }
    __device__ __forceinline__ const char* abase(const Unit& u) const { return gather ? (const char*)A : (const char*)A + (size_t)u.pm * 256 * K * 2; }
    __device__ __forceinline__ const char* bbase(const Unit& u) const { return (const char*)Bt + ((size_t)u.e * 2048 + (size_t)u.pn * 256) * K * 2; }
    __device__ __forceinline__ void aoff(const Unit& u, const int (&R)[2], const int (&C)[2], unsigned (&v)[2][2]) const {
        int b_e = 0;
#pragma unroll
        for (int k = 0; k < NE; ++k) b_e = (k == u.e) ? cum[k] : b_e;
        const int p = u.pm - b_e;
#pragma unroll
        for (int h = 0; h < 2; ++h)
#pragma unroll
            for (int i = 0; i < 2; ++i) {
                const int r = h * HALF + R[i];
                if (gather) { int tok = 0; if (r < u.nv) tok = lists[u.e * S + 256 * p + r] >> 1; v[h][i] = (unsigned)(tok * K + C[i]) * 2u; }
                else v[h][i] = (unsigned)(r * K + C[i]) * 2u;
            }
    }
};

template <class Epi, class Sched, bool ALIGN_EPI>
__device__ __forceinline__ void gemm_phase(LAS unsigned char* lds, const int K, const Sched& S_, const Epi& E) {
    int tid_ = threadIdx.x; asm volatile("" : "+v"(tid_));
    const int tid = tid_, wid = __builtin_amdgcn_readfirstlane(tid >> 6), lane = tid & 63, wr = wid >> 2, wc = wid & 3, fr = lane & 15, fq = lane >> 4;
    const int nt = K / BK;
    int Rr[2], Cc[2]; unsigned voffB[2];
#pragma unroll
    for (int i = 0; i < 2; ++i) { int R, C; stage_rc(tid * 16 + i * 8192, R, C); Rr[i] = R; Cc[i] = C; const int Rb = Epi::PERM ? ((R & ~31) + perm32(R & 31)) : R; voffB[i] = (unsigned)(Rb * K + C) * 2u; }
    const size_t kstep = (size_t)(BK * 2);
    const size_t hstep = (size_t)HALF * K * 2;
    const unsigned ldsw = (unsigned)wid * 1024u;
    const int aoff = lds_byte(wr * 64 + fr, fq * 8), boff = lds_byte(wc * 32 + fr, fq * 8);
#define PG8_SA(b, h) (((b) * 2 + (h)) * HTB)
#define PG8_SB(b, h) ((4 + (b) * 2 + (h)) * HTB)
#define PG8_STAGE(bufoff, gbase, voff) do { _Pragma("unroll") for (int _i = 0; _i < 2; ++_i) \
        __builtin_amdgcn_global_load_lds((const unsigned*)((const char*)(gbase) + (voff)[_i]), (LAS unsigned*)(lds + (bufoff) + ldsw + _i * 8192), 16, 0, 0); } while (0)
#define PG8_LDA(dst, b, h) do { _Pragma("unroll") for (int m = 0; m < 4; ++m) _Pragma("unroll") for (int k = 0; k < 2; ++k) dst[m][k] = *(const LAS bf16x8*)(lds + PG8_SA(b, h) + aoff + m * 2048 + k * 1024); } while (0)
#define PG8_LDB(dst, b, h) do { _Pragma("unroll") for (int n = 0; n < 2; ++n) _Pragma("unroll") for (int k = 0; k < 2; ++k) dst[n][k] = *(const LAS bf16x8*)(lds + PG8_SB(b, h) + boff + n * 2048 + k * 1024); } while (0)
#define PG8_MMA(ai, bj, At, Bt) do { __builtin_amdgcn_s_setprio(1); _Pragma("unroll") for (int m = 0; m < 4; ++m) _Pragma("unroll") for (int n = 0; n < 2; ++n) _Pragma("unroll") for (int k = 0; k < 2; ++k) \
        acc[ai][bj][m][n] = __builtin_amdgcn_mfma_f32_16x16x32_bf16(Bt[n][k], At[m][k], acc[ai][bj][m][n], 0, 0, 0); __builtin_amdgcn_s_setprio(0); } while (0)
#define PG8_WAIT_V(n) asm volatile("s_waitcnt vmcnt(" #n ")" ::: "memory")
#define PG8_WAIT_L(n) asm volatile("s_waitcnt lgkmcnt(" #n ")" ::: "memory")
#define PG8_BAR __builtin_amdgcn_s_barrier()
#define PG8_SCHED __builtin_amdgcn_sched_barrier(0)
    Unit cur, nxt; int ui = 0;
    if (!S_.next(0, cur)) return;
    f32x4 acc[2][2][4][2];
#pragma unroll
    for (int a = 0; a < 2; ++a)
#pragma unroll
        for (int b = 0; b < 2; ++b)
#pragma unroll
            for (int m = 0; m < 4; ++m)
#pragma unroll
                for (int n = 0; n < 2; ++n) acc[a][b][m][n] = (f32x4){0.f, 0.f, 0.f, 0.f};
    bf16x8 At[4][2], B0[2][2], B1[2][2];
    const char* cA = S_.abase(cur); const char* cB = S_.bbase(cur);
    unsigned vA[2][2], nvA[2][2]; S_.aoff(cur, Rr, Cc, vA);
    typename Epi::Pre pre = E.prefetch(cur, wr, fr);
    PG8_STAGE(PG8_SB(0, 0), cB, voffB); PG8_STAGE(PG8_SB(0, 1), cB + hstep, voffB); PG8_STAGE(PG8_SA(0, 0), cA, vA[0]); PG8_STAGE(PG8_SA(0, 1), cA, vA[1]);
    if (wr == 1) PG8_BAR;
    PG8_WAIT_V(2); PG8_BAR;
    PG8_STAGE(PG8_SB(1, 0), cB + kstep, voffB); PG8_STAGE(PG8_SA(1, 0), cA + kstep, vA[0]); PG8_STAGE(PG8_SB(1, 1), cB + hstep + kstep, voffB);
    PG8_WAIT_V(6); PG8_BAR;
    for (;;) {
        const bool has_next = S_.next(ui + 1, nxt);
        const char* nA = has_next ? S_.abase(nxt) : cA; const char* nB = has_next ? S_.bbase(nxt) : cB;
        if (has_next) S_.aoff(nxt, Rr, Cc, nvA); else {
#pragma unroll
            for (int h = 0; h < 2; ++h)
#pragma unroll
                for (int i = 0; i < 2; ++i) nvA[h][i] = vA[h][i]; }
        for (int t = 0; t < nt; t += 2) {
            const bool last = (t == nt - 2);
            const char* a1 = cA + (size_t)(t + 1) * kstep;
            const char* a2 = last ? nA : cA + (size_t)(t + 2) * kstep; const char* b2 = last ? nB : cB + (size_t)(t + 2) * kstep;
            const char* a3 = a2 + kstep; const char* b3 = b2 + kstep;
            unsigned wA[2][2];
#pragma unroll
            for (int h = 0; h < 2; ++h)
#pragma unroll
                for (int i = 0; i < 2; ++i) wA[h][i] = last ? nvA[h][i] : vA[h][i];
            PG8_LDB(B0, 0, 0); PG8_LDB(B1, 0, 1); PG8_SCHED; PG8_LDA(At, 0, 0); PG8_STAGE(PG8_SA(1, 1), a1, vA[1]);
            PG8_WAIT_V(8); PG8_WAIT_L(0); PG8_BAR; PG8_MMA(0, 0, At, B0); PG8_MMA(0, 1, At, B1); PG8_BAR; PG8_SCHED;
            PG8_LDA(At, 0, 1); PG8_STAGE(PG8_SB(0, 0), b2, voffB); PG8_STAGE(PG8_SB(0, 1), b2 + hstep, voffB); PG8_STAGE(PG8_SA(0, 0), a2, wA[0]);
            PG8_WAIT_V(8); PG8_WAIT_L(0); PG8_BAR; PG8_MMA(1, 0, At, B0); PG8_MMA(1, 1, At, B1); PG8_BAR; PG8_SCHED;
            PG8_LDB(B0, 1, 0); PG8_LDB(B1, 1, 1); PG8_SCHED; PG8_LDA(At, 1, 0); PG8_STAGE(PG8_SA(0, 1), a2, wA[1]);
            PG8_WAIT_V(8); PG8_WAIT_L(0); PG8_BAR; PG8_MMA(0, 0, At, B0); PG8_MMA(0, 1, At, B1); PG8_BAR; PG8_SCHED;
            PG8_LDA(At, 1, 1); PG8_STAGE(PG8_SB(1, 0), b3, voffB); PG8_STAGE(PG8_SB(1, 1), b3 + hstep, voffB); PG8_STAGE(PG8_SA(1, 0), a3, wA[0]);
            PG8_WAIT_V(8); PG8_WAIT_L(0); PG8_BAR; PG8_MMA(1, 0, At, B0); PG8_MMA(1, 1, At, B1); PG8_BAR; PG8_SCHED;
        }
        if constexpr (ALIGN_EPI) { if (wr == 0) PG8_BAR; }
        asm volatile(NOP64 NOP64 : "+v"(acc[0][0][0][0]), "+v"(acc[0][0][0][1]), "+v"(acc[0][0][1][0]), "+v"(acc[0][0][1][1]), "+v"(acc[0][0][2][0]), "+v"(acc[0][0][2][1]), "+v"(acc[0][0][3][0]), "+v"(acc[0][0][3][1]),
                                   "+v"(acc[0][1][0][0]), "+v"(acc[0][1][0][1]), "+v"(acc[0][1][1][0]), "+v"(acc[0][1][1][1]), "+v"(acc[0][1][2][0]), "+v"(acc[0][1][2][1]), "+v"(acc[0][1][3][0]), "+v"(acc[0][1][3][1]) :: "memory");
        asm volatile("" : "+v"(acc[1][0][0][0]), "+v"(acc[1][0][0][1]), "+v"(acc[1][0][1][0]), "+v"(acc[1][0][1][1]), "+v"(acc[1][0][2][0]), "+v"(acc[1][0][2][1]), "+v"(acc[1][0][3][0]), "+v"(acc[1][0][3][1]),
                          "+v"(acc[1][1][0][0]), "+v"(acc[1][1][0][1]), "+v"(acc[1][1][1][0]), "+v"(acc[1][1][1][1]), "+v"(acc[1][1][2][0]), "+v"(acc[1][1][2][1]), "+v"(acc[1][1][3][0]), "+v"(acc[1][1][3][1]) :: "memory");
        E(acc, cur, wr, wc, fr, fq, pre);
        if (!has_next) break;
#pragma unroll
        for (int a = 0; a < 2; ++a)
#pragma unroll
            for (int b = 0; b < 2; ++b)
#pragma unroll
                for (int m = 0; m < 4; ++m)
#pragma unroll
                    for (int n = 0; n < 2; ++n) acc[a][b][m][n] = (f32x4){0.f, 0.f, 0.f, 0.f};
        cur = nxt; cA = nA; cB = nB; ++ui;
        pre = E.prefetch(cur, wr, fr);
#pragma unroll
        for (int h = 0; h < 2; ++h)
#pragma unroll
            for (int i = 0; i < 2; ++i) vA[h][i] = nvA[h][i];
        if constexpr (ALIGN_EPI) { if (wr == 1) PG8_BAR; }
    }
    PG8_WAIT_V(0);
    if constexpr (!ALIGN_EPI) { if (wr == 0) PG8_BAR; }
    PG8_BAR;
#undef PG8_SA
#undef PG8_SB
#undef PG8_STAGE
#undef PG8_LDA
#undef PG8_LDB
#undef PG8_MMA
#undef PG8_WAIT_V
#undef PG8_WAIT_L
#undef PG8_BAR
#undef PG8_SCHED
}

typedef const f32x4 (&AccRef)[2][2][4][2];

struct EpiProj {
    static constexpr bool PERM = true;
    bf16* Q; bf16* GA; const float* rstd;
    struct Pre { float rs[2][4]; };
    __device__ __forceinline__ Pre prefetch(const Unit& u, int wr, int fr) const { Pre p;
#pragma unroll
        for (int ai = 0; ai < 2; ++ai)
#pragma unroll
            for (int m = 0; m < 4; ++m) p.rs[ai][m] = rstd[u.pm * BM + wr * 64 + fr + ai * HALF + m * 16];
        return p; }
    __device__ __forceinline__ void operator()(AccRef acc_, const Unit& u, int wr, int wc, int fr, int fq, const Pre& pre) const {
        const int row0 = u.pm * BM + wr * 64 + fr;
        f32x4 acc[2][2][4][2];
#pragma unroll
        for (int ai = 0; ai < 2; ++ai)
#pragma unroll
            for (int m = 0; m < 4; ++m) { const float rs = pre.rs[ai][m];
#pragma unroll
                for (int bj = 0; bj < 2; ++bj)
#pragma unroll
                    for (int n = 0; n < 2; ++n) acc[ai][bj][m][n] = acc_[ai][bj][m][n] * rs; }
        if (u.pn < 16) {
            bf16* base = Q + (size_t)(u.pn >> 2) * ((size_t)S * 1024) + (u.pn & 3) * 256 + wc * 32 + 8 * fq;
#pragma unroll
            for (int ai = 0; ai < 2; ++ai)
#pragma unroll
                for (int m = 0; m < 4; ++m) { bf16* rowp = base + (size_t)(row0 + ai * HALF + m * 16) * 1024;
#pragma unroll
                    for (int bj = 0; bj < 2; ++bj) { const f32x4 v0 = acc[ai][bj][m][0], v1 = acc[ai][bj][m][1];
                        u32x4 w; w.x = cvt_pk_bf16(v0[0], v0[1]); w.y = cvt_pk_bf16(v0[2], v0[3]); w.z = cvt_pk_bf16(v1[0], v1[1]); w.w = cvt_pk_bf16(v1[2], v1[3]);
                        *(u32x4*)(rowp + bj * HALF) = w; } }
        } else {
            const int pg = u.pn - 16;
            bf16* base = GA + (size_t)(pg >> 3) * ((size_t)S * 2048) + (pg & 7) * 256 + wc * 32 + 8 * fq;
#pragma unroll
            for (int ai = 0; ai < 2; ++ai)
#pragma unroll
                for (int m = 0; m < 4; ++m) { bf16* rowp = base + (size_t)(row0 + ai * HALF + m * 16) * 2048;
#pragma unroll
                    for (int bj = 0; bj < 2; ++bj) { f32x4 v0 = acc[ai][bj][m][0], v1 = acc[ai][bj][m][1];
#pragma unroll
                        for (int j = 0; j < 4; ++j) { v0[j] = sigmoidf_(v0[j]); v1[j] = sigmoidf_(v1[j]); }
                        u32x4 w; w.x = cvt_pk_bf16(v0[0], v0[1]); w.y = cvt_pk_bf16(v0[2], v0[3]); w.z = cvt_pk_bf16(v1[0], v1[1]); w.w = cvt_pk_bf16(v1[2], v1[3]);
                        *(u32x4*)(rowp + bj * HALF) = w; } }
        }
    }
};
template <int MODE> struct EpiGate {
    static constexpr bool PERM = true;
    const bf16* G; bf16* O; int ld; bf16* Ost = nullptr;
    struct Pre {}; __device__ __forceinline__ Pre prefetch(const Unit&, int, int) const { return Pre{}; }
    __device__ __forceinline__ void operator()(AccRef acc, const Unit& u, int wr, int wc, int fr, int fq, const Pre&) const {
        const int row0 = u.pm * BM + wr * 64 + fr, col0 = u.pn * BM + wc * 32 + 8 * fq; bf16* const Ow = Ost ? Ost : O;
#pragma unroll
        for (int ai = 0; ai < 2; ++ai) {
            u32x4 gv[4][2], ov[4][2];
#pragma unroll
            for (int m = 0; m < 4; ++m)
#pragma unroll
                for (int bj = 0; bj < 2; ++bj) { const size_t off = (size_t)(row0 + ai * HALF + m * 16) * ld + col0 + bj * HALF;
                    gv[m][bj] = *(const u32x4*)(G + off); if (MODE == 2) ov[m][bj] = *(const u32x4*)(O + off); }
#pragma unroll
            for (int m = 0; m < 4; ++m)
#pragma unroll
                for (int bj = 0; bj < 2; ++bj) { const size_t off = (size_t)(row0 + ai * HALF + m * 16) * ld + col0 + bj * HALF;
                    const f32x4 v0 = acc[ai][bj][m][0], v1 = acc[ai][bj][m][1]; const u32x4 g = gv[m][bj];
                    float a[8] = {v0[0], v0[1], v0[2], v0[3], v1[0], v1[1], v1[2], v1[3]};
                    const float gg[8] = {bflo(g.x), bfhi(g.x), bflo(g.y), bfhi(g.y), bflo(g.z), bfhi(g.z), bflo(g.w), bfhi(g.w)};
                    if (MODE == 1) {
#pragma unroll
                        for (int j = 0; j < 8; ++j) a[j] = gg[j] * sigmoidf_(a[j]);
                    } else if (MODE == 0) {
#pragma unroll
                        for (int j = 0; j < 8; ++j) a[j] = gg[j] * a[j];
                    } else {
                        const u32x4 o = ov[m][bj];
                        const float oo[8] = {bflo(o.x), bfhi(o.x), bflo(o.y), bfhi(o.y), bflo(o.z), bfhi(o.z), bflo(o.w), bfhi(o.w)};
#pragma unroll
                        for (int j = 0; j < 8; ++j) a[j] = oo[j] + gg[j] * a[j];
                    }
                    u32x4 w; w.x = cvt_pk_bf16(a[0], a[1]); w.y = cvt_pk_bf16(a[2], a[3]); w.z = cvt_pk_bf16(a[4], a[5]); w.w = cvt_pk_bf16(a[6], a[7]);
                    *(u32x4*)(Ow + off) = w; }
            asm volatile("" ::: "memory");
        }
    }
};
template <bool IN_F32> struct EpiResid {
    static constexpr bool PERM = true;
    const float* xin32; const bf16* xin16; bf16* xout;
    struct Pre {}; __device__ __forceinline__ Pre prefetch(const Unit&, int, int) const { return Pre{}; }
    __device__ __forceinline__ void operator()(AccRef acc, const Unit& u, int wr, int wc, int fr, int fq, const Pre&) const {
        const int row0 = u.pm * BM + wr * 64 + fr, col0 = u.pn * BM + wc * 32 + 8 * fq;
#pragma unroll
        for (int ai = 0; ai < 2; ++ai) {
            f32x4 xf[4][2][2]; u32x4 xh[4][2];
#pragma unroll
            for (int m = 0; m < 4; ++m)
#pragma unroll
                for (int bj = 0; bj < 2; ++bj) { const size_t off = (size_t)(row0 + ai * HALF + m * 16) * D + col0 + bj * HALF;
                    if (IN_F32) { xf[m][bj][0] = *(const f32x4*)(xin32 + off); xf[m][bj][1] = *(const f32x4*)(xin32 + off + 4); } else xh[m][bj] = *(const u32x4*)(xin16 + off); }
#pragma unroll
            for (int m = 0; m < 4; ++m)
#pragma unroll
                for (int bj = 0; bj < 2; ++bj) { const size_t off = (size_t)(row0 + ai * HALF + m * 16) * D + col0 + bj * HALF;
                    f32x4 a0 = acc[ai][bj][m][0], a1 = acc[ai][bj][m][1];
                    if (IN_F32) { a0 += xf[m][bj][0]; a1 += xf[m][bj][1]; }
                    else { const u32x4 h = xh[m][bj]; a0 += (f32x4){bflo(h.x), bfhi(h.x), bflo(h.y), bfhi(h.y)}; a1 += (f32x4){bflo(h.z), bfhi(h.z), bflo(h.w), bfhi(h.w)}; }
                    u32x4 w; w.x = cvt_pk_bf16(a0[0], a0[1]); w.y = cvt_pk_bf16(a0[2], a0[3]); w.z = cvt_pk_bf16(a1[0], a1[1]); w.w = cvt_pk_bf16(a1[2], a1[3]);
                    *(u32x4*)(xout + off) = w; }
            asm volatile("" ::: "memory");
        }
    }
};
struct EpiSwiglu {
    static constexpr bool PERM = true;
    bf16* O; int ld; const float* rstd; bool moe; int cumv[NE];
    struct Pre { float rs[2][4]; };
    __device__ __forceinline__ Pre prefetch(const Unit& u, int wr, int fr) const { Pre pp;
        int b_e = 0;
#pragma unroll
        for (int k = 0; k < NE; ++k) b_e = (k == u.e) ? cumv[k] : b_e;
        const int p = u.pm - b_e;
#pragma unroll
        for (int ai = 0; ai < 2; ++ai)
#pragma unroll
            for (int m = 0; m < 4; ++m) { const int r = ai * HALF + wr * 64 + m * 16 + fr; int idx = u.pm * BM + r;
                if (moe) idx = u.e * S + ((r < u.nv) ? 256 * p + r : 0);
                pp.rs[ai][m] = rstd[idx]; }
        return pp; }
    __device__ __forceinline__ void operator()(AccRef acc, const Unit& u, int wr, int wc, int fr, int fq, const Pre& pre) const {
        const int row0 = u.pm * BM + wr * 64 + fr, col0 = u.pn * HALF + wc * 32 + 8 * fq;
#pragma unroll
        for (int ai = 0; ai < 2; ++ai)
#pragma unroll
            for (int m = 0; m < 4; ++m) { bf16* rowp = O + (size_t)(row0 + ai * HALF + m * 16) * ld + col0; const float rs = pre.rs[ai][m];
                float a[8];
#pragma unroll
                for (int n = 0; n < 2; ++n)
#pragma unroll
                    for (int j = 0; j < 4; ++j) { const float g = acc[ai][0][m][n][j] * rs, up = acc[ai][1][m][n][j] * rs; a[n * 4 + j] = g * sigmoidf_(g) * up; }
                u32x4 w; w.x = cvt_pk_bf16(a[0], a[1]); w.y = cvt_pk_bf16(a[2], a[3]); w.z = cvt_pk_bf16(a[4], a[5]); w.w = cvt_pk_bf16(a[6], a[7]);
                *(u32x4*)rowp = w; }
    }
};
struct EpiMoeDown {
    static constexpr bool PERM = true;
    bf16* O; const int* lists; const float* gw; int cumv[NE];
    struct Pre {}; __device__ __forceinline__ Pre prefetch(const Unit&, int, int) const { return Pre{}; }
    __device__ __forceinline__ void operator()(AccRef acc, const Unit& u, int wr, int wc, int fr, int fq, const Pre&) const {
        int b_e = 0;
#pragma unroll
        for (int k = 0; k < NE; ++k) b_e = (k == u.e) ? cumv[k] : b_e;
        const int p = u.pm - b_e; const int col0 = u.pn * BM + wc * 32 + 8 * fq;
#pragma unroll
        for (int ai = 0; ai < 2; ++ai)
#pragma unroll
            for (int m = 0; m < 4; ++m) { const int r = ai * HALF + wr * 64 + m * 16 + fr;
                if (r < u.nv) { const int slot = lists[u.e * S + 256 * p + r]; const float g = gw[slot]; bf16* rowp = O + (size_t)slot * D + col0;
#pragma unroll
                    for (int bj = 0; bj < 2; ++bj) { const f32x4 v0 = acc[ai][bj][m][0] * g, v1 = acc[ai][bj][m][1] * g;
                        u32x4 w; w.x = cvt_pk_bf16(v0[0], v0[1]); w.y = cvt_pk_bf16(v0[2], v0[3]); w.z = cvt_pk_bf16(v1[0], v1[1]); w.w = cvt_pk_bf16(v1[2], v1[3]);
                        *(u32x4*)(rowp + bj * HALF) = w; } } }
    }
};
}

struct Args { const float* in[24]; float* out; unsigned char* ws; int ph_lo, ph_hi; };
struct Frame {
    LAS unsigned char* lds;
    gu32* ctl;
    unsigned char* ws;
    int tid, lane, wave, vcu, G, bid;
    const struct Args __attribute__((address_space(4)))* ka;
};

struct TItem { const float* src; bf16* dst; const float* gk; int N, K, k0, n0, drow0; };
__device__ __forceinline__ TItem titem(const float* W, int K, int N, bf16* WT, int il  , int item, const float* gk) {
    TItem t; const int nblk = N / 32, kb = item / nblk, nb = item % nblk; t.src = W; t.dst = WT; t.gk = gk; t.N = N; t.K = K; t.k0 = 64 * kb; t.n0 = 32 * nb;
    t.drow0 = il ? ((t.n0 >> 7) * 256 + (t.n0 & 127) + (il == 2 ? 128 : 0)) : t.n0; return t;
}
__device__ __forceinline__ void titem_load(const TItem& t, float (&v)[32], int lane) {
    const float* p = t.src + (size_t)(t.k0 + (lane >> 5)) * t.N + t.n0 + (lane & 31);
#pragma unroll
    for (int i = 0; i < 32; ++i) v[i] = p[(size_t)(2 * i) * t.N];
}
__device__ __forceinline__ void titem_store(const TItem& t, const float (&v)[32], LAS float* scr, int lane) {
#pragma unroll
    for (int i = 0; i < 32; ++i) scr[(2 * i + (lane >> 5)) * 33 + (lane & 31)] = v[i];
    LDS_WAIT(); asm volatile("" ::: "memory");
    const int c = lane & 7;
    f32x4 g0 = (f32x4){1.f, 1.f, 1.f, 1.f}, g1 = g0;
    if (t.gk) { g0 = *(const f32x4*)(t.gk + t.k0 + 8 * c); g1 = *(const f32x4*)(t.gk + t.k0 + 8 * c + 4); }
#pragma unroll
    for (int j = 0; j < 4; ++j) { const int n = (lane >> 3) + 8 * j; const LAS float* s = scr + (8 * c) * 33 + n;
        u32x4 o; o.x = pk2(s[0 * 33] * g0.x, s[1 * 33] * g0.y); o.y = pk2(s[2 * 33] * g0.z, s[3 * 33] * g0.w); o.z = pk2(s[4 * 33] * g1.x, s[5 * 33] * g1.y); o.w = pk2(s[6 * 33] * g1.z, s[7 * 33] * g1.w);
        *(GAS u32x4*)(t.dst + (size_t)(t.drow0 + n) * t.K + t.k0 + 8 * c) = o; }
    LDS_WAIT(); asm volatile("" ::: "memory");
}
__device__ __forceinline__ float row32_to_bf16_rstd(Frame& F, const float* xrow, bf16* orow) {
    const GAS f32x4* xr = (const GAS f32x4*)xrow + F.lane; GAS unsigned long long* o8 = (GAS unsigned long long*)orow + F.lane; float s = 0.f;
#pragma unroll
    for (int j = 0; j < 8; ++j) { const f32x4 v = xr[64 * j]; const unsigned w0 = pk2(v.x, v.y), w1 = pk2(v.z, v.w); o8[64 * j] = (unsigned long long)w0 | ((unsigned long long)w1 << 32);
        const float a0 = bflo(w0), a1 = bfhi(w0), a2 = bflo(w1), a3 = bfhi(w1); s += (a0 * a0 + a1 * a1) + (a2 * a2 + a3 * a3); }
    return 1.0f / sqrtf(wave_sum(s) * (1.f / D) + RMS_EPS);
}
__device__ __forceinline__ float rms_row16_rstd(Frame& F, const bf16* xrow) {
    const GAS u32x4* xr = (const GAS u32x4*)xrow + F.lane; float s = 0.f;
#pragma unroll
    for (int j = 0; j < 4; ++j) { const u32x4 h = xr[64 * j]; const float a0 = bflo(h.x), a1 = bfhi(h.x), a2 = bflo(h.y), a3 = bfhi(h.y), a4 = bflo(h.z), a5 = bfhi(h.z), a6 = bflo(h.w), a7 = bfhi(h.w);
        s += ((a0 * a0 + a1 * a1) + (a2 * a2 + a3 * a3)) + ((a4 * a4 + a5 * a5) + (a6 * a6 + a7 * a7)); }
    return 1.0f / sqrtf(wave_sum(s) * (1.f / D) + RMS_EPS);
}
__device__ __forceinline__ void rms_row16_to_bf16(Frame& F, const bf16* xrow, const float* g, bf16* orow) {
    const GAS u32x4* xr = (const GAS u32x4*)xrow + F.lane; const GAS f32x4* gr = (const GAS f32x4*)g + 2 * F.lane;
    float v[4][8]; float s = 0.f;
#pragma unroll
    for (int j = 0; j < 4; ++j) { const u32x4 h = xr[64 * j]; v[j][0] = bflo(h.x); v[j][1] = bfhi(h.x); v[j][2] = bflo(h.y); v[j][3] = bfhi(h.y); v[j][4] = bflo(h.z); v[j][5] = bfhi(h.z); v[j][6] = bflo(h.w); v[j][7] = bfhi(h.w);
#pragma unroll
        for (int q = 0; q < 8; ++q) s += v[j][q] * v[j][q]; }
    const float rstd = 1.0f / sqrtf(wave_sum(s) * (1.f / D) + RMS_EPS);
    GAS u32x4* o = (GAS u32x4*)orow + F.lane;
#pragma unroll
    for (int j = 0; j < 4; ++j) { const f32x4 g0 = gr[128 * j], g1 = gr[128 * j + 1]; u32x4 w;
        w.x = pk2(v[j][0] * rstd * g0.x, v[j][1] * rstd * g0.y); w.y = pk2(v[j][2] * rstd * g0.z, v[j][3] * rstd * g0.w);
        w.z = pk2(v[j][4] * rstd * g1.x, v[j][5] * rstd * g1.y); w.w = pk2(v[j][6] * rstd * g1.z, v[j][7] * rstd * g1.w); o[64 * j] = w; }
}
__device__ __forceinline__ void rms_row_to_bf16(Frame& F, const float* xrow, const float* g, bf16* orow) {
    const GAS f32x4* xr = (const GAS f32x4*)xrow + F.lane; const GAS f32x4* gr = (const GAS f32x4*)g + F.lane;
    f32x4 v[8]; float s = 0.f;
#pragma unroll
    for (int j = 0; j < 8; ++j) { v[j] = xr[64 * j]; s += (v[j].x * v[j].x + v[j].y * v[j].y) + (v[j].z * v[j].z + v[j].w * v[j].w); }
    const float rstd = 1.0f / sqrtf(wave_sum(s) * (1.f / D) + RMS_EPS);
    GAS unsigned long long* o8 = (GAS unsigned long long*)orow + F.lane;
#pragma unroll
    for (int j = 0; j < 8; ++j) { const f32x4 gg = gr[64 * j]; o8[64 * j] = (unsigned long long)pk2(v[j].x * rstd * gg.x, v[j].y * rstd * gg.y) | ((unsigned long long)pk2(v[j].z * rstd * gg.z, v[j].w * rstd * gg.w) << 32); }
}

__device__ __forceinline__ void cis_d(double th, float& c, float& s) {
    const double TWO_PI = 6.283185307179586476925286766559;
    const double k = rint(th / TWO_PI); const float r = (float)(th - k * TWO_PI);
    c = cosf(r); s = sinf(r);
}
__device__ __forceinline__ void ssm_tables_group(Frame& F, int g, const float* a_re, const float* a_im, const float* log_dt, const float* b_re, const float* b_im,
                                                 const float* c_re, const float* c_im) {
    const int n = F.lane;
    const double dt = exp((double)log_dt[g]); const double ar = (double)a_re[g * SN + n], ai = (double)a_im[g * SN + n];
    float cr, sr; cis_d(dt * ai, cr, sr); const float mag = (float)exp(dt * ar);
    const float abr = mag * cr, abi = mag * sr;
    float cl, sl; cis_d(dt * ai * (double)CH, cl, sl); const float magl = (float)exp(dt * ar * (double)CH);
    float* abar = (float*)(F.ws + WS_SSMT + ST_ABAR); float* abarl = (float*)(F.ws + WS_SSMT + ST_ABARL);
    abar[(g * SN + n) * 2] = abr; abar[(g * SN + n) * 2 + 1] = abi; abarl[(g * SN + n) * 2] = magl * cl; abarl[(g * SN + n) * 2 + 1] = magl * sl;
    const float arf = (float)ar, aif = (float)ai; const float den = arf * arf + aif * aif; const float nre = abr - 1.0f;
    const float zre = (nre * arf + abi * aif) / den, zim = (abi * arf - nre * aif) / den;
    bf16* bbf = (bf16*)(F.ws + WS_SSMT + ST_BBF);
#pragma unroll
    for (int q = 0; q < SP; ++q) {
        const float br = b_re[(g * SN + n) * SP + q], bi = b_im[(g * SN + n) * SP + q];
        const float re = zre * br - zim * bi, im = zre * bi + zim * br;
        const int l = (n & 31) + 32 * (q >> 3), j = q & 7;
        bbf[((size_t)(g * 4 + (n >> 5)) * 64 + l) * 8 + j] = (bf16)f2bf(re);
        bbf[((size_t)(g * 4 + 2 + (n >> 5)) * 64 + l) * 8 + j] = (bf16)f2bf(im);
    }
    bf16* ctf = (bf16*)(F.ws + WS_SSMT + ST_CTF);
    for (int kk = 0; kk < 4; ++kk)
#pragma unroll
        for (int j = 0; j < 8; ++j) { const int l = F.lane, kp = 32 * kk + 8 * (l >> 4) + j, st = kp >> 1, p = l & 15;
            const float v = (kp & 1) ? -c_im[(g * SP + p) * SN + st] : c_re[(g * SP + p) * SN + st];
            ctf[((size_t)(g * 4 + kk) * 64 + l) * 8 + j] = (bf16)f2bf(v); }
}

constexpr int XROWB = 272;
constexpr size_t WS_RT = 574 * MiB;
__device__ __forceinline__ void cmul_acc(float& xr, float& xi, float ar, float ai, float br, float bi) {
    const float nr = ar * xr - ai * xi + br, ni = ar * xi + ai * xr + bi; xr = nr; xi = ni;
}
template <bool READOUT>
__device__ __forceinline__ void ssm_run(Frame& F, int g, int run, const bf16* U, bf16* Y, const float* dskip, LAS unsigned char* xl) {
    const int lane = F.lane, ci = lane & 31, hh = lane >> 5, c0 = run * 8;
    const float* abar = (const float*)(F.ws + WS_SSMT + ST_ABAR); const float* abarl = (const float*)(F.ws + WS_SSMT + ST_ABARL);
    float* XE = (float*)(F.ws + WS_XE) + (size_t)g * NCH * 128;
    float* RT = (float*)(F.ws + WS_RT) + (size_t)g * 64 * 128;
    float ar[2], ai[2], lr[2], li[2];
#pragma unroll
    for (int s = 0; s < 2; ++s) { const int n = ci + 32 * s; ar[s] = abar[(g * SN + n) * 2]; ai[s] = abar[(g * SN + n) * 2 + 1]; lr[s] = abarl[(g * SN + n) * 2]; li[s] = abarl[(g * SN + n) * 2 + 1]; }
    bf16x8 bfr[4], ctf[4];
#pragma unroll
    for (int nt = 0; nt < 4; ++nt) bfr[nt] = *(const bf16x8*)((const bf16*)(F.ws + WS_SSMT + ST_BBF) + ((size_t)(g * 4 + nt) * 64 + lane) * 8);
    float dsk = 0.f;
    float xr[2] = {0.f, 0.f}, xi[2] = {0.f, 0.f};
    float xer[4][2], xei[4][2];
    float l2r[2], l2i[2];
#pragma unroll
    for (int s = 0; s < 2; ++s) { l2r[s] = lr[s] * lr[s] - li[s] * li[s]; l2i[s] = 2.f * lr[s] * li[s]; }
    if (READOUT) {
#pragma unroll
        for (int kk = 0; kk < 4; ++kk) ctf[kk] = *(const bf16x8*)((const bf16*)(F.ws + WS_SSMT + ST_CTF) + ((size_t)(g * 4 + kk) * 64 + lane) * 8);
        dsk = dskip[g * SP + (lane & 15)];
#pragma unroll
        for (int u = 0; u < 4; ++u)
#pragma unroll
            for (int s = 0; s < 2; ++s) { const int cx = (u == 0) ? c0 : (c0 + 2 * u + hh - 1); xer[u][s] = XE[cx * 128 + ci + 32 * s]; xei[u][s] = XE[cx * 128 + 64 + ci + 32 * s]; }
        float l8r[2], l8i[2];
#pragma unroll
        for (int s = 0; s < 2; ++s) { const float l4r = l2r[s] * l2r[s] - l2i[s] * l2i[s], l4i = 2.f * l2r[s] * l2i[s]; l8r[s] = l4r * l4r - l4i * l4i; l8i[s] = 2.f * l4r * l4i; }
        for (int rb = 0; rb < run; rb += 8) {
            float tr[8][2], ti[8][2];
#pragma unroll
            for (int q = 0; q < 8; ++q)
#pragma unroll
                for (int s = 0; s < 2; ++s) { const int rr = (rb + q < run) ? rb + q : 0; tr[q][s] = RT[rr * 128 + ci + 32 * s] + RT[(32 + rr) * 128 + ci + 32 * s]; ti[q][s] = RT[rr * 128 + 64 + ci + 32 * s] + RT[(32 + rr) * 128 + 64 + ci + 32 * s]; }
#pragma unroll
            for (int q = 0; q < 8; ++q) if (rb + q < run) {
#pragma unroll
                for (int s = 0; s < 2; ++s) cmul_acc(xr[s], xi[s], l8r[s], l8i[s], tr[q][s], ti[q][s]); }
        }
        if (hh) {
#pragma unroll
            for (int s = 0; s < 2; ++s) cmul_acc(xr[s], xi[s], lr[s], li[s], xer[0][s], xei[0][s]); }
    }
    float hr[2] = {0.f, 0.f}, hi2[2] = {0.f, 0.f};
    bf16x8 afn[4]; bf16 uvn[2][4];
#pragma unroll
    for (int u = 0; u < 4; ++u) {
        const int cA = c0 + 2 * u, cm = cA + hh;
        if (!READOUT) { xr[0] = xr[1] = xi[0] = xi[1] = 0.f; }
        else if (u > 0) {
#pragma unroll
            for (int s = 0; s < 2; ++s) cmul_acc(xr[s], xi[s], lr[s], li[s], xer[u][s], xei[u][s]);
        }
        bf16x8 af[4];
        if (u == 0) { const int seg = (ci >> 2) & 1, tk = 4 * (ci >> 3) + (ci & 3);
#pragma unroll
          for (int k = 0; k < 4; ++k) afn[k] = *(const bf16x8*)(U + (size_t)((cA + seg) * CH + 16 * k + tk) * SSMW + g * SP + 8 * hh);
          if (READOUT) {
#pragma unroll
              for (int sg = 0; sg < 2; ++sg)
#pragma unroll
                  for (int r = 0; r < 4; ++r) uvn[sg][r] = U[(size_t)((cA + sg) * CH + 4 * (lane >> 4) + r) * SSMW + g * SP + (lane & 15)]; } }
#pragma unroll
        for (int k = 0; k < 4; ++k) af[k] = afn[k];
        if (u < 3) { const int seg = (ci >> 2) & 1, tk = 4 * (ci >> 3) + (ci & 3);
#pragma unroll
          for (int k = 0; k < 4; ++k) afn[k] = *(const bf16x8*)(U + (size_t)((cA + 2 + seg) * CH + 16 * k + tk) * SSMW + g * SP + 8 * hh); }
#pragma unroll
        for (int k = 0; k < 4; ++k) {
            float uv[2][4];
            if (READOUT) {
#pragma unroll
                for (int sg = 0; sg < 2; ++sg)
#pragma unroll
                    for (int r = 0; r < 4; ++r) uv[sg][r] = bf2f(uvn[sg][r]);
                if (k < 3 || u < 3) { const int cn = (k < 3) ? cA : cA + 2, kn = (k < 3) ? k + 1 : 0;
#pragma unroll
                    for (int sg = 0; sg < 2; ++sg)
#pragma unroll
                        for (int r = 0; r < 4; ++r) uvn[sg][r] = U[(size_t)((cn + sg) * CH + 16 * kn + 4 * (lane >> 4) + r) * SSMW + g * SP + (lane & 15)]; }
            }
            f32x16 bu[4];
            mfma32_x4_zero(bu[0], bu[1], bu[2], bu[3], af[k], bfr[0], bfr[1], bfr[2], bfr[3]);
#pragma unroll
            for (int r = 0; r < 16; ++r) {
#pragma unroll
                for (int s = 0; s < 2; ++s) {
                    cmul_acc(xr[s], xi[s], ar[s], ai[s], bu[s][r], bu[2 + s][r]);
                    if (READOUT) *(LAS unsigned*)(xl + (hh * 16 + r) * XROWB + (ci + 32 * s) * 4) = cvt_pk_bf16(xr[s], xi[s]);
                }
            }
            if (READOUT) {
                LDS_WAIT();
#pragma unroll
                for (int sg = 0; sg < 2; ++sg) {
                    bf16x8 xa[4];
#pragma unroll
                    for (int kk = 0; kk < 4; ++kk) xa[kk] = *(const LAS bf16x8*)(xl + (sg * 16 + (lane & 15)) * XROWB + (32 * kk + 8 * (lane >> 4)) * 2);
                    LDS_WAIT();
                    const f32x4 y = mfma16_chain4(xa[0], xa[1], xa[2], xa[3], ctf[0], ctf[1], ctf[2], ctf[3]);
#pragma unroll
                    for (int r = 0; r < 4; ++r) { const size_t idx = (size_t)((cA + sg) * CH + 16 * k + 4 * (lane >> 4) + r) * SSMW + g * SP + (lane & 15);
                        const float v = y[r] + dsk * uv[sg][r];
                        const float e = __expf(-1.5957691216057308f * (v + 0.044715f * v * v * v));
                        Y[idx] = (bf16)f2bf(v * __builtin_amdgcn_rcpf(1.0f + e)); }
                }
                LDS_WAIT();
            }
        }
        if (!READOUT) {
#pragma unroll
            for (int s = 0; s < 2; ++s) { XE[cm * 128 + ci + 32 * s] = xr[s]; XE[cm * 128 + 64 + ci + 32 * s] = xi[s];
                cmul_acc(hr[s], hi2[s], l2r[s], l2i[s], xr[s], xi[s]); }
        }
    }
    if (!READOUT) {
#pragma unroll
        for (int s = 0; s < 2; ++s) {
            float er = hr[s], ei = hi2[s];
            if (!hh) { const float nr = lr[s] * er - li[s] * ei, ni = lr[s] * ei + li[s] * er; er = nr; ei = ni; }
            RT[(hh * 32 + run) * 128 + ci + 32 * s] = er; RT[(hh * 32 + run) * 128 + 64 + ci + 32 * s] = ei;
        }
    }
}

__device__ __forceinline__ void attn_item(Frame& F, int h, int qt, const bf16* Q, const bf16* K, const bf16* V, bf16* O) {
    const int lane = F.lane, ci = lane & 31, hh = lane >> 5, t0 = qt * 32;
    bf16x8 qf[8];
    { const bf16* qrow = Q + (size_t)(t0 + ci) * SBW + h * HD + 8 * hh;
#pragma unroll
      for (int ks = 0; ks < 8; ++ks) qf[ks] = *(const bf16x8*)(qrow + 16 * ks); }
    f32x16 o[4];
#pragma unroll
    for (int dt = 0; dt < 4; ++dt)
#pragma unroll
        for (int r = 0; r < 16; ++r) o[dt][r] = 0.f;
    float carry = 0.f;
    for (int kt = qt; kt >= 0; --kt) {
        const int k0 = kt * 32;
        bf16x8 kf[8];
        { const bf16* krow = K + (size_t)(k0 + ci) * SBW + h * HD + 8 * hh;
#pragma unroll
          for (int ks = 0; ks < 8; ++ks) kf[ks] = *(const bf16x8*)(krow + 16 * ks); }
        unsigned vv[2][8][2];
#pragma unroll
        for (int s = 0; s < 2; ++s)
#pragma unroll
            for (int j = 0; j < 8; ++j) { const bf16* vrow = V + (size_t)(k0 + 16 * s + 8 * (j >> 2) + 4 * hh + (j & 3)) * SBW + h * HD + 2 * ci;
                vv[s][j][0] = *(const unsigned*)vrow; vv[s][j][1] = *(const unsigned*)(vrow + 64); }
        const f32x16 c = mfma32_chain8(kf, qf);
        float z[16], sp[16];
        const bool diag = (kt == qt);
#pragma unroll
        for (int r = 0; r < 16; ++r) { const int i = (r & 3) + 8 * (r >> 2) + 4 * hh; z[r] = c[r] * 0.08838834764831845f;
            const bool valid = !diag || (i < ci);
            sp[r] = valid ? (fmaxf(z[r], 0.f) + __logf(1.0f + __expf(-fabsf(z[r])))) : 0.f; }
        float gs[4], pg[4];
#pragma unroll
        for (int g = 0; g < 4; ++g) { gs[g] = (sp[4 * g] + sp[4 * g + 1]) + (sp[4 * g + 2] + sp[4 * g + 3]); pg[g] = __shfl_xor(gs[g], 32); }
        float w[16]; float above = 0.f;
#pragma unroll
        for (int g = 3; g >= 0; --g) {
            float run = carry + above + (hh == 0 ? pg[g] : 0.f);
#pragma unroll
            for (int q = 3; q >= 0; --q) { const int r = 4 * g + q, i = q + 8 * g + 4 * hh; run += sp[r];
                const bool valid = !diag || (i < ci); w[r] = valid ? __expf(z[r] - run) : 0.f; }
            above += gs[g] + pg[g];
        }
        carry += above;
        bf16x8 pb[2];
#pragma unroll
        for (int s = 0; s < 2; ++s) { u32x4 t; t.x = cvt_pk_bf16(w[8 * s], w[8 * s + 1]); t.y = cvt_pk_bf16(w[8 * s + 2], w[8 * s + 3]); t.z = cvt_pk_bf16(w[8 * s + 4], w[8 * s + 5]); t.w = cvt_pk_bf16(w[8 * s + 6], w[8 * s + 7]);
            pb[s] = __builtin_bit_cast(bf16x8, t); }
        bf16x8 va[4][2];
#pragma unroll
        for (int dt = 0; dt < 4; ++dt)
#pragma unroll
            for (int s = 0; s < 2; ++s) { const unsigned sel = (dt & 1) ? 0x07060302u : 0x05040100u; u32x4 t;
                t.x = __builtin_amdgcn_perm(vv[s][1][dt >> 1], vv[s][0][dt >> 1], sel); t.y = __builtin_amdgcn_perm(vv[s][3][dt >> 1], vv[s][2][dt >> 1], sel);
                t.z = __builtin_amdgcn_perm(vv[s][5][dt >> 1], vv[s][4][dt >> 1], sel); t.w = __builtin_amdgcn_perm(vv[s][7][dt >> 1], vv[s][6][dt >> 1], sel);
                va[dt][s] = __builtin_bit_cast(bf16x8, t); }
        mfma32_pv(o, va, pb);
        if (__all(carry > SB_THRESH)) break;
    }
    MFMA_SETTLE4(o[0], o[1], o[2], o[3]);
    bf16* orow = O + (size_t)(t0 + ci) * SBW + h * HD + 8 * hh;
#pragma unroll
    for (int dp = 0; dp < 2; ++dp)
#pragma unroll
        for (int g = 0; g < 4; ++g) { u32x4 t;
            t.x = cvt_pk_bf16(o[2 * dp][4 * g], o[2 * dp + 1][4 * g]); t.y = cvt_pk_bf16(o[2 * dp][4 * g + 1], o[2 * dp + 1][4 * g + 1]);
            t.z = cvt_pk_bf16(o[2 * dp][4 * g + 2], o[2 * dp + 1][4 * g + 2]); t.w = cvt_pk_bf16(o[2 * dp][4 * g + 3], o[2 * dp + 1][4 * g + 3]);
            *(u32x4*)(orow + 64 * dp + 16 * g) = t; }
}

constexpr int NPHASE = 21;

__device__ __forceinline__ Frame mk_frame() {
    Frame F; int t_ = threadIdx.x; asm volatile("" : "+v"(t_)); int b_ = blockIdx.x; asm volatile("" : "+s"(b_));
    const Args __attribute__((address_space(4)))* ka = (const Args __attribute__((address_space(4)))*)__builtin_amdgcn_kernarg_segment_ptr(); asm volatile("" : "+s"(ka));
    extern __shared__ __attribute__((aligned(16))) unsigned char lds[];
    F.ka = ka; unsigned char* w_ = ka->ws;
    F.lds = (LAS unsigned char*)lds; F.ws = w_; F.ctl = (gu32*)(w_ + WS_CTL);
    F.tid = t_; F.lane = t_ & 63; F.wave = __builtin_amdgcn_readfirstlane(t_ >> 6);
    F.G = gridDim.x; F.vcu = (F.G % 8 == 0) ? (b_ % 8) * (F.G / 8) + b_ / 8 : b_; F.bid = b_;
    return F;
}
#define WSP(off) ((bf16*)(F.ws + (off)))

#if MK_ONE_LAUNCH
#define GRID_BAR() xcd_barrier(bar)
#else
#define GRID_BAR() do { } while (0)
#endif
#ifndef PHMASK
#define PHMASK 0x7FF
#endif
#ifndef DUP
#define DUP 0ull
#endif
#define REPS(k) (1 + (int)(((DUP) >> (k)) & 1ull))
#define PROBE_O(k, ptr, scratch) ((REPS(k) == 2 && rep_ == 0) ? (scratch) : (ptr))
#define IN(k) (lo <= (k) && (k) < hi)
#define SEAM(k) do { if (IN(k) && IN((k) + 1)) GRID_BAR(); } while (0)
template <int l> __device__ __forceinline__ void layer_phases(const int lo, const int hi, const XcdBarrier& bar) {
    constexpr int pb = l * 10;
        for (int rep_ = 0; rep_ < REPS(pb + 0); ++rep_) if (((PHMASK >> 0) & 1) && IN(pb + 0)) { if (rep_ > 0) GRID_BAR();
            Frame F = mk_frame(); const int gw = F.vcu * NWAVES + F.wave, NGW = F.G * NWAVES; LAS float* scr = (LAS float*)(F.lds + F.wave * 16384);
            bf16* Win_t = WSP(WS_W + W_IN); bf16* Wglu_t = WSP(WS_W + W_GLU); bf16* Pa_t = WSP(WS_W + W_PA); bf16* Ps_t = WSP(WS_W + W_PS);
            bf16* Wout_t = WSP(WS_W + W_OUT); bf16* Wgu_t = WSP(WS_W + W_GU); bf16* Wdn_t = WSP(WS_W + W_DN_DENSE); bf16* Wdnm_t = WSP(WS_W + W_DN_MOE);
            const float* w_in = F.ka->in[4] + (size_t)l * D * INC; const float* w_glu = F.ka->in[13] + (size_t)l * SSMW * SSMW;
            const float* p_attn = F.ka->in[14] + (size_t)l * SBW * D; const float* p_ssm = F.ka->in[15] + (size_t)l * SSMW * D; const float* w_out = F.ka->in[16] + (size_t)l * D * D;
            constexpr int I_IN = (D / 64) * (INC / 32), I_GLU = (SSMW / 64) * (SSMW / 32), I_PA = (SBW / 64) * (D / 32), I_OUT = (D / 64) * (D / 32);
            constexpr int I_FG = (D / 64) * (FFD / 32), I_FD = (FFD / 64) * (D / 32);
            constexpr int I_MG = (D / 64) * (FFE / 32), I_MD = (FFE / 64) * (D / 32);
            const int n_ffn = (l == 0) ? (2 * I_FG + I_FD) : NE * (2 * I_MG + I_MD);
            const int NITEMS = I_IN + I_GLU + 2 * I_PA + I_OUT + n_ffn;
            auto decode = [&](int it) -> TItem {
                int r = it;
                if (r < I_IN) return titem(w_in, D, INC, Win_t, 0, r, F.ka->in[1] + l * D); r -= I_IN;
                if (r < I_GLU) return titem(w_glu, SSMW, SSMW, Wglu_t, 0, r, nullptr); r -= I_GLU;
                if (r < I_PA) return titem(p_attn, SBW, D, Pa_t, 0, r, nullptr); r -= I_PA;
                if (r < I_PA) return titem(p_ssm, SSMW, D, Ps_t, 0, r, nullptr); r -= I_PA;
                if (r < I_OUT) return titem(w_out, D, D, Wout_t, 0, r, nullptr); r -= I_OUT;
                if (l == 0) {
                    if (r < I_FG) return titem(F.ka->in[17], D, FFD, Wgu_t, 1, r, F.ka->in[2]); r -= I_FG;
                    if (r < I_FG) return titem(F.ka->in[18], D, FFD, Wgu_t, 2, r, F.ka->in[2]); r -= I_FG;
                    return titem(F.ka->in[19], FFD, D, Wdn_t, 0, r, nullptr);
                }
                const int per = 2 * I_MG + I_MD, e = r / per; r -= e * per;
                if (r < I_MG) return titem(F.ka->in[21] + (size_t)e * D * FFE, D, FFE, Wgu_t + (size_t)e * 2048 * D, 1, r, F.ka->in[2] + D); r -= I_MG;
                if (r < I_MG) return titem(F.ka->in[22] + (size_t)e * D * FFE, D, FFE, Wgu_t + (size_t)e * 2048 * D, 2, r, F.ka->in[2] + D); r -= I_MG;
                return titem(F.ka->in[23] + (size_t)e * FFE * D, FFE, D, Wdnm_t + (size_t)e * 2048 * FFE, 0, r, nullptr);
            };
            { float va[32], vb[32]; TItem cur, nxt; int it = gw;
              if (it < NITEMS) { cur = decode(it); titem_load(cur, va, F.lane); }
              for (; it < NITEMS; it += NGW) {
                  const bool has = it + NGW < NITEMS;
                  if (has) { nxt = decode(it + NGW); titem_load(nxt, vb, F.lane); }
                  asm volatile("" ::: "memory");
                  titem_store(cur, va, scr, F.lane);
                  if (has) { cur = nxt;
#pragma unroll
                      for (int i = 0; i < 32; ++i) va[i] = vb[i]; }
              } }
            if (gw < SG) ssm_tables_group(F, gw, F.ka->in[5] + l * SG * SN, F.ka->in[6] + l * SG * SN, F.ka->in[7] + l * SG, F.ka->in[8] + (size_t)l * SG * SN * SP, F.ka->in[9] + (size_t)l * SG * SN * SP,
                                          F.ka->in[10] + (size_t)l * SG * SP * SN, F.ka->in[11] + (size_t)l * SG * SP * SN);
            if constexpr (l == 0) { bf16* XB = WSP(WS_XB); float* RSTD = (float*)(F.ws + WS_RSTD); for (int m = gw; m < S; m += NGW) { const float rs = row32_to_bf16_rstd(F, F.ka->in[0] + (size_t)m * D, XB + (size_t)m * D); if (F.lane == 0) RSTD[m] = rs; } }
            else { const bf16* XB = WSP(WS_XB); float* RSTD = (float*)(F.ws + WS_RSTD); for (int m = gw; m < S; m += NGW) { const float rs = rms_row16_rstd(F, XB + (size_t)m * D); if (F.lane == 0) RSTD[m] = rs; } }
        }
        SEAM(pb + 0);
        for (int rep_ = 0; rep_ < REPS(pb + 1); ++rep_) if (((PHMASK >> 1) & 1) && IN(pb + 1)) { if (rep_ > 0) GRID_BAR();
            Frame F = mk_frame();
            pg8::DenseSched Sd; Sd.so.init(S, INC, F.G, F.bid); Sd.A = WSP(WS_XB); Sd.Bt = WSP(WS_W + W_IN); Sd.K = D;
            pg8::EpiProj E{WSP(WS_Q), WSP(WS_GA), (const float*)(F.ws + WS_RSTD)};
            pg8::gemm_phase<pg8::EpiProj, pg8::DenseSched, true>(F.lds, D, Sd, E);
        }
        SEAM(pb + 1);
        for (int rep_ = 0; rep_ < REPS(pb + 2); ++rep_) if (((PHMASK >> 2) & 1) && IN(pb + 2)) { if (rep_ > 0) GRID_BAR();
            Frame F = mk_frame(); const int gw = F.vcu * NWAVES + F.wave, NGW = F.G * NWAVES;
            bf16* Qb = WSP(WS_Q); bf16* Kb = Qb + (size_t)S * 1024; bf16* Vb = Kb + (size_t)S * 1024; bf16* Ub = Vb + (size_t)S * 1024;
            { const int g = gw >> 5, run = gw & 31; if (gw < SG * 32) ssm_run<false>(F, g, run, Ub, WSP(WS_Y), nullptr, F.lds + F.wave * 16384); }
            bf16* OATT = WSP(WS_OATT);
            for (int it = gw; it < NH * (S / 32); it += NGW) { const int h = it & 7, qt = it >> 3; attn_item(F, h, qt, Qb, Kb, Vb, OATT); }
        }
        SEAM(pb + 2);
        for (int rep_ = 0; rep_ < REPS(pb + 3); ++rep_) if (((PHMASK >> 3) & 1) && IN(pb + 3)) { if (rep_ > 0) GRID_BAR();
            Frame F = mk_frame(); const int gw = F.vcu * NWAVES + F.wave;
            const int g = gw >> 5, run = gw & 31; if (gw < SG * 32) ssm_run<true>(F, g, run, WSP(WS_Q) + (size_t)3 * S * 1024, WSP(WS_Y), F.ka->in[12] + l * SG * SP, F.lds + F.wave * 16384);
        }
        SEAM(pb + 3);
        for (int rep_ = 0; rep_ < REPS(pb + 4); ++rep_) if (((PHMASK >> 4) & 1) && IN(pb + 4)) { if (rep_ > 0) GRID_BAR();
            { Frame F = mk_frame();
              pg8::DenseSched Sd; Sd.so.init(S, D, F.G, F.bid); Sd.A = WSP(WS_OATT); Sd.Bt = WSP(WS_W + W_PA); Sd.K = SBW;
              pg8::EpiGate<0> E{WSP(WS_GA), PROBE_O(pb + 4, WSP(WS_GA), WSP(WS_ACT)), D};
              pg8::gemm_phase<pg8::EpiGate<0>, pg8::DenseSched, true>(F.lds, SBW, Sd, E); }
            { Frame F = mk_frame();
              pg8::DenseSched Sd; Sd.so.init(S, SSMW, F.G, F.bid); Sd.A = WSP(WS_Y); Sd.Bt = WSP(WS_W + W_GLU); Sd.K = SSMW;
              pg8::EpiGate<1> E{WSP(WS_Y), PROBE_O(pb + 4, WSP(WS_OSSM), WSP(WS_ACT) + (size_t)S * D), SSMW};
              pg8::gemm_phase<pg8::EpiGate<1>, pg8::DenseSched, true>(F.lds, SSMW, Sd, E); }
        }
        SEAM(pb + 4);
        for (int rep_ = 0; rep_ < REPS(pb + 5); ++rep_) if (((PHMASK >> 5) & 1) && IN(pb + 5)) { if (rep_ > 0) GRID_BAR();
            Frame F = mk_frame();
            pg8::DenseSched Sd; Sd.so.init(S, D, F.G, F.bid); Sd.A = WSP(WS_OSSM); Sd.Bt = WSP(WS_W + W_PS); Sd.K = SSMW;
            pg8::EpiGate<2> E{WSP(WS_GB), WSP(WS_GA), D, PROBE_O(pb + 5, (bf16*)nullptr, WSP(WS_ACT))};
            pg8::gemm_phase<pg8::EpiGate<2>, pg8::DenseSched, true>(F.lds, SSMW, Sd, E);
        }
        SEAM(pb + 5);
        for (int rep_ = 0; rep_ < REPS(pb + 6); ++rep_) if (((PHMASK >> 6) & 1) && IN(pb + 6)) { if (rep_ > 0) GRID_BAR();
            Frame F = mk_frame();
            pg8::DenseSched Sd; Sd.so.init(S, D, F.G, F.bid); Sd.A = WSP(WS_GA); Sd.Bt = WSP(WS_W + W_OUT); Sd.K = D;
            pg8::EpiResid<false> E{nullptr, WSP(WS_XB), PROBE_O(pb + 6, WSP(WS_XB), WSP(WS_ACT))}; pg8::gemm_phase<pg8::EpiResid<false>, pg8::DenseSched, true>(F.lds, D, Sd, E);
        }
        SEAM(pb + 6);
        for (int rep_ = 0; rep_ < REPS(pb + 7); ++rep_) if (((PHMASK >> 7) & 1) && IN(pb + 7)) { if (rep_ > 0) GRID_BAR();
            Frame F = mk_frame(); const int gw = F.vcu * NWAVES + F.wave, NGW = F.G * NWAVES;
            const float* gnorm = F.ka->in[2] + l * D; const bf16* XB = WSP(WS_XB);
            float* RSTD = (float*)(F.ws + WS_RSTD);
            if (l == 0) { for (int m = gw; m < S; m += NGW) { const float rs = rms_row16_rstd(F, XB + (size_t)m * D); if (F.lane == 0) RSTD[m] = rs; } }
            else {
                const float* wrt = F.ka->in[20]; int* lists = (int*)(F.ws + WS_MOE); float* gatew = (float*)(F.ws + WS_MOE + (size_t)NE * S * 4);
                for (int m = gw; m < S; m += NGW) {
                    const GAS u32x4* xr = (const GAS u32x4*)(XB + (size_t)m * D) + F.lane; const GAS f32x4* gr = (const GAS f32x4*)gnorm + 2 * F.lane;
                    float v[4][8]; float s = 0.f; float lg[NE];
#pragma unroll
                    for (int e = 0; e < NE; ++e) lg[e] = 0.f;
                    const char* wbase = (const char*)wrt + (size_t)F.lane * (8 * NE * 4);
#pragma unroll
                    for (int j = 0; j < 4; ++j) { const u32x4 h = xr[64 * j]; v[j][0] = bflo(h.x); v[j][1] = bfhi(h.x); v[j][2] = bflo(h.y); v[j][3] = bfhi(h.y); v[j][4] = bflo(h.z); v[j][5] = bfhi(h.z); v[j][6] = bflo(h.w); v[j][7] = bfhi(h.w);
                        const f32x4 g0 = gr[128 * j], g1 = gr[128 * j + 1]; const float gq[8] = {g0.x, g0.y, g0.z, g0.w, g1.x, g1.y, g1.z, g1.w};
                        const char* wb = wbase + (size_t)j * (512 * NE * 4); asm volatile("" : "+v"(wb) :: "memory");
                        const GAS f32x4* wp = (const GAS f32x4*)wb;
#pragma unroll
                        for (int q = 0; q < 8; ++q) { s += v[j][q] * v[j][q]; const f32x4 w0 = wp[2 * q], w1 = wp[2 * q + 1]; const float hq = v[j][q] * gq[q];
                            lg[0] += hq * w0.x; lg[1] += hq * w0.y; lg[2] += hq * w0.z; lg[3] += hq * w0.w; lg[4] += hq * w1.x; lg[5] += hq * w1.y; lg[6] += hq * w1.z; lg[7] += hq * w1.w;
                            if ((q & 3) == 3) asm volatile("" : "+v"(lg[0]), "+v"(lg[1]), "+v"(lg[2]), "+v"(lg[3]), "+v"(lg[4]), "+v"(lg[5]), "+v"(lg[6]), "+v"(lg[7]) :: "memory"); } }
                    const float rstd = 1.0f / sqrtf(wave_sum(s) * (1.f / D) + RMS_EPS);
                    if (F.lane == 0) RSTD[m] = rstd;
#pragma unroll
                    for (int e = 0; e < NE; ++e) lg[e] = wave_sum(lg[e]) * rstd;
                    int i1 = 0; float v1 = lg[0];
#pragma unroll
                    for (int e = 1; e < NE; ++e) if (lg[e] > v1) { v1 = lg[e]; i1 = e; }
                    int i2 = (i1 == 0) ? 1 : 0; float v2 = -3.0e38f;
#pragma unroll
                    for (int e = 0; e < NE; ++e) if (e != i1 && lg[e] > v2) { v2 = lg[e]; i2 = e; }
                    if (F.lane == 0) {
                        const float e2 = __expf(v2 - v1); const float g1 = 1.0f / (1.0f + e2), g2 = e2 / (1.0f + e2);
                        const unsigned p1 = __hip_atomic_fetch_add((unsigned*)(F.ctl + CW_MOECNT + 64 * i1), 1u, RLX_AGENT);
                        const unsigned p2 = __hip_atomic_fetch_add((unsigned*)(F.ctl + CW_MOECNT + 64 * i2), 1u, RLX_AGENT);
                        lists[i1 * S + (int)p1] = 2 * m; lists[i2 * S + (int)p2] = 2 * m + 1; gatew[2 * m] = g1; gatew[2 * m + 1] = g2;
                        float* RSTDE = (float*)(F.ws + WS_RSTDE); RSTDE[i1 * S + (int)p1] = rstd; RSTDE[i2 * S + (int)p2] = rstd;
                    }
                }
            }
        }
        SEAM(pb + 7);
        if (l == 0) {
            for (int rep_ = 0; rep_ < REPS(pb + 8); ++rep_) if (((PHMASK >> 8) & 1) && IN(pb + 8)) { if (rep_ > 0) GRID_BAR();
                Frame F = mk_frame();
                pg8::DenseSched Sd; Sd.so.init(S, 2 * FFD, F.G, F.bid); Sd.A = WSP(WS_XB); Sd.Bt = WSP(WS_W + W_GU); Sd.K = D;
                pg8::EpiSwiglu E; E.O = WSP(WS_ACT); E.ld = FFD; E.rstd = (const float*)(F.ws + WS_RSTD); E.moe = false;
#pragma unroll
                for (int e = 0; e < NE; ++e) E.cumv[e] = 0;
                pg8::gemm_phase<pg8::EpiSwiglu, pg8::DenseSched, true>(F.lds, D, Sd, E);
            }
            SEAM(pb + 8);
            for (int rep_ = 0; rep_ < REPS(pb + 9); ++rep_) if (((PHMASK >> 9) & 1) && IN(pb + 9)) { if (rep_ > 0) GRID_BAR();
                Frame F = mk_frame();
                pg8::DenseSched Sd; Sd.so.init(S, D, F.G, F.bid); Sd.A = WSP(WS_ACT); Sd.Bt = WSP(WS_W + W_DN_DENSE); Sd.K = FFD;
                pg8::EpiResid<false> E{nullptr, WSP(WS_XB), PROBE_O(pb + 9, WSP(WS_XB), WSP(WS_GA))};
                pg8::gemm_phase<pg8::EpiResid<false>, pg8::DenseSched, true>(F.lds, FFD, Sd, E);
            }
            SEAM(pb + 9);
        } else {
            for (int rep_ = 0; rep_ < REPS(pb + 8); ++rep_) if (((PHMASK >> 8) & 1) && IN(pb + 8)) { if (rep_ > 0) GRID_BAR();
                Frame F = mk_frame(); const int* lists = (const int*)(F.ws + WS_MOE);
                pg8::MoeSched Sm; Sm.A = WSP(WS_XB); Sm.Bt = WSP(WS_W + W_GU); Sm.K = D; Sm.gather = true; Sm.lists = lists; Sm.init((const unsigned*)(F.ctl + CW_MOECNT), F.G, F.bid);
                pg8::EpiSwiglu E; E.O = WSP(WS_ACT); E.ld = FFE; E.rstd = (const float*)(F.ws + WS_RSTDE); E.moe = true;
#pragma unroll
                for (int e = 0; e < NE; ++e) E.cumv[e] = Sm.cum[e];
                pg8::gemm_phase<pg8::EpiSwiglu, pg8::MoeSched, true>(F.lds, D, Sm, E);
            }
            SEAM(pb + 8);
            for (int rep_ = 0; rep_ < REPS(pb + 9); ++rep_) if (((PHMASK >> 9) & 1) && IN(pb + 9)) { if (rep_ > 0) GRID_BAR();
                Frame F = mk_frame(); const int* lists = (const int*)(F.ws + WS_MOE); const float* gatew = (const float*)(F.ws + WS_MOE + (size_t)NE * S * 4);
                pg8::MoeSched Sm; Sm.A = WSP(WS_ACT); Sm.Bt = WSP(WS_W + W_DN_MOE); Sm.K = FFE; Sm.gather = false; Sm.lists = lists; Sm.init((const unsigned*)(F.ctl + CW_MOECNT), F.G, F.bid);
                pg8::EpiMoeDown E; E.O = WSP(WS_MOEY); E.lists = lists; E.gw = gatew;
#pragma unroll
                for (int e = 0; e < NE; ++e) E.cumv[e] = Sm.cum[e];
                pg8::gemm_phase<pg8::EpiMoeDown, pg8::MoeSched, true>(F.lds, FFE, Sm, E);
            }
            SEAM(pb + 9);
        }
}

__global__ void __launch_bounds__(NTHR, 2) trunk_fwd(Args args) {
    extern __shared__ __attribute__((aligned(16))) unsigned char lds[];
    {
        LAS unsigned char* l0 = (LAS unsigned char*)lds;
        for (int u = threadIdx.x; u < (LDS_BYTES - LDSCTL_OFF) / 4; u += NTHR) ((LAS unsigned*)(l0 + LDSCTL_OFF))[u] = 0u;
        __syncthreads();
    }
#if MK_ONE_LAUNCH
    XcdBarrier bar = xcd_barrier_post((unsigned*)(args.ws + WS_CTL) + CW_BAR, (volatile LAS unsigned*)((LAS unsigned char*)lds + MISC_OFF) + 8);
#else
    XcdBarrier bar; bar.bar = nullptr; bar.x = 0; bar.st = nullptr;
#endif
    const int lo = args.ph_lo, hi = args.ph_hi;
    layer_phases<0>(lo, hi, bar);
    layer_phases<1>(lo, hi, bar);

    if (((PHMASK >> 10) & 1) && IN(20)) {
        Frame F = mk_frame(); const int gw = F.vcu * NWAVES + F.wave, NGW = F.G * NWAVES;
        const float* gnorm = F.ka->in[3]; const bf16* MOEY = WSP(WS_MOEY); const bf16* XB = WSP(WS_XB); float* out = F.ka->out;
        for (int m = gw; m < S; m += NGW) {
            const GAS u32x4* xr = (const GAS u32x4*)(XB + (size_t)m * D) + F.lane; const GAS f32x4* gr = (const GAS f32x4*)gnorm + 2 * F.lane;
            const GAS u32x4* y0 = (const GAS u32x4*)(MOEY + (size_t)(2 * m) * D) + F.lane; const GAS u32x4* y1 = (const GAS u32x4*)(MOEY + (size_t)(2 * m + 1) * D) + F.lane;
            float v[4][8]; float s = 0.f;
#pragma unroll
            for (int j = 0; j < 4; ++j) { const u32x4 h = xr[64 * j], a = y0[64 * j], b = y1[64 * j];
                v[j][0] = bflo(h.x) + (bflo(a.x) + bflo(b.x)); v[j][1] = bfhi(h.x) + (bfhi(a.x) + bfhi(b.x)); v[j][2] = bflo(h.y) + (bflo(a.y) + bflo(b.y)); v[j][3] = bfhi(h.y) + (bfhi(a.y) + bfhi(b.y));
                v[j][4] = bflo(h.z) + (bflo(a.z) + bflo(b.z)); v[j][5] = bfhi(h.z) + (bfhi(a.z) + bfhi(b.z)); v[j][6] = bflo(h.w) + (bflo(a.w) + bflo(b.w)); v[j][7] = bfhi(h.w) + (bfhi(a.w) + bfhi(b.w));
#pragma unroll
                for (int q = 0; q < 8; ++q) s += v[j][q] * v[j][q]; }
            const float rstd = 1.0f / sqrtf(wave_sum(s) * (1.f / D) + RMS_EPS);
            GAS f32x4* o = (GAS f32x4*)(out + (size_t)m * D) + 2 * F.lane;
#pragma unroll
            for (int j = 0; j < 4; ++j) { const f32x4 g0 = gr[128 * j], g1 = gr[128 * j + 1];
                o[128 * j] = (f32x4){v[j][0] * rstd * g0.x, v[j][1] * rstd * g0.y, v[j][2] * rstd * g0.z, v[j][3] * rstd * g0.w};
                o[128 * j + 1] = (f32x4){v[j][4] * rstd * g1.x, v[j][5] * rstd * g1.y, v[j][6] * rstd * g1.z, v[j][7] * rstd * g1.w}; }
        }
    }
#undef IN
#undef SEAM
}


extern "C" void kernel_launch(void* const* d_in, const int* in_sizes, int n_in, void* d_out, int out_size, void* d_ws, size_t ws_size, hipStream_t stream) {
    static int grid = 0;
    if (grid == 0) {
        if (n_in != 24 || out_size != S * D || ws_size < WS_END) { fprintf(stderr, "kernel_launch: unexpected problem (n_in %d, out %d, ws %zu); nothing launched\n", n_in, out_size, ws_size); grid = -1; return; }
        int dev = 0, cus = 0, per_cu = 0;
        if (hipGetDevice(&dev) != hipSuccess || hipDeviceGetAttribute(&cus, hipDeviceAttributeMultiprocessorCount, dev) != hipSuccess) { grid = -1; return; }
        if (hipFuncSetAttribute((const void*)trunk_fwd, hipFuncAttributeMaxDynamicSharedMemorySize, LDS_BYTES) != hipSuccess) { fprintf(stderr, "kernel_launch: hipFuncSetAttribute failed\n"); grid = -1; return; }
        if (hipOccupancyMaxActiveBlocksPerMultiprocessor(&per_cu, (const void*)trunk_fwd, NTHR, LDS_BYTES) != hipSuccess || per_cu < 1)
            fprintf(stderr, "kernel_launch: note: occupancy query reports %d workgroups per CU\n", per_cu);
        (void)hipGetLastError();
        grid = cus;
    }
    if (grid < 0) return;
    if (hipMemsetAsync((char*)d_ws + WS_CTL, 0, CTL_ZERO_BYTES, stream) != hipSuccess) return;
    Args a{};
    for (int i = 0; i < 24; ++i) a.in[i] = (const float*)d_in[i];
    a.out = (float*)d_out; a.ws = (unsigned char*)d_ws;
#if MK_ONE_LAUNCH
    a.ph_lo = 0; a.ph_hi = NPHASE;
    hipLaunchKernelGGL(trunk_fwd, dim3(grid), dim3(NTHR), LDS_BYTES, stream, a);
#else
    for (int p = 0; p < NPHASE; ++p) { a.ph_lo = p; a.ph_hi = p + 1; hipLaunchKernelGGL(trunk_fwd, dim3(grid), dim3(NTHR), LDS_BYTES, stream, a); }
#endif
}
```

```cpp
#include <hip/hip_runtime.h>
#include <cstdio>
#include <cstdint>

#ifndef MK_ONE_LAUNCH
#define MK_ONE_LAUNCH 1
#endif

#define GAS __attribute__((address_space(1)))
#define LAS __attribute__((address_space(3)))
typedef unsigned short bf16;
typedef short bf16x8 __attribute__((ext_vector_type(8)));
typedef float f32x4 __attribute__((ext_vector_type(4)));
typedef float f32x16 __attribute__((ext_vector_type(16)));
typedef unsigned u32x4 __attribute__((ext_vector_type(4)));
typedef unsigned u32x2 __attribute__((ext_vector_type(2)));
typedef GAS unsigned gu32;

constexpr int S = 16384, D = 2048, INC = 8192, SBW = 1024, SSMW = 1024, NH = 8, HD = 128;
constexpr int SG = 64, SN = 64, SP = 16;
constexpr int FFD = 4096, NE = 8, FFE = 1024;
constexpr int CH = 64, NCH = S / CH;
constexpr float RMS_EPS = 1e-6f;
constexpr float SB_THRESH = 30.0f;

constexpr size_t MiB = 1u << 20;
constexpr size_t WS_CTL = 0, CTL_ZERO_BYTES = 1 * MiB;
constexpr size_t WS_SSMT = 1 * MiB;
constexpr size_t WS_MOE = 2 * MiB;
constexpr size_t WS_RSTDE = 3 * MiB + 256 * 1024;
constexpr size_t WS_RSTD = 3 * MiB;
constexpr size_t WS_XE = 4 * MiB;
constexpr size_t WS_W = 12 * MiB;
constexpr size_t W_IN = 0, W_GLU = 32 * MiB, W_PA = 34 * MiB, W_PS = 38 * MiB, W_OUT = 42 * MiB, W_FFN = 50 * MiB;
constexpr size_t W_GU = W_FFN, W_DN_DENSE = W_FFN + 32 * MiB, W_DN_MOE = W_FFN + 64 * MiB;
constexpr size_t WS_Y = 158 * MiB, WS_OSSM = 190 * MiB;
constexpr size_t WS_XB = 510 * MiB;
constexpr size_t WS_Q = 222 * MiB;
constexpr size_t WS_GA = 350 * MiB, WS_GB = 414 * MiB;
constexpr size_t WS_ACT = 222 * MiB;
constexpr size_t WS_MOEY = 350 * MiB;
constexpr size_t WS_OATT = 478 * MiB;
constexpr size_t WS_END = 576 * MiB;

constexpr int CW_BAR = 4096;
constexpr int CW_MOECNT = 16384;

constexpr size_t ST_ABAR = 0;
constexpr size_t ST_ABARL = 32768;
constexpr size_t ST_BBF = 65536;
constexpr size_t ST_CTF = 65536 + 262144;

constexpr int NWAVES = 8, NTHR = 512;
constexpr int RING_BYTES = 131072, LDSCTL_OFF = RING_BYTES, MISC_OFF = LDSCTL_OFF + 320, LDS_BYTES = 147456;

#define RLX_AGENT __ATOMIC_RELAXED, __HIP_MEMORY_SCOPE_AGENT
#define LDS_WAIT() asm volatile("s_waitcnt lgkmcnt(0)" ::: "memory")
#define VM_WAIT() asm volatile("s_waitcnt vmcnt(0)" ::: "memory")

__device__ __forceinline__ unsigned f2bf(float f) { unsigned u = __builtin_bit_cast(unsigned, f); return (u + 0x7fffu + ((u >> 16) & 1u)) >> 16; }

typedef float f32x2_t __attribute__((ext_vector_type(2)));
typedef __bf16 bf16x2_t __attribute__((ext_vector_type(2)));
__device__ __forceinline__ unsigned cvt_pk_bf16(float lo, float hi) { const f32x2_t v = {lo, hi}; const bf16x2_t b = __builtin_convertvector(v, bf16x2_t); return __builtin_bit_cast(unsigned, b); }
__device__ __forceinline__ unsigned pk2(float lo, float hi) { return cvt_pk_bf16(lo, hi); }
#define NOP64 "s_nop 15\n\ts_nop 15\n\ts_nop 15\n\ts_nop 15\n\t"
#define MFMA_SETTLE4(a, b, c, d) asm volatile(NOP64 NOP64 : "+v"(a), "+v"(b), "+v"(c), "+v"(d))
#define MFMA_PRE(a) asm volatile("s_nop 15" : "+v"(a))
#define MFMA_SETTLE1(a) asm volatile(NOP64 NOP64 : "+v"(a))
__device__ __forceinline__ void mfma32_x4_zero(f32x16& d0, f32x16& d1, f32x16& d2, f32x16& d3, bf16x8 a, bf16x8 b0, bf16x8 b1, bf16x8 b2, bf16x8 b3) {
    asm volatile("s_nop 7\n\tv_mfma_f32_32x32x16_bf16 %0, %4, %5, 0\n\tv_mfma_f32_32x32x16_bf16 %1, %4, %6, 0\n\tv_mfma_f32_32x32x16_bf16 %2, %4, %7, 0\n\tv_mfma_f32_32x32x16_bf16 %3, %4, %8, 0\n\t" NOP64 NOP64
                 : "=&v"(d0), "=&v"(d1), "=&v"(d2), "=&v"(d3) : "v"(a), "v"(b0), "v"(b1), "v"(b2), "v"(b3));
}
__device__ __forceinline__ f32x4 mfma16_chain4(bf16x8 a0, bf16x8 a1, bf16x8 a2, bf16x8 a3, bf16x8 b0, bf16x8 b1, bf16x8 b2, bf16x8 b3) {
    f32x4 y;
    asm volatile("s_nop 7\n\tv_mfma_f32_16x16x32_bf16 %0, %1, %5, 0\n\tv_mfma_f32_16x16x32_bf16 %0, %2, %6, %0\n\tv_mfma_f32_16x16x32_bf16 %0, %3, %7, %0\n\tv_mfma_f32_16x16x32_bf16 %0, %4, %8, %0\n\t" NOP64 NOP64
                 : "=&v"(y) : "v"(a0), "v"(a1), "v"(a2), "v"(a3), "v"(b0), "v"(b1), "v"(b2), "v"(b3));
    return y;
}
__device__ __forceinline__ f32x16 mfma32_chain8(const bf16x8 (&a)[8], const bf16x8 (&b)[8]) {
    f32x16 c;
    asm volatile("s_nop 7\n\tv_mfma_f32_32x32x16_bf16 %0, %1, %9, 0\n\tv_mfma_f32_32x32x16_bf16 %0, %2, %10, %0\n\tv_mfma_f32_32x32x16_bf16 %0, %3, %11, %0\n\tv_mfma_f32_32x32x16_bf16 %0, %4, %12, %0\n\t"
                 "v_mfma_f32_32x32x16_bf16 %0, %5, %13, %0\n\tv_mfma_f32_32x32x16_bf16 %0, %6, %14, %0\n\tv_mfma_f32_32x32x16_bf16 %0, %7, %15, %0\n\tv_mfma_f32_32x32x16_bf16 %0, %8, %16, %0\n\t" NOP64 NOP64
                 : "=&v"(c) : "v"(a[0]), "v"(a[1]), "v"(a[2]), "v"(a[3]), "v"(a[4]), "v"(a[5]), "v"(a[6]), "v"(a[7]), "v"(b[0]), "v"(b[1]), "v"(b[2]), "v"(b[3]), "v"(b[4]), "v"(b[5]), "v"(b[6]), "v"(b[7]));
    return c;
}
__device__ __forceinline__ void mfma32_pv(f32x16 (&o)[4], const bf16x8 (&va)[4][2], const bf16x8 (&pb)[2]) {
    asm volatile("s_nop 7\n\tv_mfma_f32_32x32x16_bf16 %0, %4, %12, %0\n\tv_mfma_f32_32x32x16_bf16 %1, %6, %12, %1\n\tv_mfma_f32_32x32x16_bf16 %2, %8, %12, %2\n\tv_mfma_f32_32x32x16_bf16 %3, %10, %12, %3\n\t"
                 "v_mfma_f32_32x32x16_bf16 %0, %5, %13, %0\n\tv_mfma_f32_32x32x16_bf16 %1, %7, %13, %1\n\tv_mfma_f32_32x32x16_bf16 %2, %9, %13, %2\n\tv_mfma_f32_32x32x16_bf16 %3, %11, %13, %3\n\ts_nop 7"
                 : "+v"(o[0]), "+v"(o[1]), "+v"(o[2]), "+v"(o[3]) : "v"(va[0][0]), "v"(va[0][1]), "v"(va[1][0]), "v"(va[1][1]), "v"(va[2][0]), "v"(va[2][1]), "v"(va[3][0]), "v"(va[3][1]), "v"(pb[0]), "v"(pb[1]));
}
__device__ __forceinline__ float bflo(unsigned w) { return __builtin_bit_cast(float, w << 16); }
__device__ __forceinline__ float bfhi(unsigned w) { return __builtin_bit_cast(float, w & 0xffff0000u); }
__device__ __forceinline__ float bf2f(bf16 b) { return __builtin_bit_cast(float, ((unsigned)b) << 16); }
__device__ __forceinline__ float sigmoidf_(float x) { return __builtin_amdgcn_rcpf(1.0f + __expf(-x)); }
__device__ __forceinline__ float wave_sum(float v) {
#pragma unroll
    for (int o = 1; o < 64; o <<= 1) v += __shfl_xor(v, o);
    return v;
}

#define XB_TMO      128
#define XB_XCNT(j)  (256  + 64 * (j))
#define XB_XSUB(j)  (1280 + 64 * (j))
#define XB_XGEN(j)  (2304 + 64 * (j))
#define XB_TOP      3328
#define XB_TOPGEN   3392
#define XCD_BAR_WORDS 3456
#define XB_SPIN_CAP (1u << 18)
__device__ __forceinline__ unsigned xb_ld(unsigned* p)              { return __hip_atomic_load(p, __ATOMIC_RELAXED, __HIP_MEMORY_SCOPE_AGENT); }
__device__ __forceinline__ unsigned xb_add(unsigned* p, unsigned v) { return __hip_atomic_fetch_add(p, v, __ATOMIC_RELAXED, __HIP_MEMORY_SCOPE_AGENT); }
__device__ __forceinline__ unsigned xb_xcc_id() { return (unsigned)__builtin_amdgcn_s_getreg((3 << 11) | 20) & 0xFu; }
#define XB_SPIN(cond, bar) do { unsigned _sp = 0; while (cond) { __builtin_amdgcn_s_sleep(1); \
    if ((++_sp & 255u) == 0u) { if (xb_ld(&(bar)[XB_TMO])) break; if (_sp > XB_SPIN_CAP) { atomicAdd(&(bar)[XB_TMO], 1u); break; } } } } while (0)
struct XcdBarrier { unsigned* bar; unsigned x; volatile LAS unsigned* st; };
__device__ __forceinline__ XcdBarrier xcd_barrier_post(unsigned* bar, volatile LAS unsigned* st) {
    XcdBarrier b; b.bar = bar; b.x = xb_xcc_id(); b.st = st;
    if (threadIdx.x == 0) (void)xb_add(&bar[XB_XCNT(b.x)], 1u);
    return b;
}
__device__ __forceinline__ void xcd_barrier_complete(unsigned* bar, unsigned x, unsigned& nloc, unsigned& nx) {
    const unsigned G = gridDim.x * gridDim.y * gridDim.z;
    unsigned sum, cnt, mine, sp = 0u;
    for (;;) {
        sum = 0u; cnt = 0u; mine = 0u;
#pragma unroll
        for (unsigned j = 0; j < 16; ++j) { const unsigned c = xb_ld(&bar[XB_XCNT(j)]); sum += c; cnt += (c > 0u) ? 1u : 0u; mine = (j == x) ? c : mine; }
        if (sum == G) break;
        __builtin_amdgcn_s_sleep(1);
        if ((++sp & 255u) == 0u) { if (xb_ld(&bar[XB_TMO])) break; if (sp > XB_SPIN_CAP) { atomicAdd(&bar[XB_TMO], 1u); break; } }
    }
    nloc = mine > 0u ? mine : 1u; nx = cnt > 0u ? cnt : 1u;
}
__device__ __forceinline__ void xcd_barrier(const XcdBarrier& b) {
    asm volatile("s_waitcnt vmcnt(0)" ::: "memory");
    __syncthreads();
    if (threadIdx.x == 0) {
        unsigned* bar = b.bar;
        __builtin_amdgcn_s_waitcnt(0);
        unsigned nloc = b.st[0], nx = b.st[1];
        if (nloc == 0u) { xcd_barrier_complete(bar, b.x, nloc, nx); b.st[0] = nloc; b.st[1] = nx; }
        const unsigned old = xb_add(&bar[XB_XSUB(b.x)], 1u);
        const unsigned gen = old / nloc;
        if (old + 1u == (gen + 1u) * nloc) {
            __builtin_amdgcn_fence(__ATOMIC_RELEASE, "");
            asm volatile("s_waitcnt vmcnt(0)" ::: "memory");
            const unsigned og = xb_add(&bar[XB_TOP], 1u);
            const unsigned tg = og / nx;
            if (og + 1u == (tg + 1u) * nx) xb_add(&bar[XB_TOPGEN], 1u);
            else XB_SPIN(xb_ld(&bar[XB_TOPGEN]) == tg, bar);
            __builtin_amdgcn_fence(__ATOMIC_ACQUIRE, "");
            xb_add(&bar[XB_XGEN(b.x)], 1u);
            asm volatile("s_waitcnt vmcnt(0)" ::: "memory");
        } else {
            XB_SPIN(xb_ld(&bar[XB_XGEN(b.x)]) == gen, bar);
            __builtin_amdgcn_fence(__ATOMIC_ACQUIRE, "");
            asm volatile("s_waitcnt vmcnt(0)" ::: "memory");
        }
    }
    __syncthreads();
}

namespace pg8 {
constexpr int BM = 256, BK = 64, HALF = 128, HTB = HALF * BK * 2, STAGE_BYTES = 8 * HTB, NXCD = 8, WGM = 8;
__host__ __device__ __forceinline__ int lds_byte(int r, int c) { const int st = (r >> 4) * 2 + (c >> 5), rr = r & 15, cc = c & 31, ob = rr * 64 + cc * 2; return st * 1024 + (ob ^ (((ob >> 9) & 1) << 5)); }
__host__ __device__ __forceinline__ void stage_rc(int b, int& R, int& C) { const int st = b / 1024, sb = b % 1024, swz = sb ^ (((sb >> 9) & 1) << 5); R = (st >> 1) * 16 + swz / 64; C = (st & 1) * 32 + (swz % 64) / 2; }
__host__ __device__ __forceinline__ int perm32(int rho) { const int n = rho >> 4, i = rho & 15; return 8 * (i >> 2) + 4 * n + (i & 3); }

struct Unit { int pm, pn, e, nv; };

struct StaticOrder {
    int nM, nN, nwg, G, c;
    __device__ void init(int M, int N, int G_, int c_) { nM = M / BM; nN = N / BM; nwg = nM * nN; G = G_; c = c_; }
    __device__ bool next(int i, Unit& u) const {
        const long L = (long)i * G + c; if (L >= nwg) return false;
        int wgid = (int)L; { const int q = nwg / NXCD, r = nwg % NXCD, xcd = wgid % NXCD, off = wgid / NXCD; wgid = (xcd < r ? xcd * (q + 1) : r * (q + 1) + (xcd - r) * q) + off; }
        const int nig = WGM * nN, gid = wgid / nig, fm = gid * WGM, gsz = (nM - fm) < WGM ? (nM - fm) : WGM;
        u.pm = fm + ((wgid % nig) % gsz); u.pn = (wgid % nig) / gsz; u.e = 0; u.nv = 256; return true;
    }
};
struct DenseSched {
    StaticOrder so; const bf16* A; const bf16* Bt; int K;
    __device__ __forceinline__ bool next(int i, Unit& u) const { return so.next(i, u); }
    __device__ __forceinline__ const char* abase(const Unit& u) const { return (const char*)A + (size_t)u.pm * 256 * K * 2; }
    __device__ __forceinline__ const char* bbase(const Unit& u) const { return (const char*)Bt + (size_t)u.pn * 256 * K * 2; }
    __device__ __forceinline__ void aoff(const Unit&, const int (&R)[2], const int (&C)[2], unsigned (&v)[2][2]) const {
#pragma unroll
        for (int h = 0; h < 2; ++h)
#pragma unroll
            for (int i = 0; i < 2; ++i) v[h][i] = (unsigned)((h * HALF + R[i]) * K + C[i]) * 2u;
    }
};
struct MoeSched {
    const bf16* A; const bf16* Bt; int K; int G, c; bool gather;
    const int* lists; int cnt[NE]; int cum[NE + 1];
    __device__ void init(const unsigned* cntw, int G_, int c_) {
        G = G_; c = c_; int a = 0;
#pragma unroll
        for (int e = 0; e < NE; ++e) { cnt[e] = __builtin_amdgcn_readfirstlane((int)__hip_atomic_load(cntw + 64 * e, RLX_AGENT)); cum[e] = a; a += (cnt[e] + 255) >> 8; }
        cum[NE] = a;
    }
    __device__ __forceinline__ bool next(int i, Unit& u) const {
        const int L = i * G + c; if (L >= cum[NE] * 8) return false;
        const int gp = L >> 3; u.pn = L & 7; u.pm = gp; int e = 0;
#pragma unroll
        for (int k = 1; k < NE; ++k) e += (gp >= cum[k]) ? 1 : 0;
        u.e = e; int c_e = 0, b_e = 0;
#pragma unroll
        for (int k = 0; k < NE; ++k) { c_e = (k == e) ? cnt[k] : c_e; b_e = (k == e) ? cum[k] : b_e; }
        const int p = gp - b_e; int nv = c_e - 256 * p; u.nv = nv > 256 ? 256 : nv; return true;
    }
    __device__ __forceinline__ const char* abase(const Unit& u) const { return gather ? (const char*)A : (const char*)A + (size_t)u.pm * 256 * K * 2; }
    __device__ __forceinline__ const char* bbase(const Unit& u) const { return (const char*)Bt + ((size_t)u.e * 2048 + (size_t)u.pn * 256) * K * 2; }
    __device__ __forceinline__ void aoff(const Unit& u, const int (&R)[2], const int (&C)[2], unsigned (&v)[2][2]) const {
        int b_e = 0;
#pragma unroll
        for (int k = 0; k < NE; ++k) b_e = (k == u.e) ? cum[k] : b_e;
        const int p = u.pm - b_e;
#pragma unroll
        for (int h = 0; h < 2; ++h)
#pragma unroll
            for (int i = 0; i < 2; ++i) {
                const int r = h * HALF + R[i];
                if (gather) { int tok = 0; if (r < u.nv) tok = lists[u.e * S + 256 * p + r] >> 1; v[h][i] = (unsigned)(tok * K + C[i]) * 2u; }
                else v[h][i] = (unsigned)(r * K + C[i]) * 2u;
            }
    }
};

template <class Epi, class Sched, bool ALIGN_EPI>
__device__ __forceinline__ void gemm_phase(LAS unsigned char* lds, const int K, const Sched& S_, const Epi& E) {
    int tid_ = threadIdx.x; asm volatile("" : "+v"(tid_));
    const int tid = tid_, wid = __builtin_amdgcn_readfirstlane(tid >> 6), lane = tid & 63, wr = wid >> 2, wc = wid & 3, fr = lane & 15, fq = lane >> 4;
    const int nt = K / BK;
    int Rr[2], Cc[2]; unsigned voffB[2];
#pragma unroll
    for (int i = 0; i < 2; ++i) { int R, C; stage_rc(tid * 16 + i * 8192, R, C); Rr[i] = R; Cc[i] = C; const int Rb = Epi::PERM ? ((R & ~31) + perm32(R & 31)) : R; voffB[i] = (unsigned)(Rb * K + C) * 2u; }
    const size_t kstep = (size_t)(BK * 2);
    const size_t hstep = (size_t)HALF * K * 2;
    const unsigned ldsw = (unsigned)wid * 1024u;
    const int aoff = lds_byte(wr * 64 + fr, fq * 8), boff = lds_byte(wc * 32 + fr, fq * 8);
#define PG8_SA(b, h) (((b) * 2 + (h)) * HTB)
#define PG8_SB(b, h) ((4 + (b) * 2 + (h)) * HTB)
#define PG8_STAGE(bufoff, gbase, voff) do { _Pragma("unroll") for (int _i = 0; _i < 2; ++_i) \
        __builtin_amdgcn_global_load_lds((const unsigned*)((const char*)(gbase) + (voff)[_i]), (LAS unsigned*)(lds + (bufoff) + ldsw + _i * 8192), 16, 0, 0); } while (0)
#define PG8_LDA(dst, b, h) do { _Pragma("unroll") for (int m = 0; m < 4; ++m) _Pragma("unroll") for (int k = 0; k < 2; ++k) dst[m][k] = *(const LAS bf16x8*)(lds + PG8_SA(b, h) + aoff + m * 2048 + k * 1024); } while (0)
#define PG8_LDB(dst, b, h) do { _Pragma("unroll") for (int n = 0; n < 2; ++n) _Pragma("unroll") for (int k = 0; k < 2; ++k) dst[n][k] = *(const LAS bf16x8*)(lds + PG8_SB(b, h) + boff + n * 2048 + k * 1024); } while (0)
#define PG8_MMA(ai, bj, At, Bt) do { __builtin_amdgcn_s_setprio(1); _Pragma("unroll") for (int m = 0; m < 4; ++m) _Pragma("unroll") for (int n = 0; n < 2; ++n) _Pragma("unroll") for (int k = 0; k < 2; ++k) \
        acc[ai][bj][m][n] = __builtin_amdgcn_mfma_f32_16x16x32_bf16(Bt[n][k], At[m][k], acc[ai][bj][m][n], 0, 0, 0); __builtin_amdgcn_s_setprio(0); } while (0)
#define PG8_WAIT_V(n) asm volatile("s_waitcnt vmcnt(" #n ")" ::: "memory")
#define PG8_WAIT_L(n) asm volatile("s_waitcnt lgkmcnt(" #n ")" ::: "memory")
#define PG8_BAR __builtin_amdgcn_s_barrier()
#define PG8_SCHED __builtin_amdgcn_sched_barrier(0)
    Unit cur, nxt; int ui = 0;
    if (!S_.next(0, cur)) return;
    f32x4 acc[2][2][4][2];
#pragma unroll
    for (int a = 0; a < 2; ++a)
#pragma unroll
        for (int b = 0; b < 2; ++b)
#pragma unroll
            for (int m = 0; m < 4; ++m)
#pragma unroll
                for (int n = 0; n < 2; ++n) acc[a][b][m][n] = (f32x4){0.f, 0.f, 0.f, 0.f};
    bf16x8 At[4][2], B0[2][2], B1[2][2];
    const char* cA = S_.abase(cur); const char* cB = S_.bbase(cur);
    unsigned vA[2][2], nvA[2][2]; S_.aoff(cur, Rr, Cc, vA);
    typename Epi::Pre pre = E.prefetch(cur, wr, fr);
    PG8_STAGE(PG8_SB(0, 0), cB, voffB); PG8_STAGE(PG8_SB(0, 1), cB + hstep, voffB); PG8_STAGE(PG8_SA(0, 0), cA, vA[0]); PG8_STAGE(PG8_SA(0, 1), cA, vA[1]);
    if (wr == 1) PG8_BAR;
    PG8_WAIT_V(2); PG8_BAR;
    PG8_STAGE(PG8_SB(1, 0), cB + kstep, voffB); PG8_STAGE(PG8_SA(1, 0), cA + kstep, vA[0]); PG8_STAGE(PG8_SB(1, 1), cB + hstep + kstep, voffB);
    PG8_WAIT_V(6); PG8_BAR;
    for (;;) {
        const bool has_next = S_.next(ui + 1, nxt);
        const char* nA = has_next ? S_.abase(nxt) : cA; const char* nB = has_next ? S_.bbase(nxt) : cB;
        if (has_next) S_.aoff(nxt, Rr, Cc, nvA); else {
#pragma unroll
            for (int h = 0; h < 2; ++h)
#pragma unroll
                for (int i = 0; i < 2; ++i) nvA[h][i] = vA[h][i]; }
        for (int t = 0; t < nt; t += 2) {
            const bool last = (t == nt - 2);
            const char* a1 = cA + (size_t)(t + 1) * kstep;
            const char* a2 = last ? nA : cA + (size_t)(t + 2) * kstep; const char* b2 = last ? nB : cB + (size_t)(t + 2) * kstep;
            const char* a3 = a2 + kstep; const char* b3 = b2 + kstep;
            unsigned wA[2][2];
#pragma unroll
            for (int h = 0; h < 2; ++h)
#pragma unroll
                for (int i = 0; i < 2; ++i) wA[h][i] = last ? nvA[h][i] : vA[h][i];
            PG8_LDB(B0, 0, 0); PG8_LDB(B1, 0, 1); PG8_SCHED; PG8_LDA(At, 0, 0); PG8_STAGE(PG8_SA(1, 1), a1, vA[1]);
            PG8_WAIT_V(8); PG8_WAIT_L(0); PG8_BAR; PG8_MMA(0, 0, At, B0); PG8_MMA(0, 1, At, B1); PG8_BAR; PG8_SCHED;
            PG8_LDA(At, 0, 1); PG8_STAGE(PG8_SB(0, 0), b2, voffB); PG8_STAGE(PG8_SB(0, 1), b2 + hstep, voffB); PG8_STAGE(PG8_SA(0, 0), a2, wA[0]);
            PG8_WAIT_V(8); PG8_WAIT_L(0); PG8_BAR; PG8_MMA(1, 0, At, B0); PG8_MMA(1, 1, At, B1); PG8_BAR; PG8_SCHED;
            PG8_LDB(B0, 1, 0); PG8_LDB(B1, 1, 1); PG8_SCHED; PG8_LDA(At, 1, 0); PG8_STAGE(PG8_SA(0, 1), a2, wA[1]);
            PG8_WAIT_V(8); PG8_WAIT_L(0); PG8_BAR; PG8_MMA(0, 0, At, B0); PG8_MMA(0, 1, At, B1); PG8_BAR; PG8_SCHED;
            PG8_LDA(At, 1, 1); PG8_STAGE(PG8_SB(1, 0), b3, voffB); PG8_STAGE(PG8_SB(1, 1), b3 + hstep, voffB); PG8_STAGE(PG8_SA(1, 0), a3, wA[0]);
            PG8_WAIT_V(8); PG8_WAIT_L(0); PG8_BAR; PG8_MMA(1, 0, At, B0); PG8_MMA(1, 1, At, B1); PG8_BAR; PG8_SCHED;
        }
        if constexpr (ALIGN_EPI) { if (wr == 0) PG8_BAR; }
        asm volatile(NOP64 NOP64 : "+v"(acc[0][0][0][0]), "+v"(acc[0][0][0][1]), "+v"(acc[0][0][1][0]), "+v"(acc[0][0][1][1]), "+v"(acc[0][0][2][0]), "+v"(acc[0][0][2][1]), "+v"(acc[0][0][3][0]), "+v"(acc[0][0][3][1]),
                                   "+v"(acc[0][1][0][0]), "+v"(acc[0][1][0][1]), "+v"(acc[0][1][1][0]), "+v"(acc[0][1][1][1]), "+v"(acc[0][1][2][0]), "+v"(acc[0][1][2][1]), "+v"(acc[0][1][3][0]), "+v"(acc[0][1][3][1]) :: "memory");
        asm volatile("" : "+v"(acc[1][0][0][0]), "+v"(acc[1][0][0][1]), "+v"(acc[1][0][1][0]), "+v"(acc[1][0][1][1]), "+v"(acc[1][0][2][0]), "+v"(acc[1][0][2][1]), "+v"(acc[1][0][3][0]), "+v"(acc[1][0][3][1]),
                          "+v"(acc[1][1][0][0]), "+v"(acc[1][1][0][1]), "+v"(acc[1][1][1][0]), "+v"(acc[1][1][1][1]), "+v"(acc[1][1][2][0]), "+v"(acc[1][1][2][1]), "+v"(acc[1][1][3][0]), "+v"(acc[1][1][3][1]) :: "memory");
        E(acc, cur, wr, wc, fr, fq, pre);
        if (!has_next) break;
#pragma unroll
        for (int a = 0; a < 2; ++a)
#pragma unroll
            for (int b = 0; b < 2; ++b)
#pragma unroll
                for (int m = 0; m < 4; ++m)
#pragma unroll
                    for (int n = 0; n < 2; ++n) acc[a][b][m][n] = (f32x4){0.f, 0.f, 0.f, 0.f};
        cur = nxt; cA = nA; cB = nB; ++ui;
        pre = E.prefetch(cur, wr, fr);
#pragma unroll
        for (int h = 0; h < 2; ++h)
#pragma unroll
            for (int i = 0; i < 2; ++i) vA[h][i] = nvA[h][i];
        if constexpr (ALIGN_EPI) { if (wr == 1) PG8_BAR; }
    }
    PG8_WAIT_V(0);
    if constexpr (!ALIGN_EPI) { if (wr == 0) PG8_BAR; }
    PG8_BAR;
#undef PG8_SA
#undef PG8_SB
#undef PG8_STAGE
#undef PG8_LDA
#undef PG8_LDB
#undef PG8_MMA
#undef PG8_WAIT_V
#undef PG8_WAIT_L
#undef PG8_BAR
#undef PG8_SCHED
}

typedef const f32x4 (&AccRef)[2][2][4][2];
__device__ __forceinline__ unsigned bperm(int a, unsigned v) { return (unsigned)__builtin_amdgcn_ds_bpermute(a, (int)v); }
__device__ __forceinline__ u32x4 bperm4(int a, u32x4 w) { u32x4 r;
    asm volatile("s_nop 1" : "+v"(w.x), "+v"(w.y), "+v"(w.z), "+v"(w.w));
    r.x = bperm(a, w.x); r.y = bperm(a, w.y); r.z = bperm(a, w.z); r.w = bperm(a, w.w);
    asm volatile("s_nop 3" : "+v"(w.x), "+v"(w.y), "+v"(w.z), "+v"(w.w));
    return r; }
__device__ __forceinline__ f32x4 bperm4f(int a, f32x4 v) { return __builtin_bit_cast(f32x4, bperm4(a, __builtin_bit_cast(u32x4, v))); }
#define EPI_LANES const int ml_ = fq * 16 + fr, rl = ml_ >> 2, cg = ml_ & 3, ps = (((ml_ & 3) << 4) + (ml_ >> 2)) << 2

struct EpiProj {
    static constexpr bool PERM = true;
    bf16* Q; bf16* GA; const float* rstd;
    struct Pre { float rs[2][4]; };
    __device__ __forceinline__ Pre prefetch(const Unit& u, int wr, int fr) const { Pre p;
#pragma unroll
        for (int ai = 0; ai < 2; ++ai)
#pragma unroll
            for (int m = 0; m < 4; ++m) p.rs[ai][m] = rstd[u.pm * BM + wr * 64 + fr + ai * HALF + m * 16];
        return p; }
    __device__ __forceinline__ void operator()(AccRef acc_, const Unit& u, int wr, int wc, int fr, int fq, const Pre& pre) const {
        EPI_LANES; const int row0 = u.pm * BM + wr * 64 + rl;
        f32x4 acc[2][2][4][2];
#pragma unroll
        for (int ai = 0; ai < 2; ++ai)
#pragma unroll
            for (int m = 0; m < 4; ++m) { const float rs = pre.rs[ai][m];
#pragma unroll
                for (int bj = 0; bj < 2; ++bj)
#pragma unroll
                    for (int n = 0; n < 2; ++n) acc[ai][bj][m][n] = acc_[ai][bj][m][n] * rs; }
        if (u.pn < 16) {
            bf16* base = Q + (size_t)(u.pn >> 2) * ((size_t)S * 1024) + (u.pn & 3) * 256 + wc * 32 + 8 * cg;
#pragma unroll
            for (int ai = 0; ai < 2; ++ai)
#pragma unroll
                for (int m = 0; m < 4; ++m) { bf16* rowp = base + (size_t)(row0 + ai * HALF + m * 16) * 1024;
#pragma unroll
                    for (int bj = 0; bj < 2; ++bj) { const f32x4 v0 = acc[ai][bj][m][0], v1 = acc[ai][bj][m][1];
                        u32x4 w; w.x = cvt_pk_bf16(v0[0], v0[1]); w.y = cvt_pk_bf16(v0[2], v0[3]); w.z = cvt_pk_bf16(v1[0], v1[1]); w.w = cvt_pk_bf16(v1[2], v1[3]);
                        *(u32x4*)(rowp + bj * HALF) = bperm4(ps, w); } }
        } else {
            const int pg = u.pn - 16;
            bf16* base = GA + (size_t)(pg >> 3) * ((size_t)S * 2048) + (pg & 7) * 256 + wc * 32 + 8 * cg;
#pragma unroll
            for (int ai = 0; ai < 2; ++ai)
#pragma unroll
                for (int m = 0; m < 4; ++m) { bf16* rowp = base + (size_t)(row0 + ai * HALF + m * 16) * 2048;
#pragma unroll
                    for (int bj = 0; bj < 2; ++bj) { f32x4 v0 = acc[ai][bj][m][0], v1 = acc[ai][bj][m][1];
#pragma unroll
                        for (int j = 0; j < 4; ++j) { v0[j] = sigmoidf_(v0[j]); v1[j] = sigmoidf_(v1[j]); }
                        u32x4 w; w.x = cvt_pk_bf16(v0[0], v0[1]); w.y = cvt_pk_bf16(v0[2], v0[3]); w.z = cvt_pk_bf16(v1[0], v1[1]); w.w = cvt_pk_bf16(v1[2], v1[3]);
                        *(u32x4*)(rowp + bj * HALF) = bperm4(ps, w); } }
        }
    }
};
template <int MODE> struct EpiGate {
    static constexpr bool PERM = true;
    const bf16* G; bf16* O; int ld; bf16* Ost = nullptr;
    struct Pre {}; __device__ __forceinline__ Pre prefetch(const Unit&, int, int) const { return Pre{}; }
    __device__ __forceinline__ void operator()(AccRef acc, const Unit& u, int wr, int wc, int fr, int fq, const Pre&) const {
        EPI_LANES; const int row0 = u.pm * BM + wr * 64 + rl, col0 = u.pn * BM + wc * 32 + 8 * cg; bf16* const Ow = Ost ? Ost : O;
#pragma unroll
        for (int ai = 0; ai < 2; ++ai) {
            u32x4 gv[4][2], ov[4][2];
#pragma unroll
            for (int m = 0; m < 4; ++m)
#pragma unroll
                for (int bj = 0; bj < 2; ++bj) { const size_t off = (size_t)(row0 + ai * HALF + m * 16) * ld + col0 + bj * HALF;
                    gv[m][bj] = *(const u32x4*)(G + off); if (MODE == 2) ov[m][bj] = *(const u32x4*)(O + off); }
#pragma unroll
            for (int m = 0; m < 4; ++m)
#pragma unroll
                for (int bj = 0; bj < 2; ++bj) { const size_t off = (size_t)(row0 + ai * HALF + m * 16) * ld + col0 + bj * HALF;
                    const f32x4 v0 = bperm4f(ps, acc[ai][bj][m][0]), v1 = bperm4f(ps, acc[ai][bj][m][1]); const u32x4 g = gv[m][bj];
                    float a[8] = {v0[0], v0[1], v0[2], v0[3], v1[0], v1[1], v1[2], v1[3]};
                    const float gg[8] = {bflo(g.x), bfhi(g.x), bflo(g.y), bfhi(g.y), bflo(g.z), bfhi(g.z), bflo(g.w), bfhi(g.w)};
                    if (MODE == 1) {
#pragma unroll
                        for (int j = 0; j < 8; ++j) a[j] = gg[j] * sigmoidf_(a[j]);
                    } else if (MODE == 0) {
#pragma unroll
                        for (int j = 0; j < 8; ++j) a[j] = gg[j] * a[j];
                    } else {
                        const u32x4 o = ov[m][bj];
                        const float oo[8] = {bflo(o.x), bfhi(o.x), bflo(o.y), bfhi(o.y), bflo(o.z), bfhi(o.z), bflo(o.w), bfhi(o.w)};
#pragma unroll
                        for (int j = 0; j < 8; ++j) a[j] = oo[j] + gg[j] * a[j];
                    }
                    u32x4 w; w.x = cvt_pk_bf16(a[0], a[1]); w.y = cvt_pk_bf16(a[2], a[3]); w.z = cvt_pk_bf16(a[4], a[5]); w.w = cvt_pk_bf16(a[6], a[7]);
                    *(u32x4*)(Ow + off) = w; }
            asm volatile("" ::: "memory");
        }
    }
};
template <bool IN_F32> struct EpiResid {
    static constexpr bool PERM = true;
    const float* xin32; const bf16* xin16; bf16* xout;
    struct Pre {}; __device__ __forceinline__ Pre prefetch(const Unit&, int, int) const { return Pre{}; }
    __device__ __forceinline__ void operator()(AccRef acc, const Unit& u, int wr, int wc, int fr, int fq, const Pre&) const {
        EPI_LANES; const int row0 = u.pm * BM + wr * 64 + rl, col0 = u.pn * BM + wc * 32 + 8 * cg;
#pragma unroll
        for (int ai = 0; ai < 2; ++ai) {
            f32x4 xf[4][2][2]; u32x4 xh[4][2];
#pragma unroll
            for (int m = 0; m < 4; ++m)
#pragma unroll
                for (int bj = 0; bj < 2; ++bj) { const size_t off = (size_t)(row0 + ai * HALF + m * 16) * D + col0 + bj * HALF;
                    if (IN_F32) { xf[m][bj][0] = *(const f32x4*)(xin32 + off); xf[m][bj][1] = *(const f32x4*)(xin32 + off + 4); } else xh[m][bj] = *(const u32x4*)(xin16 + off); }
#pragma unroll
            for (int m = 0; m < 4; ++m)
#pragma unroll
                for (int bj = 0; bj < 2; ++bj) { const size_t off = (size_t)(row0 + ai * HALF + m * 16) * D + col0 + bj * HALF;
                    f32x4 a0 = bperm4f(ps, acc[ai][bj][m][0]), a1 = bperm4f(ps, acc[ai][bj][m][1]);
                    if (IN_F32) { a0 += xf[m][bj][0]; a1 += xf[m][bj][1]; }
                    else { const u32x4 h = xh[m][bj]; a0 += (f32x4){bflo(h.x), bfhi(h.x), bflo(h.y), bfhi(h.y)}; a1 += (f32x4){bflo(h.z), bfhi(h.z), bflo(h.w), bfhi(h.w)}; }
                    u32x4 w; w.x = cvt_pk_bf16(a0[0], a0[1]); w.y = cvt_pk_bf16(a0[2], a0[3]); w.z = cvt_pk_bf16(a1[0], a1[1]); w.w = cvt_pk_bf16(a1[2], a1[3]);
                    *(u32x4*)(xout + off) = w; }
            asm volatile("" ::: "memory");
        }
    }
};
struct EpiSwiglu {
    static constexpr bool PERM = true;
    bf16* O; int ld; const float* rstd; bool moe; int cumv[NE];
    struct Pre { float rs[2][4]; };
    __device__ __forceinline__ Pre prefetch(const Unit& u, int wr, int fr) const { Pre pp;
        int b_e = 0;
#pragma unroll
        for (int k = 0; k < NE; ++k) b_e = (k == u.e) ? cumv[k] : b_e;
        const int p = u.pm - b_e;
#pragma unroll
        for (int ai = 0; ai < 2; ++ai)
#pragma unroll
            for (int m = 0; m < 4; ++m) { const int r = ai * HALF + wr * 64 + m * 16 + fr; int idx = u.pm * BM + r;
                if (moe) idx = u.e * S + ((r < u.nv) ? 256 * p + r : 0);
                pp.rs[ai][m] = rstd[idx]; }
        return pp; }
    __device__ __forceinline__ void operator()(AccRef acc, const Unit& u, int wr, int wc, int fr, int fq, const Pre& pre) const {
        EPI_LANES; const int row0 = u.pm * BM + wr * 64 + rl, col0 = u.pn * HALF + wc * 32 + 8 * cg;
#pragma unroll
        for (int ai = 0; ai < 2; ++ai)
#pragma unroll
            for (int m = 0; m < 4; ++m) { bf16* rowp = O + (size_t)(row0 + ai * HALF + m * 16) * ld + col0; const float rs = pre.rs[ai][m];
                float a[8];
#pragma unroll
                for (int n = 0; n < 2; ++n)
#pragma unroll
                    for (int j = 0; j < 4; ++j) { const float g = acc[ai][0][m][n][j] * rs, up = acc[ai][1][m][n][j] * rs; a[n * 4 + j] = g * sigmoidf_(g) * up; }
                u32x4 w; w.x = cvt_pk_bf16(a[0], a[1]); w.y = cvt_pk_bf16(a[2], a[3]); w.z = cvt_pk_bf16(a[4], a[5]); w.w = cvt_pk_bf16(a[6], a[7]);
                *(u32x4*)rowp = bperm4(ps, w); }
    }
};
struct EpiMoeDown {
    static constexpr bool PERM = true;
    bf16* O; const int* lists; const float* gw; int cumv[NE];
    struct Pre {}; __device__ __forceinline__ Pre prefetch(const Unit&, int, int) const { return Pre{}; }
    __device__ __forceinline__ void operator()(AccRef acc, const Unit& u, int wr, int wc, int fr, int fq, const Pre&) const {
        int b_e = 0;
#pragma unroll
        for (int k = 0; k < NE; ++k) b_e = (k == u.e) ? cumv[k] : b_e;
        EPI_LANES; const int p = u.pm - b_e; const int col0 = u.pn * BM + wc * 32 + 8 * cg;
#pragma unroll
        for (int ai = 0; ai < 2; ++ai)
#pragma unroll
            for (int m = 0; m < 4; ++m) { const int r = ai * HALF + wr * 64 + m * 16 + rl;
                f32x4 pv[2][2];
#pragma unroll
                for (int bj = 0; bj < 2; ++bj) { pv[bj][0] = bperm4f(ps, acc[ai][bj][m][0]); pv[bj][1] = bperm4f(ps, acc[ai][bj][m][1]); }
                if (r < u.nv) { const int slot = lists[u.e * S + 256 * p + r]; const float g = gw[slot]; bf16* rowp = O + (size_t)slot * D + col0;
#pragma unroll
                    for (int bj = 0; bj < 2; ++bj) { const f32x4 v0 = pv[bj][0] * g, v1 = pv[bj][1] * g;
                        u32x4 w; w.x = cvt_pk_bf16(v0[0], v0[1]); w.y = cvt_pk_bf16(v0[2], v0[3]); w.z = cvt_pk_bf16(v1[0], v1[1]); w.w = cvt_pk_bf16(v1[2], v1[3]);
                        *(u32x4*)(rowp + bj * HALF) = w; } } }
    }
};
}

struct Args { const float* in[24]; float* out; unsigned char* ws; int ph_lo, ph_hi; };
struct Frame {
    LAS unsigned char* lds;
    gu32* ctl;
    unsigned char* ws;
    int tid, lane, wave, vcu, G, bid;
    const struct Args __attribute__((address_space(4)))* ka;
};

struct TItem { const float* src; bf16* dst; const float* gk; int N, K, k0, n0, drow0; };
__device__ __forceinline__ TItem titem(const float* W, int K, int N, bf16* WT, int il  , int item, const float* gk) {
    TItem t; const int nblk = N / 32, kb = item / nblk, nb = item % nblk; t.src = W; t.dst = WT; t.gk = gk; t.N = N; t.K = K; t.k0 = 64 * kb; t.n0 = 32 * nb;
    t.drow0 = il ? ((t.n0 >> 7) * 256 + (t.n0 & 127) + (il == 2 ? 128 : 0)) : t.n0; return t;
}
__device__ __forceinline__ void titem_load(const TItem& t, float (&v)[32], int lane) {
    const float* p = t.src + (size_t)(t.k0 + (lane >> 5)) * t.N + t.n0 + (lane & 31);
#pragma unroll
    for (int i = 0; i < 32; ++i) v[i] = p[(size_t)(2 * i) * t.N];
}
__device__ __forceinline__ void titem_store(const TItem& t, const float (&v)[32], LAS float* scr, int lane) {
#pragma unroll
    for (int i = 0; i < 32; ++i) scr[(2 * i + (lane >> 5)) * 33 + (lane & 31)] = v[i];
    LDS_WAIT(); asm volatile("" ::: "memory");
    const int c = lane & 7;
    f32x4 g0 = (f32x4){1.f, 1.f, 1.f, 1.f}, g1 = g0;
    if (t.gk) { g0 = *(const f32x4*)(t.gk + t.k0 + 8 * c); g1 = *(const f32x4*)(t.gk + t.k0 + 8 * c + 4); }
#pragma unroll
    for (int j = 0; j < 4; ++j) { const int n = (lane >> 3) + 8 * j; const LAS float* s = scr + (8 * c) * 33 + n;
        u32x4 o; o.x = pk2(s[0 * 33] * g0.x, s[1 * 33] * g0.y); o.y = pk2(s[2 * 33] * g0.z, s[3 * 33] * g0.w); o.z = pk2(s[4 * 33] * g1.x, s[5 * 33] * g1.y); o.w = pk2(s[6 * 33] * g1.z, s[7 * 33] * g1.w);
        *(GAS u32x4*)(t.dst + (size_t)(t.drow0 + n) * t.K + t.k0 + 8 * c) = o; }
    LDS_WAIT(); asm volatile("" ::: "memory");
}
__device__ __forceinline__ float row32_to_bf16_rstd(Frame& F, const float* xrow, bf16* orow) {
    const GAS f32x4* xr = (const GAS f32x4*)xrow + F.lane; GAS unsigned long long* o8 = (GAS unsigned long long*)orow + F.lane; float s = 0.f;
#pragma unroll
    for (int j = 0; j < 8; ++j) { const f32x4 v = xr[64 * j]; const unsigned w0 = pk2(v.x, v.y), w1 = pk2(v.z, v.w); o8[64 * j] = (unsigned long long)w0 | ((unsigned long long)w1 << 32);
        const float a0 = bflo(w0), a1 = bfhi(w0), a2 = bflo(w1), a3 = bfhi(w1); s += (a0 * a0 + a1 * a1) + (a2 * a2 + a3 * a3); }
    return 1.0f / sqrtf(wave_sum(s) * (1.f / D) + RMS_EPS);
}
__device__ __forceinline__ float rms_row16_rstd(Frame& F, const bf16* xrow) {
    const GAS u32x4* xr = (const GAS u32x4*)xrow + F.lane; float s = 0.f;
#pragma unroll
    for (int j = 0; j < 4; ++j) { const u32x4 h = xr[64 * j]; const float a0 = bflo(h.x), a1 = bfhi(h.x), a2 = bflo(h.y), a3 = bfhi(h.y), a4 = bflo(h.z), a5 = bfhi(h.z), a6 = bflo(h.w), a7 = bfhi(h.w);
        s += ((a0 * a0 + a1 * a1) + (a2 * a2 + a3 * a3)) + ((a4 * a4 + a5 * a5) + (a6 * a6 + a7 * a7)); }
    return 1.0f / sqrtf(wave_sum(s) * (1.f / D) + RMS_EPS);
}
__device__ __forceinline__ void rms_row16_to_bf16(Frame& F, const bf16* xrow, const float* g, bf16* orow) {
    const GAS u32x4* xr = (const GAS u32x4*)xrow + F.lane; const GAS f32x4* gr = (const GAS f32x4*)g + 2 * F.lane;
    float v[4][8]; float s = 0.f;
#pragma unroll
    for (int j = 0; j < 4; ++j) { const u32x4 h = xr[64 * j]; v[j][0] = bflo(h.x); v[j][1] = bfhi(h.x); v[j][2] = bflo(h.y); v[j][3] = bfhi(h.y); v[j][4] = bflo(h.z); v[j][5] = bfhi(h.z); v[j][6] = bflo(h.w); v[j][7] = bfhi(h.w);
#pragma unroll
        for (int q = 0; q < 8; ++q) s += v[j][q] * v[j][q]; }
    const float rstd = 1.0f / sqrtf(wave_sum(s) * (1.f / D) + RMS_EPS);
    GAS u32x4* o = (GAS u32x4*)orow + F.lane;
#pragma unroll
    for (int j = 0; j < 4; ++j) { const f32x4 g0 = gr[128 * j], g1 = gr[128 * j + 1]; u32x4 w;
        w.x = pk2(v[j][0] * rstd * g0.x, v[j][1] * rstd * g0.y); w.y = pk2(v[j][2] * rstd * g0.z, v[j][3] * rstd * g0.w);
        w.z = pk2(v[j][4] * rstd * g1.x, v[j][5] * rstd * g1.y); w.w = pk2(v[j][6] * rstd * g1.z, v[j][7] * rstd * g1.w); o[64 * j] = w; }
}
__device__ __forceinline__ void rms_row_to_bf16(Frame& F, const float* xrow, const float* g, bf16* orow) {
    const GAS f32x4* xr = (const GAS f32x4*)xrow + F.lane; const GAS f32x4* gr = (const GAS f32x4*)g + F.lane;
    f32x4 v[8]; float s = 0.f;
#pragma unroll
    for (int j = 0; j < 8; ++j) { v[j] = xr[64 * j]; s += (v[j].x * v[j].x + v[j].y * v[j].y) + (v[j].z * v[j].z + v[j].w * v[j].w); }
    const float rstd = 1.0f / sqrtf(wave_sum(s) * (1.f / D) + RMS_EPS);
    GAS unsigned long long* o8 = (GAS unsigned long long*)orow + F.lane;
#pragma unroll
    for (int j = 0; j < 8; ++j) { const f32x4 gg = gr[64 * j]; o8[64 * j] = (unsigned long long)pk2(v[j].x * rstd * gg.x, v[j].y * rstd * gg.y) | ((unsigned long long)pk2(v[j].z * rstd * gg.z, v[j].w * rstd * gg.w) << 32); }
}

__device__ __forceinline__ void cis_d(double th, float& c, float& s) {
    const double TWO_PI = 6.283185307179586476925286766559;
    const double k = rint(th / TWO_PI); const float r = (float)(th - k * TWO_PI);
    c = cosf(r); s = sinf(r);
}
__device__ __forceinline__ void ssm_tables_group(Frame& F, int g, const float* a_re, const float* a_im, const float* log_dt, const float* b_re, const float* b_im,
                                                 const float* c_re, const float* c_im) {
    const int n = F.lane;
    const double dt = exp((double)log_dt[g]); const double ar = (double)a_re[g * SN + n], ai = (double)a_im[g * SN + n];
    float cr, sr; cis_d(dt * ai, cr, sr); const float mag = (float)exp(dt * ar);
    const float abr = mag * cr, abi = mag * sr;
    float cl, sl; cis_d(dt * ai * (double)CH, cl, sl); const float magl = (float)exp(dt * ar * (double)CH);
    float* abar = (float*)(F.ws + WS_SSMT + ST_ABAR); float* abarl = (float*)(F.ws + WS_SSMT + ST_ABARL);
    abar[(g * SN + n) * 2] = abr; abar[(g * SN + n) * 2 + 1] = abi; abarl[(g * SN + n) * 2] = magl * cl; abarl[(g * SN + n) * 2 + 1] = magl * sl;
    const float arf = (float)ar, aif = (float)ai; const float den = arf * arf + aif * aif; const float nre = abr - 1.0f;
    const float zre = (nre * arf + abi * aif) / den, zim = (abi * arf - nre * aif) / den;
    bf16* bbf = (bf16*)(F.ws + WS_SSMT + ST_BBF);
#pragma unroll
    for (int q = 0; q < SP; ++q) {
        const float br = b_re[(g * SN + n) * SP + q], bi = b_im[(g * SN + n) * SP + q];
        const float re = zre * br - zim * bi, im = zre * bi + zim * br;
        const int l = (n & 31) + 32 * (q >> 3), j = q & 7;
        bbf[((size_t)(g * 4 + (n >> 5)) * 64 + l) * 8 + j] = (bf16)f2bf(re);
        bbf[((size_t)(g * 4 + 2 + (n >> 5)) * 64 + l) * 8 + j] = (bf16)f2bf(im);
    }
    bf16* ctf = (bf16*)(F.ws + WS_SSMT + ST_CTF);
    for (int kk = 0; kk < 4; ++kk)
#pragma unroll
        for (int j = 0; j < 8; ++j) { const int l = F.lane, kp = 32 * kk + 8 * (l >> 4) + j, st = kp >> 1, p = l & 15;
            const float v = (kp & 1) ? -c_im[(g * SP + p) * SN + st] : c_re[(g * SP + p) * SN + st];
            ctf[((size_t)(g * 4 + kk) * 64 + l) * 8 + j] = (bf16)f2bf(v); }
}

constexpr int XROWB = 272;
constexpr size_t WS_RT = 574 * MiB;
__device__ __forceinline__ void cmul_acc(float& xr, float& xi, float ar, float ai, float br, float bi) {
    const float nr = ar * xr - ai * xi + br, ni = ar * xi + ai * xr + bi; xr = nr; xi = ni;
}
template <bool READOUT>
__device__ __forceinline__ void ssm_run(Frame& F, int g, int run, const bf16* U, bf16* Y, const float* dskip, LAS unsigned char* xl) {
    const int lane = F.lane, ci = lane & 31, hh = lane >> 5, c0 = run * 8;
    const float* abar = (const float*)(F.ws + WS_SSMT + ST_ABAR); const float* abarl = (const float*)(F.ws + WS_SSMT + ST_ABARL);
    float* XE = (float*)(F.ws + WS_XE) + (size_t)g * NCH * 128;
    float* RT = (float*)(F.ws + WS_RT) + (size_t)g * 64 * 128;
    float ar[2], ai[2], lr[2], li[2];
#pragma unroll
    for (int s = 0; s < 2; ++s) { const int n = ci + 32 * s; ar[s] = abar[(g * SN + n) * 2]; ai[s] = abar[(g * SN + n) * 2 + 1]; lr[s] = abarl[(g * SN + n) * 2]; li[s] = abarl[(g * SN + n) * 2 + 1]; }
    bf16x8 bfr[4], ctf[4];
#pragma unroll
    for (int nt = 0; nt < 4; ++nt) bfr[nt] = *(const bf16x8*)((const bf16*)(F.ws + WS_SSMT + ST_BBF) + ((size_t)(g * 4 + nt) * 64 + lane) * 8);
    float dsk = 0.f;
    float xr[2] = {0.f, 0.f}, xi[2] = {0.f, 0.f};
    float xer[4][2], xei[4][2];
    float l2r[2], l2i[2];
#pragma unroll
    for (int s = 0; s < 2; ++s) { l2r[s] = lr[s] * lr[s] - li[s] * li[s]; l2i[s] = 2.f * lr[s] * li[s]; }
    if (READOUT) {
#pragma unroll
        for (int kk = 0; kk < 4; ++kk) ctf[kk] = *(const bf16x8*)((const bf16*)(F.ws + WS_SSMT + ST_CTF) + ((size_t)(g * 4 + kk) * 64 + lane) * 8);
        dsk = dskip[g * SP + (lane & 15)];
#pragma unroll
        for (int u = 0; u < 4; ++u)
#pragma unroll
            for (int s = 0; s < 2; ++s) { const int cx = (u == 0) ? c0 : (c0 + 2 * u + hh - 1); xer[u][s] = XE[cx * 128 + ci + 32 * s]; xei[u][s] = XE[cx * 128 + 64 + ci + 32 * s]; }
        float l8r[2], l8i[2];
#pragma unroll
        for (int s = 0; s < 2; ++s) { const float l4r = l2r[s] * l2r[s] - l2i[s] * l2i[s], l4i = 2.f * l2r[s] * l2i[s]; l8r[s] = l4r * l4r - l4i * l4i; l8i[s] = 2.f * l4r * l4i; }
        for (int rb = 0; rb < run; rb += 8) {
            float tr[8][2], ti[8][2];
#pragma unroll
            for (int q = 0; q < 8; ++q)
#pragma unroll
                for (int s = 0; s < 2; ++s) { const int rr = (rb + q < run) ? rb + q : 0; tr[q][s] = RT[rr * 128 + ci + 32 * s] + RT[(32 + rr) * 128 + ci + 32 * s]; ti[q][s] = RT[rr * 128 + 64 + ci + 32 * s] + RT[(32 + rr) * 128 + 64 + ci + 32 * s]; }
#pragma unroll
            for (int q = 0; q < 8; ++q) if (rb + q < run) {
#pragma unroll
                for (int s = 0; s < 2; ++s) cmul_acc(xr[s], xi[s], l8r[s], l8i[s], tr[q][s], ti[q][s]); }
        }
        if (hh) {
#pragma unroll
            for (int s = 0; s < 2; ++s) cmul_acc(xr[s], xi[s], lr[s], li[s], xer[0][s], xei[0][s]); }
    }
    float hr[2] = {0.f, 0.f}, hi2[2] = {0.f, 0.f};
    bf16x8 afn[4]; bf16 uvn[2][4];
#pragma unroll
    for (int u = 0; u < 4; ++u) {
        const int cA = c0 + 2 * u, cm = cA + hh;
        if (!READOUT) { xr[0] = xr[1] = xi[0] = xi[1] = 0.f; }
        else if (u > 0) {
#pragma unroll
            for (int s = 0; s < 2; ++s) cmul_acc(xr[s], xi[s], lr[s], li[s], xer[u][s], xei[u][s]);
        }
        bf16x8 af[4];
        if (u == 0) { const int seg = (ci >> 2) & 1, tk = 4 * (ci >> 3) + (ci & 3);
#pragma unroll
          for (int k = 0; k < 4; ++k) afn[k] = *(const bf16x8*)(U + (size_t)((cA + seg) * CH + 16 * k + tk) * SSMW + g * SP + 8 * hh);
          if (READOUT) {
#pragma unroll
              for (int sg = 0; sg < 2; ++sg)
#pragma unroll
                  for (int r = 0; r < 4; ++r) uvn[sg][r] = U[(size_t)((cA + sg) * CH + 4 * (lane >> 4) + r) * SSMW + g * SP + (lane & 15)]; } }
#pragma unroll
        for (int k = 0; k < 4; ++k) af[k] = afn[k];
        if (u < 3) { const int seg = (ci >> 2) & 1, tk = 4 * (ci >> 3) + (ci & 3);
#pragma unroll
          for (int k = 0; k < 4; ++k) afn[k] = *(const bf16x8*)(U + (size_t)((cA + 2 + seg) * CH + 16 * k + tk) * SSMW + g * SP + 8 * hh); }
#pragma unroll
        for (int k = 0; k < 4; ++k) {
            float uv[2][4];
            if (READOUT) {
#pragma unroll
                for (int sg = 0; sg < 2; ++sg)
#pragma unroll
                    for (int r = 0; r < 4; ++r) uv[sg][r] = bf2f(uvn[sg][r]);
                if (k < 3 || u < 3) { const int cn = (k < 3) ? cA : cA + 2, kn = (k < 3) ? k + 1 : 0;
#pragma unroll
                    for (int sg = 0; sg < 2; ++sg)
#pragma unroll
                        for (int r = 0; r < 4; ++r) uvn[sg][r] = U[(size_t)((cn + sg) * CH + 16 * kn + 4 * (lane >> 4) + r) * SSMW + g * SP + (lane & 15)]; }
            }
            f32x16 bu[4];
            mfma32_x4_zero(bu[0], bu[1], bu[2], bu[3], af[k], bfr[0], bfr[1], bfr[2], bfr[3]);
#pragma unroll
            for (int r = 0; r < 16; ++r) {
#pragma unroll
                for (int s = 0; s < 2; ++s) {
                    cmul_acc(xr[s], xi[s], ar[s], ai[s], bu[s][r], bu[2 + s][r]);
                    if (READOUT) *(LAS unsigned*)(xl + (hh * 16 + r) * XROWB + (ci + 32 * s) * 4) = cvt_pk_bf16(xr[s], xi[s]);
                }
            }
            if (READOUT) {
                LDS_WAIT();
#pragma unroll
                for (int sg = 0; sg < 2; ++sg) {
                    bf16x8 xa[4];
#pragma unroll
                    for (int kk = 0; kk < 4; ++kk) xa[kk] = *(const LAS bf16x8*)(xl + (sg * 16 + (lane & 15)) * XROWB + (32 * kk + 8 * (lane >> 4)) * 2);
                    LDS_WAIT();
                    const f32x4 y = mfma16_chain4(xa[0], xa[1], xa[2], xa[3], ctf[0], ctf[1], ctf[2], ctf[3]);
#pragma unroll
                    for (int r = 0; r < 4; ++r) { const size_t idx = (size_t)((cA + sg) * CH + 16 * k + 4 * (lane >> 4) + r) * SSMW + g * SP + (lane & 15);
                        const float v = y[r] + dsk * uv[sg][r];
                        const float e = __expf(-1.5957691216057308f * (v + 0.044715f * v * v * v));
                        Y[idx] = (bf16)f2bf(v * __builtin_amdgcn_rcpf(1.0f + e)); }
                }
                LDS_WAIT();
            }
        }
        if (!READOUT) {
#pragma unroll
            for (int s = 0; s < 2; ++s) { XE[cm * 128 + ci + 32 * s] = xr[s]; XE[cm * 128 + 64 + ci + 32 * s] = xi[s];
                cmul_acc(hr[s], hi2[s], l2r[s], l2i[s], xr[s], xi[s]); }
        }
    }
    if (!READOUT) {
#pragma unroll
        for (int s = 0; s < 2; ++s) {
            float er = hr[s], ei = hi2[s];
            if (!hh) { const float nr = lr[s] * er - li[s] * ei, ni = lr[s] * ei + li[s] * er; er = nr; ei = ni; }
            RT[(hh * 32 + run) * 128 + ci + 32 * s] = er; RT[(hh * 32 + run) * 128 + 64 + ci + 32 * s] = ei;
        }
    }
}

__device__ __forceinline__ void attn_item(Frame& F, int h, int qt, const bf16* Q, const bf16* K, const bf16* V, bf16* O) {
    const int lane = F.lane, ci = lane & 31, hh = lane >> 5, t0 = qt * 32;
    bf16x8 qf[8];
    { const bf16* qrow = Q + (size_t)(t0 + ci) * SBW + h * HD + 8 * hh;
#pragma unroll
      for (int ks = 0; ks < 8; ++ks) qf[ks] = *(const bf16x8*)(qrow + 16 * ks); }
    f32x16 o[4];
#pragma unroll
    for (int dt = 0; dt < 4; ++dt)
#pragma unroll
        for (int r = 0; r < 16; ++r) o[dt][r] = 0.f;
    float carry = 0.f;
    for (int kt = qt; kt >= 0; --kt) {
        const int k0 = kt * 32;
        bf16x8 kf[8];
        { const bf16* krow = K + (size_t)(k0 + ci) * SBW + h * HD + 8 * hh;
#pragma unroll
          for (int ks = 0; ks < 8; ++ks) kf[ks] = *(const bf16x8*)(krow + 16 * ks); }
        unsigned vv[2][8][2];
#pragma unroll
        for (int s = 0; s < 2; ++s)
#pragma unroll
            for (int j = 0; j < 8; ++j) { const bf16* vrow = V + (size_t)(k0 + 16 * s + 8 * (j >> 2) + 4 * hh + (j & 3)) * SBW + h * HD + 2 * ci;
                vv[s][j][0] = *(const unsigned*)vrow; vv[s][j][1] = *(const unsigned*)(vrow + 64); }
        const f32x16 c = mfma32_chain8(kf, qf);
        float z[16], sp[16];
        const bool diag = (kt == qt);
#pragma unroll
        for (int r = 0; r < 16; ++r) { const int i = (r & 3) + 8 * (r >> 2) + 4 * hh; z[r] = c[r] * 0.08838834764831845f;
            const bool valid = !diag || (i < ci);
            sp[r] = valid ? (fmaxf(z[r], 0.f) + __logf(1.0f + __expf(-fabsf(z[r])))) : 0.f; }
        float gs[4], pg[4];
#pragma unroll
        for (int g = 0; g < 4; ++g) { gs[g] = (sp[4 * g] + sp[4 * g + 1]) + (sp[4 * g + 2] + sp[4 * g + 3]); pg[g] = __shfl_xor(gs[g], 32); }
        float w[16]; float above = 0.f;
#pragma unroll
        for (int g = 3; g >= 0; --g) {
            float run = carry + above + (hh == 0 ? pg[g] : 0.f);
#pragma unroll
            for (int q = 3; q >= 0; --q) { const int r = 4 * g + q, i = q + 8 * g + 4 * hh; run += sp[r];
                const bool valid = !diag || (i < ci); w[r] = valid ? __expf(z[r] - run) : 0.f; }
            above += gs[g] + pg[g];
        }
        carry += above;
        bf16x8 pb[2];
#pragma unroll
        for (int s = 0; s < 2; ++s) { u32x4 t; t.x = cvt_pk_bf16(w[8 * s], w[8 * s + 1]); t.y = cvt_pk_bf16(w[8 * s + 2], w[8 * s + 3]); t.z = cvt_pk_bf16(w[8 * s + 4], w[8 * s + 5]); t.w = cvt_pk_bf16(w[8 * s + 6], w[8 * s + 7]);
            pb[s] = __builtin_bit_cast(bf16x8, t); }
        bf16x8 va[4][2];
#pragma unroll
        for (int dt = 0; dt < 4; ++dt)
#pragma unroll
            for (int s = 0; s < 2; ++s) { const unsigned sel = (dt & 1) ? 0x07060302u : 0x05040100u; u32x4 t;
                t.x = __builtin_amdgcn_perm(vv[s][1][dt >> 1], vv[s][0][dt >> 1], sel); t.y = __builtin_amdgcn_perm(vv[s][3][dt >> 1], vv[s][2][dt >> 1], sel);
                t.z = __builtin_amdgcn_perm(vv[s][5][dt >> 1], vv[s][4][dt >> 1], sel); t.w = __builtin_amdgcn_perm(vv[s][7][dt >> 1], vv[s][6][dt >> 1], sel);
                va[dt][s] = __builtin_bit_cast(bf16x8, t); }
        mfma32_pv(o, va, pb);
        if (__all(carry > SB_THRESH)) break;
    }
    MFMA_SETTLE4(o[0], o[1], o[2], o[3]);
    bf16* orow = O + (size_t)(t0 + ci) * SBW + h * HD + 8 * hh;
#pragma unroll
    for (int dp = 0; dp < 2; ++dp)
#pragma unroll
        for (int g = 0; g < 4; ++g) { u32x4 t;
            t.x = cvt_pk_bf16(o[2 * dp][4 * g], o[2 * dp + 1][4 * g]); t.y = cvt_pk_bf16(o[2 * dp][4 * g + 1], o[2 * dp + 1][4 * g + 1]);
            t.z = cvt_pk_bf16(o[2 * dp][4 * g + 2], o[2 * dp + 1][4 * g + 2]); t.w = cvt_pk_bf16(o[2 * dp][4 * g + 3], o[2 * dp + 1][4 * g + 3]);
            *(u32x4*)(orow + 64 * dp + 16 * g) = t; }
}

constexpr int NPHASE = 21;

__device__ __forceinline__ Frame mk_frame() {
    Frame F; int t_ = threadIdx.x; asm volatile("" : "+v"(t_)); int b_ = blockIdx.x; asm volatile("" : "+s"(b_));
    const Args __attribute__((address_space(4)))* ka = (const Args __attribute__((address_space(4)))*)__builtin_amdgcn_kernarg_segment_ptr(); asm volatile("" : "+s"(ka));
    extern __shared__ __attribute__((aligned(16))) unsigned char lds[];
    F.ka = ka; unsigned char* w_ = ka->ws;
    F.lds = (LAS unsigned char*)lds; F.ws = w_; F.ctl = (gu32*)(w_ + WS_CTL);
    F.tid = t_; F.lane = t_ & 63; F.wave = __builtin_amdgcn_readfirstlane(t_ >> 6);
    F.G = gridDim.x; F.vcu = (F.G % 8 == 0) ? (b_ % 8) * (F.G / 8) + b_ / 8 : b_; F.bid = b_;
    return F;
}
#define WSP(off) ((bf16*)(F.ws + (off)))

#if MK_ONE_LAUNCH
#define GRID_BAR() xcd_barrier(bar)
#else
#define GRID_BAR() do { } while (0)
#endif
#ifndef PHMASK
#define PHMASK 0x7FF
#endif
#ifndef DUP
#define DUP 0ull
#endif
#define REPS(k) (1 + (int)(((DUP) >> (k)) & 1ull))
#define PROBE_O(k, ptr, scratch) ((REPS(k) == 2 && rep_ == 0) ? (scratch) : (ptr))
#define IN(k) (lo <= (k) && (k) < hi)
#define SEAM(k) do { if (IN(k) && IN((k) + 1)) GRID_BAR(); } while (0)
template <int l> __device__ __forceinline__ void layer_phases(const int lo, const int hi, const XcdBarrier& bar) {
    constexpr int pb = l * 10;
        for (int rep_ = 0; rep_ < REPS(pb + 0); ++rep_) if (((PHMASK >> 0) & 1) && IN(pb + 0)) { if (rep_ > 0) GRID_BAR();
            Frame F = mk_frame(); const int gw = F.vcu * NWAVES + F.wave, NGW = F.G * NWAVES; LAS float* scr = (LAS float*)(F.lds + F.wave * 16384);
            bf16* Win_t = WSP(WS_W + W_IN); bf16* Wglu_t = WSP(WS_W + W_GLU); bf16* Pa_t = WSP(WS_W + W_PA); bf16* Ps_t = WSP(WS_W + W_PS);
            bf16* Wout_t = WSP(WS_W + W_OUT); bf16* Wgu_t = WSP(WS_W + W_GU); bf16* Wdn_t = WSP(WS_W + W_DN_DENSE); bf16* Wdnm_t = WSP(WS_W + W_DN_MOE);
            const float* w_in = F.ka->in[4] + (size_t)l * D * INC; const float* w_glu = F.ka->in[13] + (size_t)l * SSMW * SSMW;
            const float* p_attn = F.ka->in[14] + (size_t)l * SBW * D; const float* p_ssm = F.ka->in[15] + (size_t)l * SSMW * D; const float* w_out = F.ka->in[16] + (size_t)l * D * D;
            constexpr int I_IN = (D / 64) * (INC / 32), I_GLU = (SSMW / 64) * (SSMW / 32), I_PA = (SBW / 64) * (D / 32), I_OUT = (D / 64) * (D / 32);
            constexpr int I_FG = (D / 64) * (FFD / 32), I_FD = (FFD / 64) * (D / 32);
            constexpr int I_MG = (D / 64) * (FFE / 32), I_MD = (FFE / 64) * (D / 32);
            const int n_ffn = (l == 0) ? (2 * I_FG + I_FD) : NE * (2 * I_MG + I_MD);
            const int NITEMS = I_IN + I_GLU + 2 * I_PA + I_OUT + n_ffn;
            auto decode = [&](int it) -> TItem {
                int r = it;
                if (r < I_IN) return titem(w_in, D, INC, Win_t, 0, r, F.ka->in[1] + l * D); r -= I_IN;
                if (r < I_GLU) return titem(w_glu, SSMW, SSMW, Wglu_t, 0, r, nullptr); r -= I_GLU;
                if (r < I_PA) return titem(p_attn, SBW, D, Pa_t, 0, r, nullptr); r -= I_PA;
                if (r < I_PA) return titem(p_ssm, SSMW, D, Ps_t, 0, r, nullptr); r -= I_PA;
                if (r < I_OUT) return titem(w_out, D, D, Wout_t, 0, r, nullptr); r -= I_OUT;
                if (l == 0) {
                    if (r < I_FG) return titem(F.ka->in[17], D, FFD, Wgu_t, 1, r, F.ka->in[2]); r -= I_FG;
                    if (r < I_FG) return titem(F.ka->in[18], D, FFD, Wgu_t, 2, r, F.ka->in[2]); r -= I_FG;
                    return titem(F.ka->in[19], FFD, D, Wdn_t, 0, r, nullptr);
                }
                const int per = 2 * I_MG + I_MD, e = r / per; r -= e * per;
                if (r < I_MG) return titem(F.ka->in[21] + (size_t)e * D * FFE, D, FFE, Wgu_t + (size_t)e * 2048 * D, 1, r, F.ka->in[2] + D); r -= I_MG;
                if (r < I_MG) return titem(F.ka->in[22] + (size_t)e * D * FFE, D, FFE, Wgu_t + (size_t)e * 2048 * D, 2, r, F.ka->in[2] + D); r -= I_MG;
                return titem(F.ka->in[23] + (size_t)e * FFE * D, FFE, D, Wdnm_t + (size_t)e * 2048 * FFE, 0, r, nullptr);
            };
            { float va[32], vb[32]; TItem cur, nxt; int it = gw;
              if (it < NITEMS) { cur = decode(it); titem_load(cur, va, F.lane); }
              for (; it < NITEMS; it += NGW) {
                  const bool has = it + NGW < NITEMS;
                  if (has) { nxt = decode(it + NGW); titem_load(nxt, vb, F.lane); }
                  asm volatile("" ::: "memory");
                  titem_store(cur, va, scr, F.lane);
                  if (has) { cur = nxt;
#pragma unroll
                      for (int i = 0; i < 32; ++i) va[i] = vb[i]; }
              } }
            if (gw < SG) ssm_tables_group(F, gw, F.ka->in[5] + l * SG * SN, F.ka->in[6] + l * SG * SN, F.ka->in[7] + l * SG, F.ka->in[8] + (size_t)l * SG * SN * SP, F.ka->in[9] + (size_t)l * SG * SN * SP,
                                          F.ka->in[10] + (size_t)l * SG * SP * SN, F.ka->in[11] + (size_t)l * SG * SP * SN);
            if constexpr (l == 0) { bf16* XB = WSP(WS_XB); float* RSTD = (float*)(F.ws + WS_RSTD); for (int m = gw; m < S; m += NGW) { const float rs = row32_to_bf16_rstd(F, F.ka->in[0] + (size_t)m * D, XB + (size_t)m * D); if (F.lane == 0) RSTD[m] = rs; } }
            else { const bf16* XB = WSP(WS_XB); float* RSTD = (float*)(F.ws + WS_RSTD); for (int m = gw; m < S; m += NGW) { const float rs = rms_row16_rstd(F, XB + (size_t)m * D); if (F.lane == 0) RSTD[m] = rs; } }
        }
        SEAM(pb + 0);
        for (int rep_ = 0; rep_ < REPS(pb + 1); ++rep_) if (((PHMASK >> 1) & 1) && IN(pb + 1)) { if (rep_ > 0) GRID_BAR();
            Frame F = mk_frame();
            pg8::DenseSched Sd; Sd.so.init(S, INC, F.G, F.bid); Sd.A = WSP(WS_XB); Sd.Bt = WSP(WS_W + W_IN); Sd.K = D;
            pg8::EpiProj E{WSP(WS_Q), WSP(WS_GA), (const float*)(F.ws + WS_RSTD)};
            pg8::gemm_phase<pg8::EpiProj, pg8::DenseSched, true>(F.lds, D, Sd, E);
        }
        SEAM(pb + 1);
        for (int rep_ = 0; rep_ < REPS(pb + 2); ++rep_) if (((PHMASK >> 2) & 1) && IN(pb + 2)) { if (rep_ > 0) GRID_BAR();
            Frame F = mk_frame(); const int gw = F.vcu * NWAVES + F.wave, NGW = F.G * NWAVES;
            bf16* Qb = WSP(WS_Q); bf16* Kb = Qb + (size_t)S * 1024; bf16* Vb = Kb + (size_t)S * 1024; bf16* Ub = Vb + (size_t)S * 1024;
            { const int g = gw >> 5, run = gw & 31; if (gw < SG * 32) ssm_run<false>(F, g, run, Ub, WSP(WS_Y), nullptr, F.lds + F.wave * 16384); }
            bf16* OATT = WSP(WS_OATT);
            for (int it = gw; it < NH * (S / 32); it += NGW) { const int h = it & 7, qt = it >> 3; attn_item(F, h, qt, Qb, Kb, Vb, OATT); }
        }
        SEAM(pb + 2);
        for (int rep_ = 0; rep_ < REPS(pb + 3); ++rep_) if (((PHMASK >> 3) & 1) && IN(pb + 3)) { if (rep_ > 0) GRID_BAR();
            Frame F = mk_frame(); const int gw = F.vcu * NWAVES + F.wave;
            const int g = gw >> 5, run = gw & 31; if (gw < SG * 32) ssm_run<true>(F, g, run, WSP(WS_Q) + (size_t)3 * S * 1024, WSP(WS_Y), F.ka->in[12] + l * SG * SP, F.lds + F.wave * 16384);
        }
        SEAM(pb + 3);
        for (int rep_ = 0; rep_ < REPS(pb + 4); ++rep_) if (((PHMASK >> 4) & 1) && IN(pb + 4)) { if (rep_ > 0) GRID_BAR();
            { Frame F = mk_frame();
              pg8::DenseSched Sd; Sd.so.init(S, D, F.G, F.bid); Sd.A = WSP(WS_OATT); Sd.Bt = WSP(WS_W + W_PA); Sd.K = SBW;
              pg8::EpiGate<0> E{WSP(WS_GA), PROBE_O(pb + 4, WSP(WS_GA), WSP(WS_ACT)), D};
              pg8::gemm_phase<pg8::EpiGate<0>, pg8::DenseSched, true>(F.lds, SBW, Sd, E); }
            { Frame F = mk_frame();
              pg8::DenseSched Sd; Sd.so.init(S, SSMW, F.G, F.bid); Sd.A = WSP(WS_Y); Sd.Bt = WSP(WS_W + W_GLU); Sd.K = SSMW;
              pg8::EpiGate<1> E{WSP(WS_Y), PROBE_O(pb + 4, WSP(WS_OSSM), WSP(WS_ACT) + (size_t)S * D), SSMW};
              pg8::gemm_phase<pg8::EpiGate<1>, pg8::DenseSched, true>(F.lds, SSMW, Sd, E); }
        }
        SEAM(pb + 4);
        for (int rep_ = 0; rep_ < REPS(pb + 5); ++rep_) if (((PHMASK >> 5) & 1) && IN(pb + 5)) { if (rep_ > 0) GRID_BAR();
            Frame F = mk_frame();
            pg8::DenseSched Sd; Sd.so.init(S, D, F.G, F.bid); Sd.A = WSP(WS_OSSM); Sd.Bt = WSP(WS_W + W_PS); Sd.K = SSMW;
            pg8::EpiGate<2> E{WSP(WS_GB), WSP(WS_GA), D, PROBE_O(pb + 5, (bf16*)nullptr, WSP(WS_ACT))};
            pg8::gemm_phase<pg8::EpiGate<2>, pg8::DenseSched, true>(F.lds, SSMW, Sd, E);
        }
        SEAM(pb + 5);
        for (int rep_ = 0; rep_ < REPS(pb + 6); ++rep_) if (((PHMASK >> 6) & 1) && IN(pb + 6)) { if (rep_ > 0) GRID_BAR();
            Frame F = mk_frame();
            pg8::DenseSched Sd; Sd.so.init(S, D, F.G, F.bid); Sd.A = WSP(WS_GA); Sd.Bt = WSP(WS_W + W_OUT); Sd.K = D;
            pg8::EpiResid<false> E{nullptr, WSP(WS_XB), PROBE_O(pb + 6, WSP(WS_XB), WSP(WS_ACT))}; pg8::gemm_phase<pg8::EpiResid<false>, pg8::DenseSched, true>(F.lds, D, Sd, E);
        }
        SEAM(pb + 6);
        for (int rep_ = 0; rep_ < REPS(pb + 7); ++rep_) if (((PHMASK >> 7) & 1) && IN(pb + 7)) { if (rep_ > 0) GRID_BAR();
            Frame F = mk_frame(); const int gw = F.vcu * NWAVES + F.wave, NGW = F.G * NWAVES;
            const float* gnorm = F.ka->in[2] + l * D; const bf16* XB = WSP(WS_XB);
            float* RSTD = (float*)(F.ws + WS_RSTD);
            if (l == 0) { for (int m = gw; m < S; m += NGW) { const float rs = rms_row16_rstd(F, XB + (size_t)m * D); if (F.lane == 0) RSTD[m] = rs; } }
            else {
                const float* wrt = F.ka->in[20]; int* lists = (int*)(F.ws + WS_MOE); float* gatew = (float*)(F.ws + WS_MOE + (size_t)NE * S * 4);
                for (int m = gw; m < S; m += NGW) {
                    const GAS u32x4* xr = (const GAS u32x4*)(XB + (size_t)m * D) + F.lane; const GAS f32x4* gr = (const GAS f32x4*)gnorm + 2 * F.lane;
                    float v[4][8]; float s = 0.f; float lg[NE];
#pragma unroll
                    for (int e = 0; e < NE; ++e) lg[e] = 0.f;
                    const char* wbase = (const char*)wrt + (size_t)F.lane * (8 * NE * 4);
#pragma unroll
                    for (int j = 0; j < 4; ++j) { const u32x4 h = xr[64 * j]; v[j][0] = bflo(h.x); v[j][1] = bfhi(h.x); v[j][2] = bflo(h.y); v[j][3] = bfhi(h.y); v[j][4] = bflo(h.z); v[j][5] = bfhi(h.z); v[j][6] = bflo(h.w); v[j][7] = bfhi(h.w);
                        const f32x4 g0 = gr[128 * j], g1 = gr[128 * j + 1]; const float gq[8] = {g0.x, g0.y, g0.z, g0.w, g1.x, g1.y, g1.z, g1.w};
                        const char* wb = wbase + (size_t)j * (512 * NE * 4); asm volatile("" : "+v"(wb) :: "memory");
                        const GAS f32x4* wp = (const GAS f32x4*)wb;
#pragma unroll
                        for (int q = 0; q < 8; ++q) { s += v[j][q] * v[j][q]; const f32x4 w0 = wp[2 * q], w1 = wp[2 * q + 1]; const float hq = v[j][q] * gq[q];
                            lg[0] += hq * w0.x; lg[1] += hq * w0.y; lg[2] += hq * w0.z; lg[3] += hq * w0.w; lg[4] += hq * w1.x; lg[5] += hq * w1.y; lg[6] += hq * w1.z; lg[7] += hq * w1.w;
                            if ((q & 3) == 3) asm volatile("" : "+v"(lg[0]), "+v"(lg[1]), "+v"(lg[2]), "+v"(lg[3]), "+v"(lg[4]), "+v"(lg[5]), "+v"(lg[6]), "+v"(lg[7]) :: "memory"); } }
                    const float rstd = 1.0f / sqrtf(wave_sum(s) * (1.f / D) + RMS_EPS);
                    if (F.lane == 0) RSTD[m] = rstd;
#pragma unroll
                    for (int e = 0; e < NE; ++e) lg[e] = wave_sum(lg[e]) * rstd;
                    int i1 = 0; float v1 = lg[0];
#pragma unroll
                    for (int e = 1; e < NE; ++e) if (lg[e] > v1) { v1 = lg[e]; i1 = e; }
                    int i2 = (i1 == 0) ? 1 : 0; float v2 = -3.0e38f;
#pragma unroll
                    for (int e = 0; e < NE; ++e) if (e != i1 && lg[e] > v2) { v2 = lg[e]; i2 = e; }
                    if (F.lane == 0) {
                        const float e2 = __expf(v2 - v1); const float g1 = 1.0f / (1.0f + e2), g2 = e2 / (1.0f + e2);
                        const unsigned p1 = __hip_atomic_fetch_add((unsigned*)(F.ctl + CW_MOECNT + 64 * i1), 1u, RLX_AGENT);
                        const unsigned p2 = __hip_atomic_fetch_add((unsigned*)(F.ctl + CW_MOECNT + 64 * i2), 1u, RLX_AGENT);
                        lists[i1 * S + (int)p1] = 2 * m; lists[i2 * S + (int)p2] = 2 * m + 1; gatew[2 * m] = g1; gatew[2 * m + 1] = g2;
                        float* RSTDE = (float*)(F.ws + WS_RSTDE); RSTDE[i1 * S + (int)p1] = rstd; RSTDE[i2 * S + (int)p2] = rstd;
                    }
                }
            }
        }
        SEAM(pb + 7);
        if (l == 0) {
            for (int rep_ = 0; rep_ < REPS(pb + 8); ++rep_) if (((PHMASK >> 8) & 1) && IN(pb + 8)) { if (rep_ > 0) GRID_BAR();
                Frame F = mk_frame();
                pg8::DenseSched Sd; Sd.so.init(S, 2 * FFD, F.G, F.bid); Sd.A = WSP(WS_XB); Sd.Bt = WSP(WS_W + W_GU); Sd.K = D;
                pg8::EpiSwiglu E; E.O = WSP(WS_ACT); E.ld = FFD; E.rstd = (const float*)(F.ws + WS_RSTD); E.moe = false;
#pragma unroll
                for (int e = 0; e < NE; ++e) E.cumv[e] = 0;
                pg8::gemm_phase<pg8::EpiSwiglu, pg8::DenseSched, true>(F.lds, D, Sd, E);
            }
            SEAM(pb + 8);
            for (int rep_ = 0; rep_ < REPS(pb + 9); ++rep_) if (((PHMASK >> 9) & 1) && IN(pb + 9)) { if (rep_ > 0) GRID_BAR();
                Frame F = mk_frame();
                pg8::DenseSched Sd; Sd.so.init(S, D, F.G, F.bid); Sd.A = WSP(WS_ACT); Sd.Bt = WSP(WS_W + W_DN_DENSE); Sd.K = FFD;
                pg8::EpiResid<false> E{nullptr, WSP(WS_XB), PROBE_O(pb + 9, WSP(WS_XB), WSP(WS_GA))};
                pg8::gemm_phase<pg8::EpiResid<false>, pg8::DenseSched, true>(F.lds, FFD, Sd, E);
            }
            SEAM(pb + 9);
        } else {
            for (int rep_ = 0; rep_ < REPS(pb + 8); ++rep_) if (((PHMASK >> 8) & 1) && IN(pb + 8)) { if (rep_ > 0) GRID_BAR();
                Frame F = mk_frame(); const int* lists = (const int*)(F.ws + WS_MOE);
                pg8::MoeSched Sm; Sm.A = WSP(WS_XB); Sm.Bt = WSP(WS_W + W_GU); Sm.K = D; Sm.gather = true; Sm.lists = lists; Sm.init((const unsigned*)(F.ctl + CW_MOECNT), F.G, F.bid);
                pg8::EpiSwiglu E; E.O = WSP(WS_ACT); E.ld = FFE; E.rstd = (const float*)(F.ws + WS_RSTDE); E.moe = true;
#pragma unroll
                for (int e = 0; e < NE; ++e) E.cumv[e] = Sm.cum[e];
                pg8::gemm_phase<pg8::EpiSwiglu, pg8::MoeSched, true>(F.lds, D, Sm, E);
            }
            SEAM(pb + 8);
            for (int rep_ = 0; rep_ < REPS(pb + 9); ++rep_) if (((PHMASK >> 9) & 1) && IN(pb + 9)) { if (rep_ > 0) GRID_BAR();
                Frame F = mk_frame(); const int* lists = (const int*)(F.ws + WS_MOE); const float* gatew = (const float*)(F.ws + WS_MOE + (size_t)NE * S * 4);
                pg8::MoeSched Sm; Sm.A = WSP(WS_ACT); Sm.Bt = WSP(WS_W + W_DN_MOE); Sm.K = FFE; Sm.gather = false; Sm.lists = lists; Sm.init((const unsigned*)(F.ctl + CW_MOECNT), F.G, F.bid);
                pg8::EpiMoeDown E; E.O = WSP(WS_MOEY); E.lists = lists; E.gw = gatew;
#pragma unroll
                for (int e = 0; e < NE; ++e) E.cumv[e] = Sm.cum[e];
                pg8::gemm_phase<pg8::EpiMoeDown, pg8::MoeSched, true>(F.lds, FFE, Sm, E);
            }
            SEAM(pb + 9);
        }
}

__global__ void __launch_bounds__(NTHR, 2) trunk_fwd(Args args) {
    extern __shared__ __attribute__((aligned(16))) unsigned char lds[];
    {
        LAS unsigned char* l0 = (LAS unsigned char*)lds;
        for (int u = threadIdx.x; u < (LDS_BYTES - LDSCTL_OFF) / 4; u += NTHR) ((LAS unsigned*)(l0 + LDSCTL_OFF))[u] = 0u;
        __syncthreads();
    }
#if MK_ONE_LAUNCH
    XcdBarrier bar = xcd_barrier_post((unsigned*)(args.ws + WS_CTL) + CW_BAR, (volatile LAS unsigned*)((LAS unsigned char*)lds + MISC_OFF) + 8);
#else
    XcdBarrier bar; bar.bar = nullptr; bar.x = 0; bar.st = nullptr;
#endif
    const int lo = args.ph_lo, hi = args.ph_hi;
    layer_phases<0>(lo, hi, bar);
    layer_phases<1>(lo, hi, bar);

    if (((PHMASK >> 10) & 1) && IN(20)) {
        Frame F = mk_frame(); const int gw = F.vcu * NWAVES + F.wave, NGW = F.G * NWAVES;
        const float* gnorm = F.ka->in[3]; const bf16* MOEY = WSP(WS_MOEY); const bf16* XB = WSP(WS_XB); float* out = F.ka->out;
        for (int m = gw; m < S; m += NGW) {
            const GAS u32x4* xr = (const GAS u32x4*)(XB + (size_t)m * D) + F.lane; const GAS f32x4* gr = (const GAS f32x4*)gnorm + 2 * F.lane;
            const GAS u32x4* y0 = (const GAS u32x4*)(MOEY + (size_t)(2 * m) * D) + F.lane; const GAS u32x4* y1 = (const GAS u32x4*)(MOEY + (size_t)(2 * m + 1) * D) + F.lane;
            float v[4][8]; float s = 0.f;
#pragma unroll
            for (int j = 0; j < 4; ++j) { const u32x4 h = xr[64 * j], a = y0[64 * j], b = y1[64 * j];
                v[j][0] = bflo(h.x) + (bflo(a.x) + bflo(b.x)); v[j][1] = bfhi(h.x) + (bfhi(a.x) + bfhi(b.x)); v[j][2] = bflo(h.y) + (bflo(a.y) + bflo(b.y)); v[j][3] = bfhi(h.y) + (bfhi(a.y) + bfhi(b.y));
                v[j][4] = bflo(h.z) + (bflo(a.z) + bflo(b.z)); v[j][5] = bfhi(h.z) + (bfhi(a.z) + bfhi(b.z)); v[j][6] = bflo(h.w) + (bflo(a.w) + bflo(b.w)); v[j][7] = bfhi(h.w) + (bfhi(a.w) + bfhi(b.w));
#pragma unroll
                for (int q = 0; q < 8; ++q) s += v[j][q] * v[j][q]; }
            const float rstd = 1.0f / sqrtf(wave_sum(s) * (1.f / D) + RMS_EPS);
            GAS f32x4* o = (GAS f32x4*)(out + (size_t)m * D) + 2 * F.lane;
#pragma unroll
            for (int j = 0; j < 4; ++j) { const f32x4 g0 = gr[128 * j], g1 = gr[128 * j + 1];
                o[128 * j] = (f32x4){v[j][0] * rstd * g0.x, v[j][1] * rstd * g0.y, v[j][2] * rstd * g0.z, v[j][3] * rstd * g0.w};
                o[128 * j + 1] = (f32x4){v[j][4] * rstd * g1.x, v[j][5] * rstd * g1.y, v[j][6] * rstd * g1.z, v[j][7] * rstd * g1.w}; }
        }
    }
#undef IN
#undef SEAM
}


extern "C" void kernel_launch(void* const* d_in, const int* in_sizes, int n_in, void* d_out, int out_size, void* d_ws, size_t ws_size, hipStream_t stream) {
    static int grid = 0;
    if (grid == 0) {
        if (n_in != 24 || out_size != S * D || ws_size < WS_END) { fprintf(stderr, "kernel_launch: unexpected problem (n_in %d, out %d, ws %zu); nothing launched\n", n_in, out_size, ws_size); grid = -1; return; }
        int dev = 0, cus = 0, per_cu = 0;
        if (hipGetDevice(&dev) != hipSuccess || hipDeviceGetAttribute(&cus, hipDeviceAttributeMultiprocessorCount, dev) != hipSuccess) { grid = -1; return; }
        if (hipFuncSetAttribute((const void*)trunk_fwd, hipFuncAttributeMaxDynamicSharedMemorySize, LDS_BYTES) != hipSuccess) { fprintf(stderr, "kernel_launch: hipFuncSetAttribute failed\n"); grid = -1; return; }
        if (hipOccupancyMaxActiveBlocksPerMultiprocessor(&per_cu, (const void*)trunk_fwd, NTHR, LDS_BYTES) != hipSuccess || per_cu < 1)
            fprintf(stderr, "kernel_launch: note: occupancy query reports %d workgroups per CU\n", per_cu);
        (void)hipGetLastError();
        grid = cus;
    }
    if (grid < 0) return;
    if (hipMemsetAsync((char*)d_ws + WS_CTL, 0, CTL_ZERO_BYTES, stream) != hipSuccess) return;
    Args a{};
    for (int i = 0; i < 24; ++i) a.in[i] = (const float*)d_in[i];
    a.out = (float*)d_out; a.ws = (unsigned char*)d_ws;
#if MK_ONE_LAUNCH
    a.ph_lo = 0; a.ph_hi = NPHASE;
    hipLaunchKernelGGL(trunk_fwd, dim3(grid), dim3(NTHR), LDS_BYTES, stream, a);
#else
    for (int p = 0; p < NPHASE; ++p) { a.ph_lo = p; a.ph_hi = p + 1; hipLaunchKernelGGL(trunk_fwd, dim3(grid), dim3(NTHR), LDS_BYTES, stream, a); }
#endif
}
```
